# Optimizing an MI355X kernel written in HIP

```python
import math
import jax, jax.numpy as jnp
from jax import lax
import numpy as np

D_MODEL = 1024
BATCH = 2
SEQ = 16384
DEPTH = 1

M_HEADS = 4
M_QK_DIM = 64
M_V_DIM = 128
M_CHUNK = 64
GATE_SOFTCAP = 15.0
A_HEADS = 4
A_HEAD_DIM = 64
DILATED_PATTERNS = ((128, 1), (512, 4), (2048, 16))
N_GROUPS = len(DILATED_PATTERNS)
Q_BLOCK = 128
N_EXPERTS = 32
TOP_K = 4
D_FF = 1024
SWIGLU_LIMIT = 7.0
SWIGLU_ALPHA = 1.702
MOE_BLOCK = 512
EPS = 1e-6

M_WIDTH = M_HEADS * M_V_DIM
A_WIDTH = A_HEADS * A_HEAD_DIM
IN_SPLITS = (M_HEADS * M_QK_DIM, M_HEADS * M_QK_DIM, M_WIDTH, M_WIDTH, 2 * M_HEADS,
             N_GROUPS * A_WIDTH, N_GROUPS * A_WIDTH, N_GROUPS * A_WIDTH,
             D_MODEL, D_MODEL)
D_IN = sum(IN_SPLITS)

kernel_name = "hybrid_mlstm_dilated_attn_moe_block"


def _rms(t):
    tf = t.astype(jnp.float32)
    return tf * lax.rsqrt(jnp.mean(tf * tf, axis=-1, keepdims=True) + EPS)


def rms_norm(x, g):
    return (_rms(x) * g.astype(jnp.float32)).astype(x.dtype)


def soft_cap(t, cap):
    return cap * jnp.tanh(t / cap)


def alibi_slopes():
    n = N_GROUPS * A_HEADS
    s = np.exp2(-8.0 * np.arange(1, n + 1) / n).astype(np.float32)
    return jnp.asarray(s, dtype=jnp.float32).reshape(N_GROUPS, A_HEADS)


def mlstm_chunkwise(q, k, v, i_pre, f_pre):
    B, S, H, Dk = q.shape
    Dv = v.shape[-1]
    L = M_CHUNK
    nc = S // L

    def to_chunks(t):
        return t.reshape(B, nc, L, H, t.shape[-1]).transpose(0, 3, 1, 2, 4)

    qc = to_chunks(q)
    kc = to_chunks(k) * (Dk ** -0.5)
    vc = to_chunks(v)
    ic = i_pre.reshape(B, nc, L, H).transpose(0, 3, 1, 2)
    logf = jax.nn.log_sigmoid(f_pre).reshape(B, nc, L, H).transpose(0, 3, 1, 2)
    b = jnp.cumsum(logf, axis=-1)
    g = b[..., -1]

    a = g[..., None] - b + ic
    a_max = jnp.max(a, axis=-1)
    wa = jnp.exp(a - a_max[..., None])
    C_loc = jnp.einsum('bhcs,bhcsk,bhcsv->bhckv', wa, kc, vc)
    n_loc = jnp.einsum('bhcs,bhcsk->bhck', wa, kc)

    def step(carry, xs):
        C, n, m = carry
        g_c, am_c, Cl, nl = xs
        m_new = jnp.maximum(g_c + m, am_c)
        s_old = jnp.exp(g_c + m - m_new)
        s_loc = jnp.exp(am_c - m_new)
        C_new = s_old[..., None, None] * C + s_loc[..., None, None] * Cl
        n_new = s_old[..., None] * n + s_loc[..., None] * nl
        return (C_new, n_new, m_new), (C, n, m)

    init = (jnp.zeros((B, H, Dk, Dv), jnp.float32), jnp.zeros((B, H, Dk), jnp.float32),
            jnp.zeros((B, H), jnp.float32))
    xs = (g.transpose(2, 0, 1), a_max.transpose(2, 0, 1),
          C_loc.transpose(2, 0, 1, 3, 4), n_loc.transpose(2, 0, 1, 3))
    _, (C_prev, n_prev, m_prev) = lax.scan(step, init, xs)
    C_prev = C_prev.transpose(1, 2, 0, 3, 4)
    n_prev = n_prev.transpose(1, 2, 0, 3)
    m_prev = m_prev.transpose(1, 2, 0)

    causal = jnp.tril(jnp.ones((L, L), dtype=bool))
    Dlog = b[..., :, None] - b[..., None, :] + ic[..., None, :]
    Dlog = jnp.where(causal, Dlog, -jnp.inf)
    inter = b + m_prev[..., None]
    m_t = jnp.maximum(inter, jnp.max(Dlog, axis=-1))
    Sqk = jnp.einsum('bhctk,bhcsk->bhcts', qc, kc) * jnp.exp(Dlog - m_t[..., None])
    sc = jnp.exp(inter - m_t)
    num = jnp.einsum('bhcts,bhcsv->bhctv', Sqk, vc) + sc[..., None] * jnp.einsum('bhctk,bhckv->bhctv', qc, C_prev)
    den = jnp.sum(Sqk, axis=-1) + sc * jnp.einsum('bhctk,bhck->bhct', qc, n_prev)
    h = num / jnp.maximum(jnp.abs(den), jnp.exp(-m_t))[..., None]
    return h.transpose(0, 2, 3, 1, 4).reshape(B, S, H, Dv)


def dilated_window_attention(q, k, v, slopes, dilation, n_back):
    B, S, H, E = q.shape
    d = dilation
    L = S // d
    nb = -(-L // Q_BLOCK)
    Lp = nb * Q_BLOCK
    n_prev = -(-n_back // Q_BLOCK)
    KW = (n_prev + 1) * Q_BLOCK

    def to_sub(t):
        t = t.reshape(B, L, d, H, E).transpose(0, 2, 3, 1, 4)
        return jnp.pad(t, ((0, 0), (0, 0), (0, 0), (0, Lp - L), (0, 0)))

    def band(t):
        tp = jnp.pad(t, ((0, 0), (0, 0), (0, 0), (n_prev * Q_BLOCK, 0), (0, 0)))
        tp = tp.reshape(B, d, H, nb + n_prev, Q_BLOCK, E)
        return jnp.concatenate([tp[:, :, :, j:j + nb] for j in range(n_prev + 1)], axis=-2)

    qb = to_sub(q).reshape(B, d, H, nb, Q_BLOCK, E)
    kb = band(to_sub(k))
    vb = band(to_sub(v))
    s = jnp.einsum('bdhnqe,bdhnke->bdhnqk', qb, kb) * (E ** -0.5)

    qi = jnp.arange(Q_BLOCK)[:, None]
    kj = jnp.arange(KW)[None, :]
    dist = qi + n_prev * Q_BLOCK - kj
    key_pos = jnp.arange(nb)[:, None, None] * Q_BLOCK - n_prev * Q_BLOCK + kj[None]
    valid = (dist >= 0) & (dist <= n_back) & (key_pos >= 0)
    bias = -slopes[:, None, None] * (dist * d).astype(jnp.float32)[None]
    s = s + bias[None, None, :, None]
    s = jnp.where(valid[None, None, None], s, -jnp.inf)
    m = jnp.max(s, axis=-1, keepdims=True)
    p = jnp.exp(s - m)
    den = jnp.sum(p, axis=-1)
    o = jnp.einsum('bdhnqk,bdhnke->bdhnqe', p, vb) / den[..., None]
    lse = m[..., 0] + jnp.log(den)

    o = o.reshape(B, d, H, Lp, E)[:, :, :, :L].transpose(0, 3, 1, 2, 4).reshape(B, S, H, E)
    lse = lse.reshape(B, d, H, Lp)[..., :L].transpose(0, 3, 1, 2).reshape(B, S, H)
    return o, lse


def moe_ffn(h, w_router, b_router, w1, b1, w2, b2):
    B, S, D = h.shape
    N = B * S
    A = N * TOP_K
    xt = h.reshape(N, D)
    logits = (xt @ w_router + b_router).astype(jnp.float32)
    top_vals, top_idx = lax.top_k(logits, TOP_K)
    gates = jax.nn.softmax(top_vals, axis=-1)

    flat_e = top_idx.reshape(A).astype(jnp.int32)
    flat_tok = jnp.arange(A, dtype=jnp.int32) // TOP_K
    flat_g = gates.reshape(A)
    order = jnp.argsort(flat_e)
    sorted_e = flat_e[order]
    sorted_tok = flat_tok[order]
    counts = jnp.bincount(flat_e, length=N_EXPERTS)
    starts = jnp.cumsum(counts) - counts
    padded = ((counts + MOE_BLOCK - 1) // MOE_BLOCK) * MOE_BLOCK
    pends = jnp.cumsum(padded)
    pstarts = pends - padded
    dest = (pstarts[sorted_e] + jnp.arange(A) - starts[sorted_e]).astype(jnp.int32)
    NB = -(-A // MOE_BLOCK) + N_EXPERTS
    P = NB * MOE_BLOCK
    row_tok = jnp.full((P,), N, dtype=jnp.int32).at[dest].set(sorted_tok)
    block_e = jnp.minimum(jnp.searchsorted(pends, jnp.arange(NB) * MOE_BLOCK, side='right'),
                          N_EXPERTS - 1).astype(jnp.int32)
    x_pad = jnp.concatenate([xt, jnp.zeros((1, D), xt.dtype)], axis=0)

    def expert_block(args):
        rows, e = args
        xb = x_pad[rows]
        gu = xb @ w1[e] + b1[e]
        gate = jnp.minimum(gu[:, :D_FF], SWIGLU_LIMIT)
        lin = jnp.clip(gu[:, D_FF:], -SWIGLU_LIMIT, SWIGLU_LIMIT)
        glu = gate * jax.nn.sigmoid(SWIGLU_ALPHA * gate)
        return ((lin + 1.0) * glu) @ w2[e] + b2[e]

    ys = lax.map(expert_block, (row_tok.reshape(NB, MOE_BLOCK), block_e)).reshape(P, D)
    y_assign = ys[dest] * flat_g[order][:, None].astype(ys.dtype)
    y = jax.ops.segment_sum(y_assign, sorted_tok, num_segments=N)
    return y.reshape(B, S, D).astype(h.dtype)


def hybrid_block(x, norm1_g, w_in, mlstm_gate_b, mlstm_norm_g, attn_q_norm_g, attn_k_norm_g,
                 w_mlstm_branch, w_attn_branch, w_out, norm2_g, w_router, b_router, w1, b1, w2, b2):
    B, S, D = x.shape
    h = rms_norm(x, norm1_g)
    z = h @ w_in
    cuts = list(np.cumsum(IN_SPLITS)[:-1])
    mq, mk, mv, mo, mif, aq, ak, av, gm, ga = jnp.split(z, cuts, axis=-1)

    f32 = jnp.float32
    mif = mif.astype(f32) + mlstm_gate_b.astype(f32)
    i_pre = soft_cap(mif[..., :M_HEADS], GATE_SOFTCAP)
    f_pre = soft_cap(mif[..., M_HEADS:], GATE_SOFTCAP)
    h_m = mlstm_chunkwise(mq.astype(f32).reshape(B, S, M_HEADS, M_QK_DIM),
                          mk.astype(f32).reshape(B, S, M_HEADS, M_QK_DIM),
                          mv.astype(f32).reshape(B, S, M_HEADS, M_V_DIM), i_pre, f_pre)
    h_m = _rms(h_m) * mlstm_norm_g.astype(f32).reshape(M_HEADS, M_V_DIM)
    h_m = (jax.nn.sigmoid(mo.astype(f32)).reshape(B, S, M_HEADS, M_V_DIM) * h_m)
    h_m = h_m.reshape(B, S, M_WIDTH).astype(x.dtype)

    qa = _rms(aq.reshape(B, S, N_GROUPS, A_HEADS, A_HEAD_DIM)) * attn_q_norm_g.astype(f32)[:, None, :]
    ka = _rms(ak.reshape(B, S, N_GROUPS, A_HEADS, A_HEAD_DIM)) * attn_k_norm_g.astype(f32)[:, None, :]
    va = av.astype(f32).reshape(B, S, N_GROUPS, A_HEADS, A_HEAD_DIM)
    slopes = alibi_slopes()
    outs, lses = [], []
    for gi, (win, dil) in enumerate(DILATED_PATTERNS):
        o, l = dilated_window_attention(qa[:, :, gi], ka[:, :, gi], va[:, :, gi], slopes[gi], dil, win // dil)
        outs.append(o)
        lses.append(l)
    wg = jax.nn.softmax(jnp.stack(lses, axis=0), axis=0)
    h_a = jnp.sum(wg[..., None] * jnp.stack(outs, axis=0), axis=0)
    h_a = h_a.reshape(B, S, A_WIDTH).astype(x.dtype)

    y = jax.nn.sigmoid(gm) * (h_m @ w_mlstm_branch) + jax.nn.sigmoid(ga) * (h_a @ w_attn_branch)
    x = x + y @ w_out

    x = x + moe_ffn(rms_norm(x, norm2_g), w_router, b_router, w1, b1, w2, b2)
    return x


def setup_inputs(seed: int = 0) -> dict:
    key = jax.random.key(seed)
    ks = jax.random.split(key, 20)

    def nrm(k, shape, scale):
        return jax.random.normal(k, shape, jnp.float32) * scale

    x = nrm(ks[0], (BATCH, SEQ, D_MODEL), 1.0)
    norm1_g = 1.0 + nrm(ks[1], (DEPTH, D_MODEL), 0.05)
    w_in = nrm(ks[2], (DEPTH, D_MODEL, D_IN), D_MODEL ** -0.5)
    i_b = nrm(ks[3], (DEPTH, M_HEADS), 0.1) - 1.0
    f_b = jnp.linspace(3.0, 6.0, M_HEADS, dtype=jnp.float32)[None, :] + nrm(ks[4], (DEPTH, M_HEADS), 0.1)
    mlstm_gate_b = jnp.concatenate([i_b, f_b], axis=-1)
    mlstm_norm_g = 1.0 + nrm(ks[5], (DEPTH, M_WIDTH), 0.05)
    attn_q_norm_g = 1.0 + nrm(ks[6], (DEPTH, N_GROUPS, A_HEAD_DIM), 0.05)
    attn_k_norm_g = 1.0 + nrm(ks[7], (DEPTH, N_GROUPS, A_HEAD_DIM), 0.05)
    w_mlstm_branch = nrm(ks[8], (DEPTH, M_WIDTH, D_MODEL), M_WIDTH ** -0.5)
    w_attn_branch = nrm(ks[9], (DEPTH, A_WIDTH, D_MODEL), A_WIDTH ** -0.5)
    w_out = nrm(ks[10], (DEPTH, D_MODEL, D_MODEL), D_MODEL ** -0.5)
    norm2_g = 1.0 + nrm(ks[11], (DEPTH, D_MODEL), 0.05)
    w_router = nrm(ks[12], (DEPTH, D_MODEL, N_EXPERTS), D_MODEL ** -0.5)
    b_router = nrm(ks[13], (DEPTH, N_EXPERTS), 0.01)
    w1 = nrm(ks[14], (DEPTH, N_EXPERTS, D_MODEL, 2 * D_FF), D_MODEL ** -0.5)
    b1 = nrm(ks[15], (DEPTH, N_EXPERTS, 2 * D_FF), 0.01)
    w2 = nrm(ks[16], (DEPTH, N_EXPERTS, D_FF, D_MODEL), D_FF ** -0.5)
    b2 = nrm(ks[17], (DEPTH, N_EXPERTS, D_MODEL), 0.01)
    return {"x": x, "norm1_g": norm1_g, "w_in": w_in, "mlstm_gate_b": mlstm_gate_b,
            "mlstm_norm_g": mlstm_norm_g, "attn_q_norm_g": attn_q_norm_g, "attn_k_norm_g": attn_k_norm_g,
            "w_mlstm_branch": w_mlstm_branch, "w_attn_branch": w_attn_branch, "w_out": w_out,
            "norm2_g": norm2_g, "w_router": w_router, "b_router": b_router,
            "w1": w1, "b1": b1, "w2": w2, "b2": b2}


def reference(x, norm1_g, w_in, mlstm_gate_b, mlstm_norm_g, attn_q_norm_g, attn_k_norm_g,
              w_mlstm_branch, w_attn_branch, w_out, norm2_g, w_router, b_router, w1, b1, w2, b2):
    for l in range(DEPTH):
        x = hybrid_block(x, norm1_g[l], w_in[l], mlstm_gate_b[l], mlstm_norm_g[l], attn_q_norm_g[l],
                         attn_k_norm_g[l], w_mlstm_branch[l], w_attn_branch[l], w_out[l], norm2_g[l],
                         w_router[l], b_router[l], w1[l], b1[l], w2[l], b2[l])
    return x
```

```cpp
#include <hip/hip_runtime.h>
#include <cstdio>
#include <cstdint>

#ifndef MK_N_LAUNCHES
#define MK_N_LAUNCHES 1
#endif

#ifndef MAXPH
#define MAXPH 99
#endif
#ifndef DUP_PHASE
#define DUP_PHASE -1
#endif
#ifndef DUP_VARIANT
#define DUP_VARIANT 0
#endif
#define LAS __attribute__((address_space(3)))
#define GAS __attribute__((address_space(1)))
typedef unsigned short bf16_t;
typedef short bf16x8 __attribute__((ext_vector_type(8)));
typedef short s16x4 __attribute__((ext_vector_type(4)));
typedef float f32x4 __attribute__((ext_vector_type(4)));
typedef float f32x2 __attribute__((ext_vector_type(2)));
typedef unsigned u32x4 __attribute__((ext_vector_type(4)));
typedef unsigned u32x2 __attribute__((ext_vector_type(2)));
typedef int v8i_t __attribute__((ext_vector_type(8)));
typedef int v4i_t __attribute__((ext_vector_type(4)));
template <int MODE> struct FragT { typedef bf16x8 type; };
template <> struct FragT<1> { typedef v4i_t type; };

constexpr int NTOK = 32768, SEQ = 16384, DM = 1024;
constexpr int NEXP = 32, DFF = 1024;
constexpr float EPS = 1e-6f;
constexpr float LOG2E = 1.4426950408889634f;
constexpr int NPH = 11;

constexpr size_t MiB = 1u << 20;
constexpr size_t WS_CTL = 0, CTL_ZERO_BYTES = 1 * MiB;
constexpr size_t WS_GATES = 1 * MiB;
constexpr size_t WS_SSQ = 2 * MiB;
constexpr size_t WS_LSE = 4 * MiB;
constexpr size_t WS_TOPE = 6 * MiB;
constexpr size_t WS_TOPPOS = 7 * MiB;
constexpr size_t WS_LIST = 8 * MiB;
constexpr size_t WS_GLIST = 12 * MiB;
constexpr size_t WS_SRSTD = 16 * MiB;
constexpr size_t WS_MSTAT = 20 * MiB;
constexpr size_t WS_WIN = 21 * MiB;
constexpr size_t WS_WM = 33 * MiB;
constexpr size_t WS_WA = 34 * MiB;
constexpr size_t WS_WO = 35 * MiB;
constexpr size_t WS_WR = 37 * MiB;
constexpr size_t WS_W1 = 38 * MiB;
constexpr size_t WS_W2 = 102 * MiB;
constexpr size_t WS_X1B = 134 * MiB;
constexpr size_t WS_X1F8 = 198 * MiB;
constexpr size_t WS_OVL = 230 * MiB;
constexpr size_t WS_XN = WS_OVL;
constexpr size_t WS_MQ = WS_XN + 64 * MiB;
constexpr size_t WS_MK = WS_MQ + 16 * MiB;
constexpr size_t WS_MV = WS_MK + 16 * MiB;
constexpr size_t WS_MO = WS_MV + 32 * MiB;
constexpr size_t WS_AQ = WS_MO + 32 * MiB;
constexpr size_t WS_AK = WS_AQ + 48 * MiB;
constexpr size_t WS_AV = WS_AK + 48 * MiB;
constexpr size_t WS_GM = WS_AV + 48 * MiB;
constexpr size_t WS_GA = WS_GM + 64 * MiB;
constexpr size_t WS_CLOC = WS_GA + 64 * MiB;
constexpr size_t WS_HM = WS_CLOC + 16 * MiB;
constexpr size_t WS_AO = WS_HM + 32 * MiB;
constexpr size_t WS_HA = WS_AO + 48 * MiB;
constexpr size_t WS_Y = WS_HA + 32 * MiB;
constexpr size_t WS_CINIT = WS_Y + 64 * MiB;
constexpr size_t WS_NINIT = WS_CINIT + 16 * MiB;
constexpr size_t WS_XN8 = WS_NINIT + 1 * MiB;
constexpr size_t WS_WIN8 = WS_XN8 + 32 * MiB;
constexpr size_t WS_END1 = WS_WIN8 + 6 * MiB;
constexpr size_t WS_H = WS_OVL;
constexpr size_t WS_Y2 = WS_OVL + 130 * MiB;
constexpr size_t WS_END2 = WS_Y2 + 256 * MiB;
constexpr size_t WS_NEED = (WS_END1 > WS_END2 ? WS_END1 : WS_END2);

constexpr int CW_CNT = 64;
constexpr int CW_BAR = 4096;

constexpr int RING_BYTES = 131072;
constexpr int TAB_OFF = RING_BYTES;
constexpr int ROWBUF_OFF = RING_BYTES + 1024;
constexpr int TAB_OFF_UNUSED = 0;
constexpr int LDS_BYTES = 163840;
constexpr int MISC_OFF = LDS_BYTES - 256;

#define LOG2E_ 1.4426950408889634f
#define LDS_WAIT() asm volatile("s_waitcnt lgkmcnt(0)" ::: "memory")
#define VM_WAIT() asm volatile("s_waitcnt vmcnt(0)" ::: "memory")
__device__ __forceinline__ unsigned f2bf(float f) { unsigned u = __builtin_bit_cast(unsigned, f); return (u + 0x7fffu + ((u >> 16) & 1u)) >> 16; }
typedef __bf16 bf16x2_hw __attribute__((ext_vector_type(2)));
__device__ __forceinline__ unsigned pk2(float lo, float hi) { const f32x2 v = {lo, hi}; return __builtin_bit_cast(unsigned, __builtin_convertvector(v, bf16x2_hw)); }
__device__ __forceinline__ float bflo(unsigned w) { return __builtin_bit_cast(float, w << 16); }
__device__ __forceinline__ float bfhi(unsigned w) { return __builtin_bit_cast(float, w & 0xffff0000u); }
__device__ __forceinline__ float bf2f(bf16_t h) { return __builtin_bit_cast(float, (unsigned)h << 16); }
__device__ __forceinline__ float sigmoidf_(float x) { return __builtin_amdgcn_rcpf(1.0f + __builtin_amdgcn_exp2f(-LOG2E_ * x)); }
__device__ __forceinline__ u32x4 pack8(const f32x4 a, const f32x4 b) { u32x4 w; w.x = pk2(a[0], a[1]); w.y = pk2(a[2], a[3]); w.z = pk2(b[0], b[1]); w.w = pk2(b[2], b[3]); return w; }
__device__ __forceinline__ void unpack8(const u32x4 w, f32x4& a, f32x4& b) { a[0] = bflo(w.x); a[1] = bfhi(w.x); a[2] = bflo(w.y); a[3] = bfhi(w.y); b[0] = bflo(w.z); b[1] = bfhi(w.z); b[2] = bflo(w.w); b[3] = bfhi(w.w); }
__device__ __forceinline__ u32x2 pack8_fp8(const f32x4 a, const f32x4 b) { int w0 = 0, w1 = 0;
    w0 = __builtin_amdgcn_cvt_pk_fp8_f32(a[0], a[1], w0, false); w0 = __builtin_amdgcn_cvt_pk_fp8_f32(a[2], a[3], w0, true);
    w1 = __builtin_amdgcn_cvt_pk_fp8_f32(b[0], b[1], w1, false); w1 = __builtin_amdgcn_cvt_pk_fp8_f32(b[2], b[3], w1, true); return (u32x2){(unsigned)w0, (unsigned)w1}; }
#ifndef ST_WT
#define ST_WT 0
#endif
__device__ __forceinline__ void st16(void* p, const u32x4 v) {
#if ST_WT
    asm volatile("global_store_dwordx4 %0, %1, off sc1\n\ts_nop 1" :: "v"(p), "v"(v) : "memory");
#else
    *(u32x4*)p = v;
#endif
}
typedef short v4i16_t __attribute__((ext_vector_type(4)));
__device__ __forceinline__ s16x4 trread(const LAS unsigned char* p) { return __builtin_bit_cast(s16x4, __builtin_amdgcn_ds_read_tr16_b64_v4i16((LAS v4i16_t*)p)); }
__device__ __forceinline__ bf16x8 cat4(s16x4 lo, s16x4 hi) { return (bf16x8){lo[0], lo[1], lo[2], lo[3], hi[0], hi[1], hi[2], hi[3]}; }
#define MFMA16(a, b, c) __builtin_amdgcn_mfma_f32_16x16x32_bf16((a), (b), (c), 0, 0, 0)

namespace g8 {
#ifndef G8_LATE_MOE
#define G8_LATE_MOE false
#endif
#ifndef G8_LATE_BF
#define G8_LATE_BF false
#endif
#ifndef FP8_FROM
#define FP8_FROM 4
#endif
#ifndef WGM_P8
#define WGM_P8 8
#endif
#ifndef WGM_P9
#define WGM_P9 4
#endif
#ifndef WGM_P1B
#define WGM_P1B 4
#endif
#ifndef G8_WGM
#define G8_WGM 4
#endif
constexpr int BM = 256, BK = 64, HALF = 128, HTB = HALF * BK * 2, NXCD = 8, WGM = G8_WGM;
__device__ __forceinline__ int lds_byte(int r, int c) { const int st = (r >> 4) * 2 + (c >> 5), rr = r & 15, cc = c & 31, ob = rr * 64 + cc * 2; return st * 1024 + (ob ^ (((ob >> 9) & 1) << 5)); }
__device__ __forceinline__ void stage_rc(int b, int& R, int& C) { const int st = b / 1024, sb = b % 1024, swz = sb ^ (((sb >> 9) & 1) << 5); R = (st >> 1) * 16 + swz / 64; C = (st & 1) * 32 + (swz % 64) / 2; }
__device__ __forceinline__ int perm32(int rho) { const int n = rho >> 4, i = rho & 15; return 8 * (i >> 2) + 4 * n + (i & 3); }

struct GUnit { const char* A; const char* B; int nt; int pm, pn, sel, e, rt, x, y; };

struct TileOrder {
    int nM, nN, nwg, G, c, wgm;
    __device__ __forceinline__ void init(int nM_, int nN_, int G_, int c_, int wgm_ = WGM) { nM = nM_; nN = nN_; nwg = nM * nN; G = G_; c = c_; wgm = wgm_; }
    __device__ __forceinline__ bool tile(int i, int& pm, int& pn) const {
        const long L = (long)i * G + c; if (L >= nwg) return false;
        int wgid = (int)L; { const int q = nwg / NXCD, r = nwg % NXCD, xcd = wgid % NXCD, off = wgid / NXCD; wgid = (xcd < r ? xcd * (q + 1) : r * (q + 1) + (xcd - r) * q) + off; }
        const int nig = wgm * nN, gid = wgid / nig, fm = gid * wgm, gsz = (nM - fm) < wgm ? (nM - fm) : wgm;
        pm = fm + ((wgid % nig) % gsz); pn = (wgid % nig) / gsz; return true;
    }
};

template <class Epi, class Sched, bool GATHER, int MODE = 0, bool LATE = false>
__device__ __forceinline__ void gemm_phase(LAS unsigned char* lds, const Sched& S, const Epi& E, const unsigned pitchA, const unsigned pitchB, const int tid, const int wid) {
    const int lane = tid & 63, wr = wid >> 2, wc = wid & 3, fr = lane & 15, fq = lane >> 4;
    unsigned voffB[2]; unsigned offC[2][2];
    LAS unsigned* rowbuf = (LAS unsigned*)(lds + ROWBUF_OFF);
#pragma unroll
    for (int i = 0; i < 2; ++i) { int R, C; stage_rc(tid * 16 + i * 8192, R, C); const int Rb = (R & ~31) + perm32(R & 31);
        voffB[i] = (unsigned)Rb * pitchB + (unsigned)C * 2u; }
    const unsigned hstepB = (unsigned)HALF * pitchB, hstepA = (unsigned)HALF * pitchA;
    const size_t kstep = (size_t)(BK * 2);
    const unsigned ldsw = (unsigned)wid * 1024u;
    const int aoff = lds_byte(wr * 64 + fr, fq * 8), boff = lds_byte(wc * 32 + fr, fq * 8);
#define G8_SA(b, h) (((b) * 2 + (h)) * HTB)
#define G8_SB(b, h) ((4 + (b) * 2 + (h)) * HTB)
#define G8_STAGE_B(bufoff, gbase, h) do { const char* _gp = (const char*)(gbase) + (h) * hstepB; asm volatile("" : "+s"(_gp)); _Pragma("unroll") for (int _i = 0; _i < 2; ++_i) \
        __builtin_amdgcn_global_load_lds((const unsigned*)(_gp + voffB[_i]), (LAS unsigned*)(lds + (bufoff) + ldsw + _i * 8192), 16, 0, 0); } while (0)
#define G8_STAGE_A(bufoff, gbase, hh) do { const char* _gp = (const char*)(gbase) + (GATHER ? 0u : (hh) * hstepA); asm volatile("" : "+s"(_gp)); const unsigned* offs = offC[GATHER ? (hh) : 0]; _Pragma("unroll") for (int _i = 0; _i < 2; ++_i) \
        __builtin_amdgcn_global_load_lds((const unsigned*)(_gp + (offs)[_i]), (LAS unsigned*)(lds + (bufoff) + ldsw + _i * 8192), 16, 0, 0); } while (0)
#define G8_LDA(dst, b, h) do { _Pragma("unroll") for (int m = 0; m < 4; ++m) _Pragma("unroll") for (int k = 0; k < 2; ++k) dst[m][k] = *(const LAS frag_t*)(lds + G8_SA(b, h) + aoff + m * 2048 + k * 1024); } while (0)
#define G8_LDB(dst, b, h) do { _Pragma("unroll") for (int n = 0; n < 2; ++n) _Pragma("unroll") for (int k = 0; k < 2; ++k) dst[n][k] = *(const LAS frag_t*)(lds + G8_SB(b, h) + boff + n * 2048 + k * 1024); } while (0)
#define G8_CAT(x) __builtin_shufflevector((x)[0], (x)[1], 0, 1, 2, 3, 4, 5, 6, 7)
#define G8_MMA(ai, bj, At, Bt) do { __builtin_amdgcn_s_setprio(1); _Pragma("unroll") for (int m = 0; m < 4; ++m) _Pragma("unroll") for (int n = 0; n < 2; ++n) { \
        if constexpr (MODE == 0) { _Pragma("unroll") for (int k = 0; k < 2; ++k) acc[ai][bj][m][n] = __builtin_amdgcn_mfma_f32_16x16x32_bf16(Bt[n][k], At[m][k], acc[ai][bj][m][n], 0, 0, 0); } \
        else { const v8i_t _b8 = G8_CAT(Bt[n]), _a8 = G8_CAT(At[m]); asm volatile("v_mfma_f32_16x16x128_f8f6f4 %0, %1, %2, %0" : "+v"(acc[ai][bj][m][n]) : "v"(_b8), "v"(_a8)); } } \
        __builtin_amdgcn_s_setprio(0); } while (0)
#define G8_SWITCH() do { if constexpr (GATHER) { if (last && has_next) { int t2_ = tid; asm volatile("" : "+v"(t2_)); \
        _Pragma("unroll") for (int h = 0; h < 2; ++h) _Pragma("unroll") for (int i = 0; i < 2; ++i) { int R_, C_; stage_rc(t2_ * 16 + i * 8192, R_, C_); offC[h][i] = S.arow_lds(nxt, h * HALF + R_, rowbuf) + (unsigned)C_ * 2u; } \
        asm volatile("s_waitcnt lgkmcnt(0)" : "+v"(offC[0][0]), "+v"(offC[0][1]), "+v"(offC[1][0]), "+v"(offC[1][1]) :: "memory"); } } } while (0)
#define G8_WAIT_V(n) asm volatile("s_waitcnt vmcnt(" #n ")" ::: "memory")
#define G8_WAIT_L(n) asm volatile("s_waitcnt lgkmcnt(" #n ")" ::: "memory")
#define G8_BAR __builtin_amdgcn_s_barrier()
#define G8_SCHED __builtin_amdgcn_sched_barrier(0)
    GUnit cur, nxt; int ui = 0;
    if (!S.next(0, cur)) return;
    f32x4 acc[2][2][4][2];
#pragma unroll
    for (int a = 0; a < 2; ++a)
#pragma unroll
        for (int b = 0; b < 2; ++b)
#pragma unroll
            for (int m = 0; m < 4; ++m)
#pragma unroll
                for (int n = 0; n < 2; ++n) acc[a][b][m][n] = (f32x4){0.f, 0.f, 0.f, 0.f};
    typedef typename FragT<MODE>::type frag_t;
    frag_t At[4][2], B0[2][2], B1[2][2];
    const char* cA = cur.A; const char* cB = cur.B;
#pragma unroll
    for (int h = 0; h < 2; ++h)
#pragma unroll
        for (int i = 0; i < 2; ++i) { int R, C; stage_rc(tid * 16 + i * 8192, R, C);
            if constexpr (GATHER) offC[h][i] = S.arow(cur, h * HALF + R) + (unsigned)C * 2u;
            else offC[h][i] = (unsigned)R * pitchA + (unsigned)C * 2u;
        }
    if constexpr (GATHER) { asm volatile("s_waitcnt vmcnt(0)" : "+v"(offC[0][0]), "+v"(offC[0][1]), "+v"(offC[1][0]), "+v"(offC[1][1]) :: "memory"); }
    E.aux_dma(cur, lds + ROWBUF_OFF + 1024, 0, wid, lane);
    G8_STAGE_B(G8_SB(0, 0), cB, 0); G8_STAGE_B(G8_SB(0, 1), cB, 1); G8_STAGE_A(G8_SA(0, 0), cA, 0); G8_STAGE_A(G8_SA(0, 1), cA, 1);
    if (wr == 1) G8_BAR;
    G8_WAIT_V(2); G8_BAR;
    G8_STAGE_B(G8_SB(1, 0), cB + kstep, 0); G8_STAGE_A(G8_SA(1, 0), cA + kstep, 0); G8_STAGE_B(G8_SB(1, 1), cB + kstep, 1);
    G8_WAIT_V(6); G8_BAR;
    for (;;) {
        const bool has_next = S.next(ui + 1, nxt);
        const char* nA = has_next ? nxt.A : cA; const char* nB = has_next ? nxt.B : cB;
        if constexpr (GATHER) { if (has_next) S.rows_dma(nxt, rowbuf, wid, lane); }
        const int nt = cur.nt;
#pragma unroll 1
        for (int t = 0; t < nt; t += 2) {
            const bool last = (t == nt - 2);
            const char* a1 = cA + (size_t)(t + 1) * kstep;
            const char* a2 = last ? nA : cA + (size_t)(t + 2) * kstep; const char* b2 = last ? nB : cB + (size_t)(t + 2) * kstep;
            const char* a3 = a2 + kstep; const char* b3 = b2 + kstep;
            if constexpr (!LATE) {
            G8_LDB(B0, 0, 0); G8_LDB(B1, 0, 1); G8_SCHED; G8_LDA(At, 0, 0); G8_STAGE_A(G8_SA(1, 1), a1, 1);
            G8_WAIT_V(8); G8_WAIT_L(0); G8_BAR; G8_MMA(0, 0, At, B0); G8_MMA(0, 1, At, B1); G8_BAR; G8_SCHED;
            G8_SWITCH();
            G8_LDA(At, 0, 1); G8_STAGE_B(G8_SB(0, 0), b2, 0); G8_STAGE_B(G8_SB(0, 1), b2, 1); G8_STAGE_A(G8_SA(0, 0), a2, 0);
            G8_WAIT_V(8); G8_WAIT_L(0); G8_BAR; G8_MMA(1, 0, At, B0); G8_MMA(1, 1, At, B1); G8_BAR; G8_SCHED;
            G8_LDB(B0, 1, 0); G8_LDB(B1, 1, 1); G8_SCHED; G8_LDA(At, 1, 0); G8_STAGE_A(G8_SA(0, 1), a2, 1);
            G8_WAIT_V(8); G8_WAIT_L(0); G8_BAR; G8_MMA(0, 0, At, B0); G8_MMA(0, 1, At, B1); G8_BAR; G8_SCHED;
            G8_LDA(At, 1, 1); G8_STAGE_B(G8_SB(1, 0), b3, 0); G8_STAGE_B(G8_SB(1, 1), b3, 1); G8_STAGE_A(G8_SA(1, 0), a3, 0);
            G8_WAIT_V(8); G8_WAIT_L(0); G8_BAR; G8_MMA(1, 0, At, B0); G8_MMA(1, 1, At, B1); G8_BAR; G8_SCHED;
            } else {
            G8_LDB(B0, 0, 0); G8_LDB(B1, 0, 1); G8_SCHED; G8_LDA(At, 0, 0);
            G8_WAIT_V(6); G8_WAIT_L(0); G8_BAR; G8_MMA(0, 0, At, B0); G8_SCHED; G8_STAGE_A(G8_SA(1, 1), a1, 1); G8_SCHED; G8_MMA(0, 1, At, B1); G8_BAR; G8_SCHED;
            G8_SWITCH();
            G8_LDA(At, 0, 1);
            G8_WAIT_V(2); G8_WAIT_L(0); G8_BAR; G8_MMA(1, 0, At, B0); G8_SCHED; G8_STAGE_B(G8_SB(0, 0), b2, 0); G8_STAGE_B(G8_SB(0, 1), b2, 1); G8_SCHED; G8_MMA(1, 1, At, B1); G8_SCHED; G8_STAGE_A(G8_SA(0, 0), a2, 0); G8_BAR; G8_SCHED;
            G8_LDB(B0, 1, 0); G8_LDB(B1, 1, 1); G8_SCHED; G8_LDA(At, 1, 0);
            G8_WAIT_V(6); G8_WAIT_L(0); G8_BAR; G8_MMA(0, 0, At, B0); G8_SCHED; G8_STAGE_A(G8_SA(0, 1), a2, 1); G8_SCHED; G8_MMA(0, 1, At, B1); G8_BAR; G8_SCHED;
            G8_LDA(At, 1, 1);
            G8_WAIT_V(2); G8_WAIT_L(0); G8_BAR; G8_MMA(1, 0, At, B0); G8_SCHED; G8_STAGE_B(G8_SB(1, 0), b3, 0); G8_STAGE_B(G8_SB(1, 1), b3, 1); G8_SCHED; G8_MMA(1, 1, At, B1); G8_SCHED; G8_STAGE_A(G8_SA(1, 0), a3, 0); G8_BAR; G8_SCHED;
            }
        }
        if (wr == 0) G8_BAR;
        if constexpr (MODE == 1) asm volatile("s_nop 15\n\ts_nop 15" ::: "memory");
        const bool keep = E(acc, cur, wr, wc, fr, fq, lds + ROWBUF_OFF + 1024, ui & 1);
        if (!has_next) break;
        E.aux_dma(nxt, lds + ROWBUF_OFF + 1024, (ui + 1) & 1, wid, lane);
        if (!keep) {
#pragma unroll
            for (int a = 0; a < 2; ++a)
#pragma unroll
                for (int b = 0; b < 2; ++b)
#pragma unroll
                    for (int m = 0; m < 4; ++m)
#pragma unroll
                        for (int n = 0; n < 2; ++n) acc[a][b][m][n] = (f32x4){0.f, 0.f, 0.f, 0.f};
        }
        cur = nxt; cA = nA; cB = nB; ++ui;
        if (wr == 1) G8_BAR;
    }
    G8_WAIT_V(0);
    G8_BAR;
#undef G8_SA
#undef G8_SB
#undef G8_STAGE_A
#undef G8_STAGE_B
#undef G8_LDA
#undef G8_LDB
#undef G8_MMA
#undef G8_CAT
#undef G8_WAIT_V
#undef G8_SWITCH
#undef G8_WAIT_L
#undef G8_BAR
#undef G8_SCHED
}
}

typedef GAS unsigned gu32;
#define RLX_AGENT __ATOMIC_RELAXED, __HIP_MEMORY_SCOPE_AGENT
#define XB_TMO      128
#define XB_XCNT(j)  (256  + 64 * (j))
#define XB_XSUB(j)  (1280 + 64 * (j))
#define XB_XGEN(j)  (2304 + 64 * (j))
#define XB_TOP      3328
#define XB_TOPGEN   3392
#define XCD_BAR_WORDS 3456
#define XB_SPIN_CAP (1u << 22)
__device__ __forceinline__ unsigned xb_ld(unsigned* p)              { return __hip_atomic_load(p, __ATOMIC_RELAXED, __HIP_MEMORY_SCOPE_AGENT); }
__device__ __forceinline__ unsigned xb_add(unsigned* p, unsigned v) { return __hip_atomic_fetch_add(p, v, __ATOMIC_RELAXED, __HIP_MEMORY_SCOPE_AGENT); }
__device__ __forceinline__ unsigned xb_xcc_id() { return (unsigned)__builtin_amdgcn_s_getreg((3 << 11) | 20) & 0xFu; }
#define XB_SPIN(cond, bar) do { unsigned _sp = 0; while (cond) { __builtin_amdgcn_s_sleep(1); \
    if ((++_sp & 255u) == 0u) { if (xb_ld(&(bar)[XB_TMO])) break; if (_sp > XB_SPIN_CAP) { atomicAdd(&(bar)[XB_TMO], 1u); break; } } } } while (0)
struct XcdBarrier { unsigned* bar; unsigned x; volatile LAS unsigned* st; };
__device__ __forceinline__ XcdBarrier xcd_barrier_post(unsigned* bar, volatile LAS unsigned* st, const bool t0) {
    XcdBarrier b; b.bar = bar; b.x = xb_xcc_id(); b.st = st;
    if (t0) (void)xb_add(&bar[XB_XCNT(b.x)], 1u);
    return b;
}
__device__ __forceinline__ void xcd_barrier_complete(unsigned* bar, unsigned x, unsigned& nloc, unsigned& nx) {
    const unsigned G = gridDim.x * gridDim.y * gridDim.z;
    unsigned sum, cnt, mine, sp = 0u;
    for (;;) {
        sum = 0u; cnt = 0u; mine = 0u;
#pragma unroll
        for (unsigned j = 0; j < 16; ++j) { const unsigned c = xb_ld(&bar[XB_XCNT(j)]); sum += c; cnt += (c > 0u) ? 1u : 0u; mine = (j == x) ? c : mine; }
        if (sum == G) break;
        __builtin_amdgcn_s_sleep(1);
        if ((++sp & 255u) == 0u) { if (xb_ld(&bar[XB_TMO])) break; if (sp > XB_SPIN_CAP) { atomicAdd(&bar[XB_TMO], 1u); break; } }
    }
    nloc = mine > 0u ? mine : 1u; nx = cnt > 0u ? cnt : 1u;
}
__device__ __forceinline__ void xcd_barrier(const XcdBarrier& b, const bool t0) {
    asm volatile("s_waitcnt vmcnt(0)" ::: "memory");
    __syncthreads();
    if (t0) {
        unsigned* bar = b.bar;
        __builtin_amdgcn_s_waitcnt(0);
        unsigned nloc = b.st[0], nx = b.st[1];
        if (nloc == 0u) { xcd_barrier_complete(bar, b.x, nloc, nx); b.st[0] = nloc; b.st[1] = nx; }
        const unsigned old = xb_add(&bar[XB_XSUB(b.x)], 1u);
        const unsigned gen = old / nloc;
        if (old + 1u == (gen + 1u) * nloc) {
            __builtin_amdgcn_fence(__ATOMIC_RELEASE, "agent");
            asm volatile("s_waitcnt vmcnt(0)" ::: "memory");
            const unsigned og = xb_add(&bar[XB_TOP], 1u);
            const unsigned tg = og / nx;
            if (og + 1u == (tg + 1u) * nx) xb_add(&bar[XB_TOPGEN], 1u);
            else XB_SPIN(xb_ld(&bar[XB_TOPGEN]) == tg, bar);
            __builtin_amdgcn_fence(__ATOMIC_ACQUIRE, "agent");
            xb_add(&bar[XB_XGEN(b.x)], 1u);
            asm volatile("s_waitcnt vmcnt(0)" ::: "memory");
        } else {
            XB_SPIN(xb_ld(&bar[XB_XGEN(b.x)]) == gen, bar);
            __builtin_amdgcn_fence(__ATOMIC_ACQUIRE, "agent");
            asm volatile("s_waitcnt vmcnt(0)" ::: "memory");
        }
    }
    __syncthreads();
}

struct Args { const float* in[17]; float* out; unsigned char* ws; int ph_lo, ph_hi; };
typedef const __attribute__((address_space(4))) Args* KArgP;
struct Frame {
    LAS unsigned char* lds;
    int tid, lane, wave, vcu, G;
    KArgP ap;
    float* out; unsigned char* ws;
};
#define INP(k) ((const GAS float*)F.ap->in[k])
enum { I_X = 0, I_N1G, I_WIN, I_GATEB, I_MNG, I_AQG, I_AKG, I_WMB, I_WAB, I_WOUT, I_N2G, I_WR, I_BR, I_W1, I_B1, I_W2, I_B2 };
#define WSP(T, off) ((T*)(F.ws + (off)))

__device__ __forceinline__ float wave_sum(float v) {
#pragma unroll
    for (int o = 1; o < 64; o <<= 1) v += __shfl_xor(v, o);
    return v;
}

struct TItem { const GAS float* src; const GAS float* scale; unsigned char* dst; int srcpitch, dstpitchB, r0, r1, fmt, half; };
__device__ __forceinline__ TItem titem_decode(Frame& F, int it) {
    constexpr int NI_IN = 92 * 16, NI_WM = 16 * 8, NI_WA = 16 * 4, NI_WO = 16 * 16, NI_WR = 16, NI_W1 = 32 * 32 * 16;
    TItem t; t.scale = nullptr; t.fmt = 0; t.half = 0;
    int r = it;
    if (r < NI_IN) { const int q = r % 92, kb = r / 92, pn = q >> 2, wc = q & 3; const int colbase = pn < 6 ? 256 * pn : 1544 + 256 * (pn - 6);
        t.src = INP(I_WIN) + (size_t)(64 * kb) * 5896 + colbase + 64 * wc; t.srcpitch = 5896; t.r0 = 256 * pn + 32 * wc; t.r1 = t.r0 + 128;
        if (pn >= FP8_FROM) { t.dst = F.ws + WS_WIN8 + 64 * kb; t.dstpitchB = 1024; t.fmt = 1; } else { t.dst = F.ws + WS_WIN + 128 * kb; t.dstpitchB = 2048; }
        return t; } r -= NI_IN;
    if (r < NI_WM) { const int kb = r % 8, q = r / 8, pn = q >> 2, wc = q & 3;
        t.src = INP(I_WMB) + (size_t)(64 * kb) * 1024 + 256 * pn + 64 * wc; t.srcpitch = 1024; t.dst = F.ws + WS_WM + 128 * kb; t.dstpitchB = 1024; t.r0 = 256 * pn + 32 * wc; t.r1 = t.r0 + 128; return t; } r -= NI_WM;
    if (r < NI_WA) { const int kb = r % 4, q = r / 4, pn = q >> 2, wc = q & 3;
        t.src = INP(I_WAB) + (size_t)(64 * kb) * 1024 + 256 * pn + 64 * wc; t.srcpitch = 1024; t.dst = F.ws + WS_WA + 128 * kb; t.dstpitchB = 1024; t.r0 = 256 * pn + 32 * wc; t.r1 = t.r0 + 128; return t; } r -= NI_WA;
    if (r < NI_WO) { const int kb = r % 16, q = r / 16, pn = q >> 2, wc = q & 3;
        t.src = INP(I_WOUT) + (size_t)(64 * kb) * 1024 + 256 * pn + 64 * wc; t.srcpitch = 1024; t.dst = F.ws + WS_WO + 128 * kb; t.dstpitchB = 2048; t.r0 = 256 * pn + 32 * wc; t.r1 = t.r0 + 128; return t; } r -= NI_WO;
    if (r < NI_WR) { const int kb = r;
        t.src = INP(I_WR) + (size_t)(64 * kb) * 32; t.srcpitch = 32; t.dst = F.ws + WS_WR + 128 * kb; t.dstpitchB = 2048; t.r0 = 0; t.r1 = 0; t.scale = INP(I_N2G) + 64 * kb; t.half = 1; return t; } r -= NI_WR;
    if (r < NI_W1) { const int cb = r % 32; int q = r / 32; const int kb = q % 16, e = q / 16;
        const int q2 = cb & 15, rr = 256 * (q2 >> 1) + 64 * (q2 & 1) + (cb >= 16 ? 128 : 0);
        t.src = INP(I_W1) + (size_t)e * 1024 * 2048 + (size_t)(64 * kb) * 2048 + 64 * cb; t.srcpitch = 2048; t.dst = F.ws + WS_W1 + (size_t)e * 2048 * 1024 + 64 * kb; t.dstpitchB = 1024; t.r0 = rr; t.r1 = rr + 32;
        t.scale = INP(I_N2G) + 64 * kb; t.fmt = 1; return t; } r -= NI_W1;
    { const int cb = r % 16; int q = r / 16; const int kb = q % 16, e = q / 16, pn = cb >> 2, wc = cb & 3;
        t.src = INP(I_W2) + (size_t)e * 1024 * 1024 + (size_t)(64 * kb) * 1024 + 256 * pn + 64 * wc; t.srcpitch = 1024; t.dst = F.ws + WS_W2 + (size_t)e * 1024 * 1024 + 64 * kb; t.dstpitchB = 1024; t.r0 = 256 * pn + 32 * wc; t.r1 = t.r0 + 128; t.fmt = 1; return t; }
}
__device__ __forceinline__ void titem_load(const TItem& t, int lane, f32x4 (&v)[16], float (&sc)[16]) {
    const int cq = lane & 15, kq = lane >> 4;
#pragma unroll
    for (int i = 0; i < 16; ++i) { v[i] = (f32x4){0.f, 0.f, 0.f, 0.f}; if (!t.half || cq < 8) v[i] = *(const GAS f32x4*)(t.src + (size_t)(4 * i + kq) * t.srcpitch + 4 * cq); }
#pragma unroll
    for (int i = 0; i < 16; ++i) sc[i] = (t.scale ? t.scale[4 * i + kq] : 1.0f) * (t.fmt == 1 ? 32.0f : 1.0f);
}
__device__ __forceinline__ void titem_store(const TItem& t, int lane, const f32x4 (&v)[16], const float (&sc)[16], LAS float* scr) {
    const int cq = lane & 15, kq = lane >> 4;
#pragma unroll
    for (int i = 0; i < 16; ++i) { LAS float* s = scr + (4 * i + kq) * 65 + 4 * cq; s[0] = v[i][0] * sc[i]; s[1] = v[i][1] * sc[i]; s[2] = v[i][2] * sc[i]; s[3] = v[i][3] * sc[i]; }
    LDS_WAIT(); asm volatile("" ::: "memory");
    if (t.fmt == 0) {
        const int ch = lane & 7;
#pragma unroll
        for (int q = 0; q < 8; ++q) { const int n = (lane >> 3) + 8 * q; const LAS float* s = scr + (8 * ch) * 65 + n;
            u32x4 o; o.x = pk2(s[0 * 65], s[1 * 65]); o.y = pk2(s[2 * 65], s[3 * 65]); o.z = pk2(s[4 * 65], s[5 * 65]); o.w = pk2(s[6 * 65], s[7 * 65]);
            if (!t.half || n < 32) *(GAS u32x4*)(t.dst + (size_t)(n < 32 ? t.r0 + n : t.r1 + n - 32) * t.dstpitchB + ch * 16) = o; }
    } else {
        const int ch = lane & 3;
#pragma unroll
        for (int q = 0; q < 4; ++q) { const int n = (lane >> 2) + 16 * q; const LAS float* s = scr + (16 * ch) * 65 + n;
            f32x4 a0 = (f32x4){s[0 * 65], s[1 * 65], s[2 * 65], s[3 * 65]}, a1 = (f32x4){s[4 * 65], s[5 * 65], s[6 * 65], s[7 * 65]};
            f32x4 a2 = (f32x4){s[8 * 65], s[9 * 65], s[10 * 65], s[11 * 65]}, a3 = (f32x4){s[12 * 65], s[13 * 65], s[14 * 65], s[15 * 65]};
            const u32x2 lo = pack8_fp8(a0, a1), hi = pack8_fp8(a2, a3);
            *(GAS u32x4*)(t.dst + (size_t)(n < 32 ? t.r0 + n : t.r1 + n - 32) * t.dstpitchB + ch * 16) = (u32x4){lo.x, lo.y, hi.x, hi.y}; }
    }
    LDS_WAIT(); asm volatile("" ::: "memory");
}

__device__ __forceinline__ void p0_prologue(Frame& F) {
    LAS float* scr = (LAS float*)(F.lds + F.wave * 16640);
    const int gw = F.vcu * 8 + F.wave, NGW = F.G * 8;
    constexpr int NITEMS = 92 * 16 + 16 * 8 + 16 * 4 + 16 * 16 + 16 + 32 * 32 * 16 + 32 * 16 * 16;
    {
        int it = gw;
        if (it < NITEMS) {
            f32x4 vc[16], vn[16]; float sc_c[16], sc_n[16];
            TItem cur = titem_decode(F, it); titem_load(cur, F.lane, vc, sc_c);
            for (;;) {
                const int itn = it + NGW; const bool has_next = itn < NITEMS;
                TItem nxt = cur;
                if (has_next) { nxt = titem_decode(F, itn); titem_load(nxt, F.lane, vn, sc_n); }
                titem_store(cur, F.lane, vc, sc_c, scr);
                if (!has_next) break;
                cur = nxt; it = itn;
#pragma unroll
                for (int i = 0; i < 16; ++i) { vc[i] = vn[i]; sc_c[i] = sc_n[i]; }
            }
        }
    }
    __syncthreads();
    LAS float* WG = (LAS float*)(F.lds);
    for (int u = F.tid; u < 1024 * 8; u += 512) WG[(u & 7) * 1024 + (u >> 3)] = INP(I_WIN)[(size_t)(u >> 3) * 5896 + 1536 + (u & 7)];
    __syncthreads();
    f32x4 g1v[4];
#pragma unroll
    for (int j = 0; j < 4; ++j) g1v[j] = *(const GAS f32x4*)(INP(I_N1G) + 4 * F.lane + 256 * j);
    const float gb = INP(I_GATEB)[F.lane & 7];
    if (gw < NTOK) {
        f32x4 vn[4];
        { const GAS f32x4* xr = (const GAS f32x4*)(INP(I_X) + (size_t)gw * DM) + F.lane;
#pragma unroll
          for (int j = 0; j < 4; ++j) vn[j] = xr[64 * j]; }
        for (int m = gw; m < NTOK; m += NGW) {
            f32x4 v[4]; float s2 = 0.f;
#pragma unroll
            for (int j = 0; j < 4; ++j) { v[j] = vn[j]; s2 += (v[j].x * v[j].x + v[j].y * v[j].y) + (v[j].z * v[j].z + v[j].w * v[j].w); }
            if (m + NGW < NTOK) { const GAS f32x4* xr = (const GAS f32x4*)(INP(I_X) + (size_t)(m + NGW) * DM) + F.lane;
#pragma unroll
                for (int j = 0; j < 4; ++j) vn[j] = xr[64 * j]; }
            const float rstd = __builtin_amdgcn_rsqf(wave_sum(s2) * (1.f / DM) + EPS);
            GAS unsigned long long* o8 = (GAS unsigned long long*)(WSP(bf16_t, WS_XN) + (size_t)m * DM) + F.lane;
            float ga[8];
#pragma unroll
            for (int c = 0; c < 8; ++c) ga[c] = 0.f;
#pragma unroll
            for (int j = 0; j < 4; ++j) {
                v[j] = v[j] * rstd * g1v[j];
                o8[64 * j] = (unsigned long long)pk2(v[j].x, v[j].y) | ((unsigned long long)pk2(v[j].z, v[j].w) << 32);
                { int w8 = 0; w8 = __builtin_amdgcn_cvt_pk_fp8_f32(v[j].x, v[j].y, w8, false); w8 = __builtin_amdgcn_cvt_pk_fp8_f32(v[j].z, v[j].w, w8, true);
                  ((GAS unsigned*)(F.ws + WS_XN8 + (size_t)m * DM))[F.lane + 64 * j] = (unsigned)w8; }
#pragma unroll
                for (int c = 0; c < 8; ++c) { const f32x4 w = *(const LAS f32x4*)(WG + c * 1024 + 4 * F.lane + 256 * j); ga[c] += (v[j].x * w.x + v[j].y * w.y) + (v[j].z * w.z + v[j].w * w.w); }
            }
#pragma unroll
            for (int c = 0; c < 4; ++c) { const float mine = (F.lane & 4) ? ga[c + 4] : ga[c], oth = (F.lane & 4) ? ga[c] : ga[c + 4]; ga[c] = mine + __shfl_xor(oth, 4); }
#pragma unroll
            for (int c = 0; c < 2; ++c) { const float mine = (F.lane & 2) ? ga[c + 2] : ga[c], oth = (F.lane & 2) ? ga[c] : ga[c + 2]; ga[c] = mine + __shfl_xor(oth, 2); }
            { const float mine = (F.lane & 1) ? ga[1] : ga[0], oth = (F.lane & 1) ? ga[0] : ga[1]; ga[0] = mine + __shfl_xor(oth, 1); }
            float t = ga[0];
            t += __shfl_xor(t, 8); t += __shfl_xor(t, 16); t += __shfl_xor(t, 32);
            if (F.lane < 8) { const float z = t + gb; WSP(float, WS_GATES)[(size_t)m * 8 + F.lane] = 15.0f * tanhf(z * (1.0f / 15.0f)); }
        }
    }
}

struct SchedInProj { g8::TileOrder T; const char* A; const char* B;
    __device__ __forceinline__ bool next(int i, g8::GUnit& u) const { int pm, pn; if (!T.tile(i, pm, pn)) return false; u.pm = pm; u.pn = pn; u.nt = 16; u.sel = 0; u.e = 0; u.rt = 0; u.x = 0; u.y = 0;
        u.A = A + (size_t)pm * 256 * 2048; u.B = B + (size_t)pn * 256 * 2048; return true; }
    __device__ __forceinline__ unsigned arow(const g8::GUnit&, int) const { return 0u; }
};
struct SchedInProj8 { g8::TileOrder T; const char* A; const char* B;
    __device__ __forceinline__ bool next(int i, g8::GUnit& u) const { int pm, pl; if (!T.tile(i, pm, pl)) return false; const int pn = FP8_FROM + pl; u.pm = pm; u.pn = pn; u.nt = 8; u.sel = 0; u.e = 0; u.rt = 0; u.x = 256 * pm; u.y = 256;
        u.A = A; u.B = B + (size_t)pn * 256 * 1024; return true; }
    __device__ __forceinline__ unsigned arow(const g8::GUnit& u, int r) const { return (unsigned)(u.x + r) * 1024u; }
    __device__ __forceinline__ void rows_dma(const g8::GUnit&, LAS unsigned*, int, int) const {}
    __device__ __forceinline__ unsigned arow_lds(const g8::GUnit& u, int r, const LAS unsigned*) const { return (unsigned)(u.x + r) * 1024u; }
};
struct EpiInProj {
    unsigned char* ws; const GAS float* gq; const GAS float* gk; float ascale;
    __device__ __forceinline__ void aux_dma(const g8::GUnit&, LAS unsigned char*, int, int, int) const {}
    __device__ __forceinline__ bool operator()(f32x4 (&acc)[2][2][4][2], const g8::GUnit& u, int wr, int wc, int fr, int fq, LAS unsigned char* aux, int par) const {
        const int pn = u.pn;
        size_t base; int pitch, col0, kind = 0, grp = 0; float sc = 1.f;
        if (pn == 0)      { base = WS_MQ; pitch = 256; col0 = 0; }
        else if (pn == 1) { base = WS_MK; pitch = 256; col0 = 0; sc = 0.125f; }
        else if (pn < 4)  { base = WS_MV; pitch = 512; col0 = 256 * (pn - 2); }
        else if (pn < 6)  { base = WS_MO; pitch = 512; col0 = 256 * (pn - 4); kind = 1; }
        else if (pn < 9)  { base = WS_AQ; pitch = 768; col0 = 256 * (pn - 6); kind = 2; grp = pn - 6; sc = 0.125f * LOG2E; }
        else if (pn < 12) { base = WS_AK; pitch = 768; col0 = 256 * (pn - 9); kind = 3; grp = pn - 9; }
        else if (pn < 15) { base = WS_AV; pitch = 768; col0 = 256 * (pn - 12); }
        else if (pn < 19) { base = WS_GM; pitch = 1024; col0 = 256 * (pn - 15); kind = 1; }
        else              { base = WS_GA; pitch = 1024; col0 = 256 * (pn - 19); kind = 1; }
        bf16_t* dst = (bf16_t*)(ws + base);
        const int L0 = 64 * wc + 8 * fq;
        const int row0 = u.pm * 256 + wr * 64 + fr;
        f32x4 gn[2][2];
        if (kind >= 2) { const int go = grp * 64 + 8 * fq;
#pragma unroll
            for (int bj = 0; bj < 2; ++bj)
#pragma unroll
                for (int n = 0; n < 2; ++n) { const f32x4 a = *(const GAS f32x4*)(gq + go + 32 * bj + 4 * n), b = *(const GAS f32x4*)(gk + go + 32 * bj + 4 * n); gn[bj][n] = (kind == 2) ? a : b; } }
#pragma unroll
        for (int ai = 0; ai < 2; ++ai)
#pragma unroll
            for (int m = 0; m < 4; ++m) {
                const int row = row0 + 128 * ai + 16 * m;
                f32x4 v[2][2];
#pragma unroll
                for (int bj = 0; bj < 2; ++bj)
#pragma unroll
                    for (int n = 0; n < 2; ++n) v[bj][n] = acc[ai][bj][m][n] * ascale;
                if (kind == 1) {
#pragma unroll
                    for (int bj = 0; bj < 2; ++bj)
#pragma unroll
                        for (int n = 0; n < 2; ++n)
#pragma unroll
                            for (int e = 0; e < 4; ++e) v[bj][n][e] = sigmoidf_(v[bj][n][e]);
                } else if (kind >= 2) {
                    float ss = 0.f;
#pragma unroll
                    for (int bj = 0; bj < 2; ++bj)
#pragma unroll
                        for (int n = 0; n < 2; ++n) ss += (v[bj][n][0] * v[bj][n][0] + v[bj][n][1] * v[bj][n][1]) + (v[bj][n][2] * v[bj][n][2] + v[bj][n][3] * v[bj][n][3]);
                    ss += __shfl_xor(ss, 16); ss += __shfl_xor(ss, 32);
                    const float r = sc * __builtin_amdgcn_rsqf(ss * (1.0f / 64.0f) + EPS);
#pragma unroll
                    for (int bj = 0; bj < 2; ++bj)
#pragma unroll
                        for (int n = 0; n < 2; ++n) v[bj][n] = v[bj][n] * gn[bj][n] * r;
                } else {
#pragma unroll
                    for (int bj = 0; bj < 2; ++bj)
#pragma unroll
                        for (int n = 0; n < 2; ++n) v[bj][n] = v[bj][n] * sc;
                }
#pragma unroll
                for (int bj = 0; bj < 2; ++bj) st16(dst + (size_t)row * pitch + col0 + L0 + 32 * bj, pack8(v[bj][0], v[bj][1]));
            }
        return false;
    }
};

struct SchedBranch { g8::TileOrder T; const char *A0, *B0, *A1, *B1;
    __device__ __forceinline__ bool next(int i, g8::GUnit& u) const { int pm, pn; if (!T.tile(i >> 1, pm, pn)) return false; u.pm = pm; u.pn = pn; u.sel = i & 1; u.e = 0; u.rt = 0; u.x = 0; u.y = 0;
        if (u.sel == 0) { u.nt = 8; u.A = A0 + (size_t)pm * 256 * 1024; u.B = B0 + (size_t)pn * 256 * 1024; }
        else            { u.nt = 4; u.A = A1 + (size_t)pm * 256 * 1024; u.B = B1 + (size_t)pn * 256 * 1024; }
        return true; }
    __device__ __forceinline__ unsigned arow(const g8::GUnit&, int) const { return 0u; }
};
struct EpiBranch {
    const bf16_t *GM, *GA; bf16_t* Y;
    __device__ __forceinline__ void aux_dma(const g8::GUnit&, LAS unsigned char*, int, int, int) const {}
    __device__ __forceinline__ bool operator()(f32x4 (&acc)[2][2][4][2], const g8::GUnit& u, int wr, int wc, int fr, int fq, LAS unsigned char* aux, int par) const {
        const int row0 = u.pm * 256 + wr * 64 + fr, c0 = 256 * u.pn + 64 * wc + 8 * fq;
        u32x4 gan[2], gmn[2], gac[2], gmc[2];
#pragma unroll
        for (int bj = 0; bj < 2; ++bj) { const size_t ro = (size_t)row0 * 1024 + c0 + 32 * bj; gan[bj] = *(const u32x4*)(GA + ro); gmn[bj] = gan[bj]; if (u.sel == 0) gmn[bj] = *(const u32x4*)(GM + ro); }
#pragma unroll
        for (int ai = 0; ai < 2; ++ai)
#pragma unroll
            for (int m = 0; m < 4; ++m) {
                const size_t ro = (size_t)(row0 + 128 * ai + 16 * m) * 1024 + c0;
#pragma unroll
                for (int bj = 0; bj < 2; ++bj) { gac[bj] = gan[bj]; gmc[bj] = gmn[bj]; }
                if (ai * 4 + m < 7) { const int it = ai * 4 + m + 1; const size_t rn = (size_t)(row0 + 128 * (it >> 2) + 16 * (it & 3)) * 1024 + c0;
#pragma unroll
                    for (int bj = 0; bj < 2; ++bj) { gan[bj] = *(const u32x4*)(GA + rn + 32 * bj); gmn[bj] = gan[bj]; if (u.sel == 0) gmn[bj] = *(const u32x4*)(GM + rn + 32 * bj); } }
#pragma unroll
                for (int bj = 0; bj < 2; ++bj) {
                    f32x4 a0, a1; unpack8(gac[bj], a0, a1);
                    if (u.sel == 0) { f32x4 m0, m1; unpack8(gmc[bj], m0, m1);
#pragma unroll
                        for (int e = 0; e < 4; ++e) { acc[ai][bj][m][0][e] *= m0[e] * __builtin_amdgcn_rcpf(a0[e]); acc[ai][bj][m][1][e] *= m1[e] * __builtin_amdgcn_rcpf(a1[e]); }
                    } else { st16(Y + ro + 32 * bj, pack8(acc[ai][bj][m][0] * a0, acc[ai][bj][m][1] * a1)); }
                }
            }
        return u.sel == 0;
    }
};

struct SchedWout { g8::TileOrder T; const char* A; const char* B;
    __device__ __forceinline__ bool next(int i, g8::GUnit& u) const { int pm, pn; if (!T.tile(i, pm, pn)) return false; u.pm = pm; u.pn = pn; u.nt = 16; u.sel = 0; u.e = 0; u.rt = 0; u.x = 0; u.y = 0;
        u.A = A + (size_t)pm * 256 * 2048; u.B = B + (size_t)pn * 256 * 2048; return true; }
    __device__ __forceinline__ unsigned arow(const g8::GUnit&, int) const { return 0u; }
};
struct EpiWout {
    const GAS float* x; bf16_t* X1B; unsigned char* X1F8; float* SSQ;
    __device__ __forceinline__ void aux_dma(const g8::GUnit&, LAS unsigned char*, int, int, int) const {}
    __device__ __forceinline__ bool operator()(f32x4 (&acc)[2][2][4][2], const g8::GUnit& u, int wr, int wc, int fr, int fq, LAS unsigned char* aux, int par) const {
        const int row0 = u.pm * 256 + wr * 64 + fr, c0 = 256 * u.pn + 64 * wc + 8 * fq;
        const bool odd = fq & 1;
        f32x4 xn[2][2], xc[2][2];
#pragma unroll
        for (int bj = 0; bj < 2; ++bj) { const size_t ro = (size_t)row0 * 1024 + c0; xn[bj][0] = *(const GAS f32x4*)(x + ro + 32 * bj); xn[bj][1] = *(const GAS f32x4*)(x + ro + 32 * bj + 4); }
#pragma unroll
        for (int ai = 0; ai < 2; ++ai)
#pragma unroll
            for (int m = 0; m < 4; ++m) {
                const int row = row0 + 128 * ai + 16 * m; const size_t ro = (size_t)row * 1024 + c0; float ss = 0.f;
#pragma unroll
                for (int bj = 0; bj < 2; ++bj) { xc[bj][0] = xn[bj][0]; xc[bj][1] = xn[bj][1]; }
                if (ai * 4 + m < 7) { const int it = ai * 4 + m + 1; const size_t rn = (size_t)(row0 + 128 * (it >> 2) + 16 * (it & 3)) * 1024 + c0;
#pragma unroll
                    for (int bj = 0; bj < 2; ++bj) { xn[bj][0] = *(const GAS f32x4*)(x + rn + 32 * bj); xn[bj][1] = *(const GAS f32x4*)(x + rn + 32 * bj + 4); } }
                u32x2 f8[2];
#pragma unroll
                for (int bj = 0; bj < 2; ++bj) {
                    const f32x4 x0 = xc[bj][0], x1 = xc[bj][1];
                    const f32x4 v0 = acc[ai][bj][m][0] + x0, v1 = acc[ai][bj][m][1] + x1;
                    st16(X1B + ro + 32 * bj, pack8(v0, v1)); f8[bj] = pack8_fp8(v0, v1);
                    ss += (v0[0] * v0[0] + v0[1] * v0[1]) + (v0[2] * v0[2] + v0[3] * v0[3]) + (v1[0] * v1[0] + v1[1] * v1[1]) + (v1[2] * v1[2] + v1[3] * v1[3]);
                }
                const u32x2 snd = odd ? f8[0] : f8[1];
                u32x2 rcv; rcv.x = (unsigned)__shfl_xor((int)snd.x, 16); rcv.y = (unsigned)__shfl_xor((int)snd.y, 16);
                const u32x4 w16 = odd ? (u32x4){rcv.x, rcv.y, f8[1].x, f8[1].y} : (u32x4){f8[0].x, f8[0].y, rcv.x, rcv.y};
                st16(X1F8 + (size_t)row * 1024 + 256 * u.pn + 64 * wc + (odd ? 32 + 8 * (fq - 1) : 8 * fq), w16);
                ss += __shfl_xor(ss, 16); ss += __shfl_xor(ss, 32);
                if (fq == 0) SSQ[(size_t)row * 16 + u.pn * 4 + wc] = ss;
            }
        return false;
    }
};

__device__ __forceinline__ void moe_tables(Frame& F) {
    LAS int* tab = (LAS int*)(F.lds + TAB_OFF);
    if (F.wave == 0) { const unsigned* cnt = WSP(unsigned, WS_CTL) + CW_CNT;
        const int c = F.lane < NEXP ? (int)__hip_atomic_load(cnt + (F.lane & 31), RLX_AGENT) : 0;
        const int t = (c + 255) >> 8; int ts = t, of = c;
#pragma unroll
        for (int o = 1; o < 32; o <<= 1) { const int a = __shfl_up(ts, o), b2 = __shfl_up(of, o); if (F.lane >= o) { ts += a; of += b2; } }
        if (F.lane < NEXP) { tab[F.lane] = ts - t; tab[40 + F.lane] = of - c; tab[80 + F.lane] = c; }
        if (F.lane == NEXP - 1) { tab[32] = ts; tab[72] = of; } }
    __syncthreads();
}
template <int NPN, bool G1>
struct SchedMoe { g8::TileOrder T; const LAS int* tab; const char* A; const char* B; const int* LIST;
    __device__ __forceinline__ bool next(int i, g8::GUnit& u) const { int pm, pn; if (!T.tile(i, pm, pn)) return false;
        int e = 0;
        for (int k = 1; k < NEXP; ++k) e = (tab[k] <= pm) ? k : e;
        e = __builtin_amdgcn_readfirstlane(e);
        const int ts = __builtin_amdgcn_readfirstlane(tab[e]), of = __builtin_amdgcn_readfirstlane(tab[40 + e]), cn = __builtin_amdgcn_readfirstlane(tab[80 + e]);
        const int rt = pm - ts; u.pm = pm; u.pn = pn; u.sel = 0; u.e = e; u.rt = rt; u.nt = 8; u.x = of + 256 * rt; u.y = cn - 256 * rt;
        if (G1) { u.A = A; u.B = B + ((size_t)e * 2048 + 256 * pn) * 1024; }
        else { u.A = A; u.B = B + ((size_t)e * 1024 + 256 * pn) * 1024; }
        return true; }
    __device__ __forceinline__ unsigned arow(const g8::GUnit& u, int r) const {
        if (G1) { const int rr = r < u.y ? r : u.y - 1; const int tok = LIST[(size_t)u.e * NTOK + 256 * u.rt + rr]; return (unsigned)tok * 1024u; }
        else return (unsigned)(u.x + r) * 1024u; }
    __device__ __forceinline__ void rows_dma(const g8::GUnit& u, LAS unsigned* buf, int wid, int lane) const {
        if (G1) { if (wid < 4) __builtin_amdgcn_global_load_lds((const unsigned*)(LIST + (size_t)u.e * NTOK + 256 * u.rt + 64 * wid + lane), (LAS unsigned*)(buf + 64 * wid), 4, 0, 0); } }
    __device__ __forceinline__ unsigned arow_lds(const g8::GUnit& u, int r, const LAS unsigned* buf) const {
        if (G1) { const unsigned tok = buf[r]; return (tok < (unsigned)NTOK ? tok : 0u) * 1024u; }
        else return (unsigned)(u.x + r) * 1024u; }
};
struct EpiMoe1 {
    const float* SRSTD; const GAS float* b1; unsigned char* H;
    __device__ __forceinline__ void aux_dma(const g8::GUnit& u, LAS unsigned char* aux, int par, int wid, int lane) const {
        if (wid == 4) __builtin_amdgcn_global_load_lds((const unsigned*)(SRSTD + (size_t)u.e * NTOK + 256 * u.rt + 4 * lane), (LAS unsigned*)(aux + par * 2048), 16, 0, 0);
        if (wid == 5) __builtin_amdgcn_global_load_lds((const unsigned*)((const float*)b1 + (size_t)u.e * 2048 + (lane < 32 ? 0 : 1024) + 128 * u.pn + 4 * (lane & 31)), (LAS unsigned*)(aux + par * 2048 + 1024), 16, 0, 0); }
    __device__ __forceinline__ bool operator()(f32x4 (&acc)[2][2][4][2], const g8::GUnit& u, int wr, int wc, int fr, int fq, LAS unsigned char* aux, int par) const {
        const int j0 = 128 * u.pn + 32 * wc + 8 * fq; const bool odd = fq & 1;
        const LAS float* sb = (const LAS float*)(aux + par * 2048); const LAS float* bbuf = sb + 256;
        f32x4 bg[2], bl[2];
#pragma unroll
        for (int n = 0; n < 2; ++n) { bg[n] = *(const LAS f32x4*)(bbuf + 32 * wc + 8 * fq + 4 * n); bl[n] = *(const LAS f32x4*)(bbuf + 128 + 32 * wc + 8 * fq + 4 * n); }
        float rsv[2][4];
#pragma unroll
        for (int ai = 0; ai < 2; ++ai)
#pragma unroll
            for (int m = 0; m < 4; ++m) { const int r = 128 * ai + 64 * wr + 16 * m + fr; rsv[ai][m] = (r < u.y) ? sb[r] * 0.03125f : 0.f; }
#pragma unroll
        for (int ai = 0; ai < 2; ++ai)
#pragma unroll
            for (int mp = 0; mp < 2; ++mp) {
                u32x2 h8[2]; int rr[2];
#pragma unroll
                for (int q = 0; q < 2; ++q) { const int m = 2 * mp + q;
                    const int r = 128 * ai + 64 * wr + 16 * m + fr; rr[q] = r;
                    const float rs = rsv[ai][m];
                    f32x4 o[2];
#pragma unroll
                    for (int n = 0; n < 2; ++n)
#pragma unroll
                        for (int e = 0; e < 4; ++e) {
                            float g = fminf(rs * acc[ai][0][m][n][e] + bg[n][e], 7.0f);
                            float l = fminf(fmaxf(rs * acc[ai][1][m][n][e] + bl[n][e], -7.0f), 7.0f);
                            o[n][e] = (l + 1.0f) * g * sigmoidf_(1.702f * g);
                        }
                    h8[q] = pack8_fp8(o[0], o[1]); }
                const u32x2 snd = odd ? h8[0] : h8[1];
                u32x2 rcv; rcv.x = (unsigned)__shfl_xor((int)snd.x, 16); rcv.y = (unsigned)__shfl_xor((int)snd.y, 16);
                const u32x4 w16 = odd ? (u32x4){rcv.x, rcv.y, h8[1].x, h8[1].y} : (u32x4){h8[0].x, h8[0].y, rcv.x, rcv.y};
                const int r = odd ? rr[1] : rr[0];
                if (r < u.y) st16(H + (size_t)(u.x + r) * 1024 + (odd ? j0 - 8 : j0), w16);
            }
        return false;
    }
};
struct EpiMoe2 {
    const float* GLIST; const GAS float* b2; unsigned char* Y2;
    __device__ __forceinline__ void aux_dma(const g8::GUnit& u, LAS unsigned char* aux, int par, int wid, int lane) const {
        if (wid == 4) __builtin_amdgcn_global_load_lds((const unsigned*)(GLIST + (size_t)u.e * NTOK + 256 * u.rt + 4 * lane), (LAS unsigned*)(aux + par * 2048), 16, 0, 0);
        if (wid == 5) __builtin_amdgcn_global_load_lds((const unsigned*)((const float*)b2 + (size_t)u.e * 1024 + 256 * u.pn + 4 * lane), (LAS unsigned*)(aux + par * 2048 + 1024), 16, 0, 0); }
    __device__ __forceinline__ bool operator()(f32x4 (&acc)[2][2][4][2], const g8::GUnit& u, int wr, int wc, int fr, int fq, LAS unsigned char* aux, int par) const {
        const int c0 = 256 * u.pn + 64 * wc + 8 * fq; const bool odd = fq & 1;
        const LAS float* sb = (const LAS float*)(aux + par * 2048); const LAS float* bbuf = sb + 256;
        f32x4 bb[2][2];
#pragma unroll
        for (int bj = 0; bj < 2; ++bj)
#pragma unroll
            for (int n = 0; n < 2; ++n) bb[bj][n] = *(const LAS f32x4*)(bbuf + 64 * wc + 8 * fq + 32 * bj + 4 * n);
        float gtv[2][4];
#pragma unroll
        for (int ai = 0; ai < 2; ++ai)
#pragma unroll
            for (int m = 0; m < 4; ++m) { const int r = 128 * ai + 64 * wr + 16 * m + fr; gtv[ai][m] = (r < u.y) ? sb[r] * 16.0f : 0.f; }
#pragma unroll
        for (int ai = 0; ai < 2; ++ai)
#pragma unroll
            for (int m = 0; m < 4; ++m) {
                const int r = 128 * ai + 64 * wr + 16 * m + fr; const bool valid = r < u.y;
                const float gt = gtv[ai][m];
                u32x2 f8[2];
#pragma unroll
                for (int bj = 0; bj < 2; ++bj) f8[bj] = pack8_fp8((acc[ai][bj][m][0] * 0.03125f + bb[bj][0]) * gt, (acc[ai][bj][m][1] * 0.03125f + bb[bj][1]) * gt);
                const u32x2 snd = odd ? f8[0] : f8[1];
                u32x2 rcv; rcv.x = (unsigned)__shfl_xor((int)snd.x, 16); rcv.y = (unsigned)__shfl_xor((int)snd.y, 16);
                const u32x4 w16 = odd ? (u32x4){rcv.x, rcv.y, f8[1].x, f8[1].y} : (u32x4){f8[0].x, f8[0].y, rcv.x, rcv.y};
                if (valid) st16(Y2 + (size_t)(u.x + r) * 1024 + 256 * u.pn + 64 * wc + (odd ? 32 + 8 * (fq - 1) : 8 * fq), w16);
            }
        return false;
    }
};

constexpr int KP = 160, VP = 288;
constexpr int ML_K = 0, ML_V = 256 * KP, ML_C = ML_V + 256 * VP, ML_F = ML_C + 64 * VP, ML_OST = ML_F + 3328;
__device__ __forceinline__ float logsigmoidf_(float f) { return fminf(f, 0.f) - log1pf(__expf(-fabsf(f))); }

__device__ __forceinline__ void ml_gates(Frame& F, int n0, int h, LAS float* Bc, LAS float* ig) {
    if (F.wave == 0) {
        const float* G = WSP(float, WS_GATES);
        float lf[4], iv[4];
#pragma unroll
        for (int e = 0; e < 4; ++e) { const size_t t = (size_t)(n0 + 4 * F.lane + e) * 8; iv[e] = G[t + h]; lf[e] = logsigmoidf_(G[t + 4 + h]); }
        lf[1] += lf[0]; lf[2] += lf[1]; lf[3] += lf[2];
        float tot = lf[3], inc = tot;
#pragma unroll
        for (int o = 1; o < 64; o <<= 1) { const float t = __shfl_up(inc, o); if (F.lane >= o) inc += t; }
        const float exc = inc - tot;
#pragma unroll
        for (int e = 0; e < 4; ++e) { Bc[4 * F.lane + e] = exc + lf[e]; ig[4 * F.lane + e] = iv[e]; }
    }
}

__device__ __forceinline__ void mlstm_state_unit(Frame& F, int u) {
    const int bh = u >> 6, sc = u & 63, b = bh >> 2, h = bh & 3;
    const int n0 = b * SEQ + sc * 256;
    LAS unsigned char* Ks = F.lds + ML_K; LAS unsigned char* Vs = F.lds + ML_V;
    LAS float* Bc = (LAS float*)(F.lds + ML_F); LAS float* ig = Bc + 256;
    const bf16_t* MK = WSP(bf16_t, WS_MK); const bf16_t* MV = WSP(bf16_t, WS_MV);
    u32x4 kreg[4], vreg[8];
#pragma unroll
    for (int t = 0; t < 4; ++t) { const int c = F.tid + 512 * t, s = c >> 3, ch = c & 7; kreg[t] = *(const u32x4*)(MK + (size_t)(n0 + s) * 256 + h * 64 + ch * 8); }
#pragma unroll
    for (int t = 0; t < 8; ++t) { const int c = F.tid + 512 * t, s = c >> 4, ch = c & 15; vreg[t] = *(const u32x4*)(MV + (size_t)(n0 + s) * 512 + h * 128 + ch * 8); }
    ml_gates(F, n0, h, Bc, ig);
    __syncthreads();
    const float Gt = Bc[255];
#pragma unroll
    for (int t = 0; t < 4; ++t) { const int c = F.tid + 512 * t, s = c >> 3, ch = c & 7; const float w = __expf(Gt - Bc[s] + ig[s]);
        f32x4 a0, a1; unpack8(kreg[t], a0, a1);
        *(LAS u32x4*)(Ks + s * KP + ch * 16) = pack8(a0 * w, a1 * w); }
#pragma unroll
    for (int t = 0; t < 8; ++t) { const int c = F.tid + 512 * t, s = c >> 4, ch = c & 15; *(LAS u32x4*)(Vs + s * VP + ch * 16) = vreg[t]; }
    __syncthreads();
    const int i = F.lane & 15, g = F.lane >> 4, w = F.wave;
    f32x4 acc[4], accn[4];
#pragma unroll
    for (int t = 0; t < 4; ++t) { acc[t] = (f32x4){0.f, 0.f, 0.f, 0.f}; accn[t] = (f32x4){0.f, 0.f, 0.f, 0.f}; }
    const bf16x8 ones = (bf16x8){0x3F80, 0x3F80, 0x3F80, 0x3F80, 0x3F80, 0x3F80, 0x3F80, 0x3F80};
    const int roff = (4 * g + (i >> 2));
    for (int ks = 0; ks < 8; ++ks) {
        const int s0 = 32 * ks;
        const LAS unsigned char* vp = Vs + (s0 + roff) * VP + (16 * w + 4 * (i & 3)) * 2;
        const bf16x8 bv = cat4(trread(vp), trread(vp + 16 * VP));
#pragma unroll
        for (int dk = 0; dk < 4; ++dk) {
            const LAS unsigned char* kp = Ks + (s0 + roff) * KP + (16 * dk + 4 * (i & 3)) * 2;
            const bf16x8 ak = cat4(trread(kp), trread(kp + 16 * KP));
            acc[dk] = MFMA16(ak, bv, acc[dk]);
            if (w == 0) accn[dk] = MFMA16(ak, ones, accn[dk]);
        }
    }
    float* CL = WSP(float, WS_CLOC) + (size_t)u * 8192;
#pragma unroll
    for (int dk = 0; dk < 4; ++dk)
#pragma unroll
        for (int r = 0; r < 4; ++r) CL[(16 * dk + 4 * g + r) * 128 + 16 * w + i] = acc[dk][r];
    if (w == 0 && i == 0) {
#pragma unroll
        for (int dk = 0; dk < 4; ++dk)
#pragma unroll
            for (int r = 0; r < 4; ++r) WSP(float, WS_MSTAT)[(size_t)u * 64 + 16 * dk + 4 * g + r] = accn[dk][r];
    }
    if (F.tid == 0) WSP(float, WS_MSTAT)[512 * 64 + u] = Gt;
    __syncthreads();
}

__device__ __forceinline__ void mlstm_scan(Frame& F) {
    const int gt = F.vcu * 512 + F.tid, NT = F.G * 512;
    const float* GT = WSP(float, WS_MSTAT) + 512 * 64;
    for (int idx = gt; idx < 8 * 8256; idx += NT) {
        const int bh = idx / 8256, el = idx % 8256;
        const float* p; float* q; size_t stride;
        if (el < 8192) { p = WSP(float, WS_CLOC) + (size_t)bh * 64 * 8192 + el; q = WSP(float, WS_CINIT) + (size_t)bh * 64 * 8192 + el; stride = 8192; }
        else { p = WSP(float, WS_MSTAT) + (size_t)bh * 64 * 64 + (el - 8192); q = WSP(float, WS_NINIT) + (size_t)bh * 64 * 64 + (el - 8192); stride = 64; }
        float st = 0.f;
#pragma unroll 1
        for (int s0 = 0; s0 < 64; s0 += 32) {
            float v[32], gv[32];
#pragma unroll
            for (int k = 0; k < 32; ++k) { v[k] = p[(size_t)(s0 + k) * stride]; gv[k] = GT[bh * 64 + s0 + k]; }
#pragma unroll
            for (int k = 0; k < 32; ++k) { q[(size_t)(s0 + k) * stride] = st; st = __expf(gv[k]) * st + v[k]; }
        }
    }
}

__device__ __forceinline__ void mlstm_out_unit(Frame& F, int u) {
    const int bh = u >> 6, sc = u & 63, b = bh >> 2, h = bh & 3;
    const int n0 = b * SEQ + sc * 256;
    LAS unsigned char* Ks = F.lds + ML_K; LAS unsigned char* Vs = F.lds + ML_V; LAS unsigned char* Cs = F.lds + ML_C;
    LAS float* Bc = (LAS float*)(F.lds + ML_F); LAS float* cS = Bc + 256; LAS float* eB = Bc + 512; LAS float* nI = Bc + 768;
    const bf16_t* MK = WSP(bf16_t, WS_MK); const bf16_t* MV = WSP(bf16_t, WS_MV);
    u32x4 kreg[4], vreg[8]; f32x4 creg[2][2];
#pragma unroll
    for (int t = 0; t < 4; ++t) { const int c = F.tid + 512 * t, s = c >> 3, ch = c & 7; kreg[t] = *(const u32x4*)(MK + (size_t)(n0 + s) * 256 + h * 64 + ch * 8); }
#pragma unroll
    for (int t = 0; t < 8; ++t) { const int c = F.tid + 512 * t, s = c >> 4, ch = c & 15; vreg[t] = *(const u32x4*)(MV + (size_t)(n0 + s) * 512 + h * 128 + ch * 8); }
    { const float* CL = WSP(float, WS_CINIT) + (size_t)u * 8192;
#pragma unroll
      for (int t = 0; t < 2; ++t) { const int c = F.tid + 512 * t, dk = c >> 4, ch = c & 15; creg[t][0] = *(const f32x4*)(CL + dk * 128 + ch * 8); creg[t][1] = *(const f32x4*)(CL + dk * 128 + ch * 8 + 4); } }
    const float nIv = (F.tid < 64) ? WSP(float, WS_NINIT)[(size_t)u * 64 + F.tid] : 0.f;
    ml_gates(F, n0, h, Bc, cS);
    __syncthreads();
    if (F.tid < 256) { const float bt = Bc[F.tid]; const float iv = cS[F.tid]; eB[F.tid] = __expf(bt); __builtin_amdgcn_s_waitcnt(0); cS[F.tid] = (iv - bt) * LOG2E; Bc[F.tid] = bt * LOG2E; }
    if (F.tid < 64) nI[F.tid] = nIv;
#pragma unroll
    for (int t = 0; t < 4; ++t) { const int c = F.tid + 512 * t, s = c >> 3, ch = c & 7; *(LAS u32x4*)(Ks + s * KP + ch * 16) = kreg[t]; }
#pragma unroll
    for (int t = 0; t < 8; ++t) { const int c = F.tid + 512 * t, s = c >> 4, ch = c & 15; *(LAS u32x4*)(Vs + s * VP + ch * 16) = vreg[t]; }
#pragma unroll
    for (int t = 0; t < 2; ++t) { const int c = F.tid + 512 * t, dk = c >> 4, ch = c & 15; *(LAS u32x4*)(Cs + dk * VP + ch * 16) = pack8(creg[t][0], creg[t][1]); }
    __syncthreads();
    const int i = F.lane & 15, g = F.lane >> 4, w = F.wave;
    const bf16_t* MQ = WSP(bf16_t, WS_MQ); const bf16_t* MO = WSP(bf16_t, WS_MO);
    const GAS float* mg = INP(I_MNG) + h * 128;
    LAS unsigned char* ost = F.lds + ML_OST + w * 2176;
    float gnv[8];
#pragma unroll
    for (int dv = 0; dv < 8; ++dv) gnv[dv] = mg[16 * dv + i];
#pragma unroll 1
    for (int half = 0; half < 2; ++half) {
        const int rt = half == 0 ? w : 15 - w;
        const int tq = 16 * rt + i;
        bf16x8 qf[2];
#pragma unroll
        for (int ks = 0; ks < 2; ++ks) qf[ks] = *(const bf16x8*)(MQ + (size_t)(n0 + tq) * 256 + h * 64 + 32 * ks + 8 * g);
        u32x4 mo[2][2];
#pragma unroll
        for (int hf = 0; hf < 2; ++hf)
#pragma unroll
            for (int q = 0; q < 2; ++q) mo[hf][q] = *(const u32x4*)(MO + (size_t)(n0 + 16 * rt + (F.lane >> 3) + 8 * q) * 512 + h * 128 + 64 * hf + 8 * (F.lane & 7));
        f32x4 acc[8];
#pragma unroll
        for (int t = 0; t < 8; ++t) acc[t] = (f32x4){0.f, 0.f, 0.f, 0.f};
        float dni = 0.f;
#pragma unroll
        for (int ks = 0; ks < 2; ++ks) {
#pragma unroll
            for (int j = 0; j < 8; ++j) dni += bf2f((bf16_t)qf[ks][j]) * nI[32 * ks + 8 * g + j];
#pragma unroll
            for (int dv = 0; dv < 8; ++dv) {
                const LAS unsigned char* cp = Cs + (32 * ks + 8 * g + (i >> 2)) * VP + (16 * dv + 4 * (i & 3)) * 2;
                acc[dv] = MFMA16(qf[ks], cat4(trread(cp), trread(cp + 4 * VP)), acc[dv]);
            }
        }
        dni += __shfl_xor(dni, 16); dni += __shfl_xor(dni, 32);
        float den = dni * eB[tq];
        { float er[4];
#pragma unroll
          for (int r = 0; r < 4; ++r) er[r] = eB[16 * rt + 4 * g + r];
#pragma unroll
          for (int dv = 0; dv < 8; ++dv)
#pragma unroll
            for (int r = 0; r < 4; ++r) acc[dv][r] *= er[r]; }
        const float bt2 = Bc[tq];
        float dpart = 0.f;
        const int nks = (rt >> 1) + 1;
        for (int ks = 0; ks < nks; ++ks) {
            const int s0 = 32 * ks;
            f32x4 s0v = (f32x4){0.f, 0.f, 0.f, 0.f}, s1v = (f32x4){0.f, 0.f, 0.f, 0.f};
#pragma unroll
            for (int kk = 0; kk < 2; ++kk) {
                const bf16x8 k0 = *(const LAS bf16x8*)(Ks + (s0 + i) * KP + (32 * kk + 8 * g) * 2);
                const bf16x8 k1 = *(const LAS bf16x8*)(Ks + (s0 + 16 + i) * KP + (32 * kk + 8 * g) * 2);
                s0v = MFMA16(k0, qf[kk], s0v); s1v = MFMA16(k1, qf[kk], s1v);
            }
            const f32x4 c0 = *(const LAS f32x4*)(cS + s0 + 4 * g), c1 = *(const LAS f32x4*)(cS + s0 + 16 + 4 * g);
            f32x4 p0, p1;
#pragma unroll
            for (int r = 0; r < 4; ++r) {
                const int sa = s0 + 4 * g + r, sb = sa + 16;
                p0[r] = (sa <= tq) ? s0v[r] * __builtin_amdgcn_exp2f(bt2 + c0[r]) : 0.f;
                p1[r] = (sb <= tq) ? s1v[r] * __builtin_amdgcn_exp2f(bt2 + c1[r]) : 0.f;
                dpart += p0[r] + p1[r];
            }
            const u32x4 pw = pack8(p0, p1); const bf16x8 pa = __builtin_bit_cast(bf16x8, pw);
#pragma unroll
            for (int dv = 0; dv < 8; ++dv) {
                const LAS unsigned char* vp = Vs + (s0 + 4 * g + (i >> 2)) * VP + (16 * dv + 4 * (i & 3)) * 2;
                acc[dv] = MFMA16(pa, cat4(trread(vp), trread(vp + 16 * VP)), acc[dv]);
            }
        }
        dpart += __shfl_xor(dpart, 16); dpart += __shfl_xor(dpart, 32);
        den += dpart;
        float ss[4], dn[4];
#pragma unroll
        for (int r = 0; r < 4; ++r) { const float d = __shfl(den, 4 * g + r); dn[r] = __builtin_amdgcn_rcpf(fmaxf(fabsf(d), 1.0f)); ss[r] = 0.f; }
#pragma unroll
        for (int dv = 0; dv < 8; ++dv)
#pragma unroll
            for (int r = 0; r < 4; ++r) { acc[dv][r] *= dn[r]; ss[r] += acc[dv][r] * acc[dv][r]; }
#pragma unroll
        for (int r = 0; r < 4; ++r) { float s = ss[r]; s += __shfl_xor(s, 1); s += __shfl_xor(s, 2); s += __shfl_xor(s, 4); s += __shfl_xor(s, 8); ss[r] = __builtin_amdgcn_rsqf(s * (1.0f / 128.0f) + EPS); }
#pragma unroll
        for (int hf = 0; hf < 2; ++hf) {
#pragma unroll
            for (int dq = 0; dq < 4; ++dq) { const int dv = 4 * hf + dq;
#pragma unroll
                for (int r = 0; r < 4; ++r) *(LAS bf16_t*)(ost + (4 * g + r) * 136 + (16 * dq + i) * 2) = (bf16_t)f2bf(acc[dv][r] * ss[r] * gnv[dv]); }
            LDS_WAIT();
#pragma unroll
            for (int q = 0; q < 2; ++q) { const int row = (F.lane >> 3) + 8 * q, ch = F.lane & 7;
                const LAS unsigned* sp = (const LAS unsigned*)(ost + row * 136 + ch * 16);
                const u32x4 hv = (u32x4){sp[0], sp[1], sp[2], sp[3]};
                f32x4 a0, a1, m0, m1; unpack8(hv, a0, a1); unpack8(mo[hf][q], m0, m1);
                *(u32x4*)(WSP(bf16_t, WS_HM) + (size_t)(n0 + 16 * rt + row) * 512 + h * 128 + 64 * hf + 8 * ch) = pack8(a0 * m0, a1 * m1); }
            LDS_WAIT();
        }
    }
    __syncthreads();
}

struct AUnit { int b, grp, h, d, rc, qb, cont; };
__device__ __forceinline__ AUnit attn_decode(int u) { AUnit a; a.b = u / 1536; int r_ = u % 1536; a.grp = r_ / 512; r_ %= 512; a.h = r_ / 128; const int j = r_ % 128;
    a.d = a.grp == 0 ? 1 : (a.grp == 1 ? 4 : 16); const int nb = 128 / a.d; a.rc = j / nb; a.qb = j % nb; a.cont = 0; return a; }
__device__ __forceinline__ void attn_fetch(Frame& F, const AUnit& a, u32x4 (&kr)[4], u32x4 (&vr)[4], bf16x8 (&qf)[2]) {
    const bf16_t* AK = WSP(bf16_t, WS_AK); const bf16_t* AV = WSP(bf16_t, WS_AV); const bf16_t* AQ = WSP(bf16_t, WS_AQ);
    const size_t hoff = (size_t)a.grp * 256 + a.h * 64; const int kk0 = a.qb == 0 ? 128 : 0;
#pragma unroll
    for (int t = 0; t < 4; ++t) { const int c = F.tid + 512 * t, kk = c >> 3, ch = c & 7;
        kr[t] = (u32x4){0u, 0u, 0u, 0u}; vr[t] = kr[t];
        if (kk >= kk0 && !(a.cont && t < 2)) { const int tok = (128 * (a.qb - 1) + kk) * a.d + a.rc; const size_t o = (size_t)(a.b * SEQ + tok) * 768 + hoff + ch * 8; kr[t] = *(const u32x4*)(AK + o); vr[t] = *(const u32x4*)(AV + o); } }
    const int i = F.lane & 15, g = F.lane >> 4; const int tokq = (128 * a.qb + 16 * F.wave + i) * a.d + a.rc;
#pragma unroll
    for (int ks = 0; ks < 2; ++ks) qf[ks] = *(const bf16x8*)(AQ + (size_t)(a.b * SEQ + tokq) * 768 + hoff + 32 * ks + 8 * g);
}
__device__ __forceinline__ void attn_compute(Frame& F, const AUnit& a, const bf16x8 (&qf)[2]) {
    const int b = a.b, grp = a.grp, h = a.h, d = a.d, rc = a.rc, qb = a.qb;
    LAS unsigned char* Ks = F.lds; LAS unsigned char* Vs = F.lds + 256 * KP;
    const int kk0 = qb == 0 ? 128 : 0;
    const int i = F.lane & 15, g = F.lane >> 4, w = F.wave;
    const int qi = 16 * w + i;
    const int tokq = (128 * qb + qi) * d + rc;
    const float slope2 = exp2f(-8.0f * (float)(grp * 4 + h + 1) / 12.0f) * (float)d * LOG2E;
    const int slo = w >> 1;
    f32x4 s0v[5], s1v[5];
    float mx = -INFINITY;
    const int dbase = qi + 128 - 32 * slo - 4 * g;
    const float nb0 = -slope2 * (float)dbase;
#pragma unroll
    for (int si = 0; si < 5; ++si) {
        const int kb = 32 * (slo + si);
        const int pb = (((qb - 1 + (kb >> 7)) & 1) << 7) | (kb & 127);
        f32x4 a0, a1;
#pragma unroll
        for (int r = 0; r < 4; ++r) { a0[r] = nb0 + slope2 * (float)(32 * si + r); a1[r] = nb0 + slope2 * (float)(32 * si + r + 16); }
#pragma unroll
        for (int kk = 0; kk < 2; ++kk) {
            const bf16x8 k0 = *(const LAS bf16x8*)(Ks + (pb + i) * KP + (32 * kk + 8 * g) * 2);
            const bf16x8 k1 = *(const LAS bf16x8*)(Ks + (pb + 16 + i) * KP + (32 * kk + 8 * g) * 2);
            a0 = MFMA16(k0, qf[kk], a0); a1 = MFMA16(k1, qf[kk], a1);
        }
        if (si == 0 || si == 4 || kk0) {
#pragma unroll
            for (int r = 0; r < 4; ++r) {
                const int ka = kb + 4 * g + r, kc = ka + 16;
                const int da = dbase - 32 * si - r, dc = da - 16;
                if (!(da >= 0 && da <= 128 && ka >= kk0)) a0[r] = -INFINITY;
                if (!(dc >= 0 && dc <= 128 && kc >= kk0)) a1[r] = -INFINITY;
            }
        }
#pragma unroll
        for (int r = 0; r < 4; ++r) mx = fmaxf(mx, fmaxf(a0[r], a1[r]));
        s0v[si] = a0; s1v[si] = a1;
    }
    mx = fmaxf(mx, __shfl_xor(mx, 16)); mx = fmaxf(mx, __shfl_xor(mx, 32));
    float den = 0.f;
    f32x4 o[4];
#pragma unroll
    for (int t = 0; t < 4; ++t) o[t] = (f32x4){0.f, 0.f, 0.f, 0.f};
#pragma unroll
    for (int si = 0; si < 5; ++si) {
        const int kb = 32 * (slo + si);
        const int pb = (((qb - 1 + (kb >> 7)) & 1) << 7) | (kb & 127);
        f32x4 p0, p1;
#pragma unroll
        for (int r = 0; r < 4; ++r) { p0[r] = __builtin_amdgcn_exp2f(s0v[si][r] - mx); p1[r] = __builtin_amdgcn_exp2f(s1v[si][r] - mx); den += p0[r] + p1[r]; }
        const u32x4 pw = pack8(p0, p1); const bf16x8 pa = __builtin_bit_cast(bf16x8, pw);
#pragma unroll
        for (int dt = 0; dt < 4; ++dt) {
            const LAS unsigned char* vp = Vs + (pb + 4 * g + (i >> 2)) * KP + (16 * dt + 4 * (i & 3)) * 2;
            o[dt] = MFMA16(pa, cat4(trread(vp), trread(vp + 16 * KP)), o[dt]);
        }
    }
    den += __shfl_xor(den, 16); den += __shfl_xor(den, 32);
    if (g == 0) WSP(float, WS_LSE)[((size_t)grp * NTOK + b * SEQ + tokq) * 4 + h] = mx + __log2f(den);
    bf16_t* AO = WSP(bf16_t, WS_AO) + (size_t)grp * NTOK * 256;
    LAS unsigned char* ost = F.lds + 2 * 256 * KP + w * 2176;
#pragma unroll
    for (int r = 0; r < 4; ++r) {
        const float dn = __builtin_amdgcn_rcpf(__shfl(den, 4 * g + r));
#pragma unroll
        for (int dt = 0; dt < 4; ++dt) *(LAS bf16_t*)(ost + (4 * g + r) * 136 + (16 * dt + i) * 2) = (bf16_t)f2bf(o[dt][r] * dn);
    }
    LDS_WAIT();
#pragma unroll
    for (int q = 0; q < 2; ++q) { const int row = (F.lane >> 3) + 8 * q, ch = F.lane & 7;
        const LAS unsigned* sp = (const LAS unsigned*)(ost + row * 136 + ch * 16);
        const u32x4 hv = (u32x4){sp[0], sp[1], sp[2], sp[3]};
        const int tk = (128 * qb + 16 * w + row) * d + rc;
        *(u32x4*)(AO + (size_t)(b * SEQ + tk) * 256 + h * 64 + 8 * ch) = hv; }
    LDS_WAIT();
}
__device__ __forceinline__ void attn_phase(Frame& F) {
    LAS unsigned char* Ks = F.lds; LAS unsigned char* Vs = F.lds + 256 * KP;
    u32x4 k0[4], v0[4], k1[4], v1[4]; bf16x8 q0[2], q1[2], qc[2];
    const int per = (3072 + F.G - 1) / F.G; const int ub = F.vcu * per, ue = (ub + per < 3072) ? ub + per : 3072;
    int u = ub;
    if (u >= ue) return;
#define ATTN_DEC(A, U) do { A = attn_decode(U); A.cont = ((U) > ub && A.qb != 0) ? 1 : 0; } while (0)
    AUnit c0, c1; ATTN_DEC(c0, u); c1 = c0;
    attn_fetch(F, c0, k0, v0, q0);
    bool has1 = (u + 1) < ue;
    if (has1) { ATTN_DEC(c1, u + 1); attn_fetch(F, c1, k1, v1, q1); }
#define ATTN_STEP(KR, VR, QR, CU, UN) do { \
        _Pragma("unroll") for (int t = 0; t < 4; ++t) { const int c = F.tid + 512 * t, kk = c >> 3, ch = c & 7; \
            const int pr = (((CU.qb - 1 + (kk >> 7)) & 1) << 7) | (kk & 127); \
            if (!(CU.cont && t < 2)) { *(LAS u32x4*)(Ks + pr * KP + ch * 16) = KR[t]; *(LAS u32x4*)(Vs + pr * KP + ch * 16) = VR[t]; } } \
        qc[0] = QR[0]; qc[1] = QR[1]; \
        __syncthreads(); \
        const AUnit cur_ = CU; const int un_ = (UN); const bool hn_ = un_ < ue; \
        if (hn_) { ATTN_DEC(CU, un_); attn_fetch(F, CU, KR, VR, QR); } \
        attn_compute(F, cur_, qc); \
        __syncthreads(); } while (0)
    for (;;) {
        ATTN_STEP(k0, v0, q0, c0, u + 2);
        if (!has1) break;
        ATTN_STEP(k1, v1, q1, c1, u + 3);
        u += 2;
        if (u >= ue) break;
        has1 = (u + 1) < ue;
    }
#undef ATTN_STEP
#undef ATTN_DEC
}

__device__ __forceinline__ void attn_merge(Frame& F) {
    const int gt = F.vcu * 512 + F.tid, NT = F.G * 512;
    const float* LSE = WSP(float, WS_LSE); const bf16_t* AO = WSP(bf16_t, WS_AO);
    for (int idx = gt; idx < NTOK * 32; idx += NT) {
        const int n = idx >> 5, ch = idx & 31, h = ch >> 3;
        const float l0 = LSE[((size_t)0 * NTOK + n) * 4 + h], l1 = LSE[((size_t)1 * NTOK + n) * 4 + h], l2 = LSE[((size_t)2 * NTOK + n) * 4 + h];
        const float m = fmaxf(l0, fmaxf(l1, l2));
        float w0 = __builtin_amdgcn_exp2f(l0 - m), w1 = __builtin_amdgcn_exp2f(l1 - m), w2 = __builtin_amdgcn_exp2f(l2 - m);
        const float inv = 1.0f / (w0 + w1 + w2); w0 *= inv; w1 *= inv; w2 *= inv;
        f32x4 a0, a1, b0, b1, c0, c1;
        unpack8(*(const u32x4*)(AO + ((size_t)0 * NTOK + n) * 256 + ch * 8), a0, a1);
        unpack8(*(const u32x4*)(AO + ((size_t)1 * NTOK + n) * 256 + ch * 8), b0, b1);
        unpack8(*(const u32x4*)(AO + ((size_t)2 * NTOK + n) * 256 + ch * 8), c0, c1);
        *(u32x4*)(WSP(bf16_t, WS_HA) + (size_t)n * 512 + ch * 8) = pack8(a0 * w0 + b0 * w1 + c0 * w2, a1 * w0 + b1 * w1 + c1 * w2);
    }
}

__device__ __forceinline__ void route_phase(Frame& F) {
    constexpr int WP = 2064;
    LAS unsigned char* WRs = F.lds;
    LAS int* lcnt = (LAS int*)(F.lds + 32 * WP); LAS int* lbase = lcnt + 32;
    const int i = F.lane & 15, g = F.lane >> 4, w = F.wave;
    const bf16_t* X1B = WSP(bf16_t, WS_X1B); const bf16_t* WR = WSP(bf16_t, WS_WR);
    bool staged = false;
    for (int blk = F.vcu; blk < NTOK / 128; blk += F.G) {
        const int row0 = blk * 128 + 16 * w;
        bf16x8 af[32];
#pragma unroll
        for (int ks = 0; ks < 32; ++ks) af[ks] = *(const bf16x8*)(X1B + (size_t)(row0 + i) * DM + 32 * ks + 8 * g);
        if (!staged) { for (int c = F.tid; c < 32 * 128; c += 512) { const int e = c >> 7, ch = c & 127; *(LAS u32x4*)(WRs + e * WP + ch * 16) = *(const u32x4*)(WR + (size_t)e * DM + ch * 8); } staged = true; }
        if (F.tid < 32) lcnt[F.tid] = 0;
        __syncthreads();
        float ssq;
        { const f32x4* sp = (const f32x4*)(WSP(float, WS_SSQ) + (size_t)(row0 + i) * 16); const f32x4 a = sp[0], b = sp[1], c = sp[2], d4 = sp[3];
          ssq = (a[0] + a[1] + a[2] + a[3]) + (b[0] + b[1] + b[2] + b[3]) + (c[0] + c[1] + c[2] + c[3]) + (d4[0] + d4[1] + d4[2] + d4[3]); }
        const float rstd = __builtin_amdgcn_rsqf(ssq * (1.0f / DM) + EPS);
        f32x4 acc[2]; acc[0] = (f32x4){0.f, 0.f, 0.f, 0.f}; acc[1] = acc[0];
#pragma unroll
        for (int ks = 0; ks < 32; ++ks) {
            const bf16x8 b0 = *(const LAS bf16x8*)(WRs + i * WP + (32 * ks + 8 * g) * 2);
            const bf16x8 b1 = *(const LAS bf16x8*)(WRs + (16 + i) * WP + (32 * ks + 8 * g) * 2);
            acc[0] = MFMA16(af[ks], b0, acc[0]); acc[1] = MFMA16(af[ks], b1, acc[1]);
        }
        const float br0 = INP(I_BR)[i], br1 = INP(I_BR)[16 + i];
        float tv[4][4]; int ti[4][4];
#pragma unroll
        for (int r = 0; r < 4; ++r) {
            const float rs = __shfl(rstd, 4 * g + r);
            float v0 = rs * acc[0][r] + br0, v1 = rs * acc[1][r] + br1;
#pragma unroll
            for (int k = 0; k < 4; ++k) {
                float bv = v0; int bi = i; if (v1 > bv) { bv = v1; bi = 16 + i; }
#pragma unroll
                for (int o = 1; o < 16; o <<= 1) { const float ov = __shfl_xor(bv, o); const int oi = __shfl_xor(bi, o); if (ov > bv || (ov == bv && oi < bi)) { bv = ov; bi = oi; } }
                tv[r][k] = bv; ti[r][k] = bi;
                if (bi == i) v0 = -INFINITY; if (bi == 16 + i) v1 = -INFINITY;
            }
        }
        float mv = 0.f, ssum = 0.f; int me = 0;
#pragma unroll
        for (int r = 0; r < 4; ++r) {
            const float e0 = 1.0f, e1 = __expf(tv[r][1] - tv[r][0]), e2 = __expf(tv[r][2] - tv[r][0]), e3 = __expf(tv[r][3] - tv[r][0]);
            const float s = e0 + e1 + e2 + e3;
            if ((i >> 2) == r) { ssum = s;
                const int k = i & 3; mv = k == 0 ? e0 : (k == 1 ? e1 : (k == 2 ? e2 : e3)); me = k == 0 ? ti[r][0] : (k == 1 ? ti[r][1] : (k == 2 ? ti[r][2] : ti[r][3])); }
        }
        const float gate = mv / ssum;
        const int tok = row0 + 4 * g + (i >> 2);
        const float myrstd = __shfl(rstd, 4 * g + (i >> 2));
        const int rank = __hip_atomic_fetch_add(lcnt + me, 1, __ATOMIC_RELAXED, __HIP_MEMORY_SCOPE_WORKGROUP);
        __syncthreads();
        if (F.tid < 32) lbase[F.tid] = (int)__hip_atomic_fetch_add(WSP(unsigned, WS_CTL) + CW_CNT + F.tid, (unsigned)lcnt[F.tid], RLX_AGENT);
        __syncthreads();
        const int pos = lbase[me] + rank;
        WSP(int, WS_TOPE)[(size_t)tok * 4 + (i & 3)] = me;
        WSP(int, WS_TOPPOS)[(size_t)tok * 4 + (i & 3)] = pos;
        WSP(int, WS_LIST)[(size_t)me * NTOK + pos] = tok;
        WSP(float, WS_GLIST)[(size_t)me * NTOK + pos] = gate;
        WSP(float, WS_SRSTD)[(size_t)me * NTOK + pos] = myrstd;
        __syncthreads();
    }
}

__device__ __forceinline__ void combine_phase(Frame& F) {
    const LAS int* tab = (const LAS int*)(F.lds + TAB_OFF);
    const int gw = F.vcu * 8 + F.wave, NGW = F.G * 8;
    const unsigned char* Y2 = F.ws + WS_Y2;
    const int c = F.lane * 16;
    for (int n0 = gw * 2; n0 < NTOK; n0 += NGW * 2) {
        size_t ro[2][4];
#pragma unroll
        for (int t = 0; t < 2; ++t) { const u32x4 ev = *(const u32x4*)(WSP(int, WS_TOPE) + (size_t)(n0 + t) * 4), pv = *(const u32x4*)(WSP(int, WS_TOPPOS) + (size_t)(n0 + t) * 4);
#pragma unroll
            for (int k = 0; k < 4; ++k) ro[t][k] = (size_t)(tab[40 + (int)ev[k]] + (int)pv[k]) * 1024 + c; }
        f32x4 s[2][4]; u32x4 y[2][4];
#pragma unroll
        for (int t = 0; t < 2; ++t) {
            { const bf16_t* xb = WSP(bf16_t, WS_X1B) + (size_t)(n0 + t) * DM + c; unpack8(*(const u32x4*)xb, s[t][0], s[t][1]); unpack8(*(const u32x4*)(xb + 8), s[t][2], s[t][3]); }
#pragma unroll
            for (int k = 0; k < 4; ++k) y[t][k] = *(const u32x4*)(Y2 + ro[t][k]); }
#pragma unroll
        for (int t = 0; t < 2; ++t) {
            f32x4 m4[4];
#pragma unroll
            for (int q = 0; q < 4; ++q) m4[q] = (f32x4){0.f, 0.f, 0.f, 0.f};
#pragma unroll
            for (int k = 0; k < 4; ++k)
#pragma unroll
                for (int q = 0; q < 4; ++q) { const f32x2 lo = __builtin_amdgcn_cvt_pk_f32_fp8((int)y[t][k][q], false), hi = __builtin_amdgcn_cvt_pk_f32_fp8((int)y[t][k][q], true);
                    m4[q][0] += lo[0]; m4[q][1] += lo[1]; m4[q][2] += hi[0]; m4[q][3] += hi[1]; }
#pragma unroll
            for (int q = 0; q < 4; ++q) *(f32x4*)(F.out + (size_t)(n0 + t) * DM + c + 4 * q) = s[t][q] + m4[q] * 0.0625f; }
    }
}

__global__ void __launch_bounds__(512, 2) hyb_fwd(Args args) {
    extern __shared__ __attribute__((aligned(16))) unsigned char lds[];
    Frame F;
    F.lds = (LAS unsigned char*)lds;
    F.tid = threadIdx.x; F.lane = F.tid & 63; F.wave = __builtin_amdgcn_readfirstlane(F.tid >> 6);
#define REFRESH_IDS() do { } while (0)
    F.G = gridDim.x; { const int bx = blockIdx.x; F.vcu = (F.G % 8 == 0) ? (bx % 8) * (F.G / 8) + bx / 8 : bx; }
    F.ap = (KArgP)__builtin_amdgcn_kernarg_segment_ptr(); F.out = args.out; F.ws = args.ws;
    volatile LAS unsigned* MISC = (volatile LAS unsigned*)(F.lds + MISC_OFF);
    for (int u = F.tid; u < 32; u += 512) MISC[u] = 0u;
    __syncthreads();
    const int lo = args.ph_lo, hi = args.ph_hi & 255, variant = args.ph_hi >> 8;
    XcdBarrier bar; bar.bar = WSP(unsigned, WS_CTL) + CW_BAR; bar.x = 0; bar.st = nullptr;
    if (hi - lo > 1) bar = xcd_barrier_post(WSP(unsigned, WS_CTL) + CW_BAR, MISC + 8, F.tid == 0);
#define IN(k) (lo <= (k) && (k) < hi)
#define SEAM(k) do { if (IN(k) && IN((k) + 1)) { REFRESH_IDS(); xcd_barrier(bar, F.tid == 0); } REFRESH_IDS(); } while (0)

    if (IN(0)) { p0_prologue(F); } SEAM(0);

    if (IN(1)) {
        { SchedInProj S; S.T.init(NTOK / 256, FP8_FROM, F.G, (int)blockIdx.x); S.A = (const char*)WSP(bf16_t, WS_XN); S.B = (const char*)WSP(bf16_t, WS_WIN);
          EpiInProj E{F.ws, INP(I_AQG), INP(I_AKG), 1.0f};
          g8::gemm_phase<EpiInProj, SchedInProj, false>(F.lds, S, E, 2048u, 2048u, F.tid, F.wave); }
        { SchedInProj8 S; S.T.init(NTOK / 256, 23 - FP8_FROM, F.G, (int)blockIdx.x, WGM_P1B); S.A = (const char*)(F.ws + WS_XN8); S.B = (const char*)(F.ws + WS_WIN8);
          EpiInProj E{F.ws, INP(I_AQG), INP(I_AKG), 0.03125f};
          g8::gemm_phase<EpiInProj, SchedInProj8, true, 1>(F.lds, S, E, 1024u, 1024u, F.tid, F.wave); }
    } SEAM(1);

    if (IN(2)) {
        if (variant != 2) for (int u = F.vcu; u < 512; u += F.G) mlstm_state_unit(F, u);
        if (variant != 1) attn_phase(F);
    } SEAM(2);

    if (IN(3)) { mlstm_scan(F); } SEAM(3);

    if (IN(4)) {
        for (int u = F.vcu; u < 512; u += F.G) mlstm_out_unit(F, u);
        attn_merge(F);
    } SEAM(4);

    if (IN(5)) {
        SchedBranch S; S.T.init(NTOK / 256, 4, F.G, (int)blockIdx.x);
        S.A0 = (const char*)WSP(bf16_t, WS_HM); S.B0 = (const char*)WSP(bf16_t, WS_WM); S.A1 = (const char*)WSP(bf16_t, WS_HA); S.B1 = (const char*)WSP(bf16_t, WS_WA);
        EpiBranch E{WSP(bf16_t, WS_GM), WSP(bf16_t, WS_GA), WSP(bf16_t, WS_Y)};
        g8::gemm_phase<EpiBranch, SchedBranch, false>(F.lds, S, E, 1024u, 1024u, F.tid, F.wave);
    } SEAM(5);

    if (IN(6)) {
        SchedWout S; S.T.init(NTOK / 256, 4, F.G, (int)blockIdx.x); S.A = (const char*)WSP(bf16_t, WS_Y); S.B = (const char*)WSP(bf16_t, WS_WO);
        EpiWout E{INP(I_X), WSP(bf16_t, WS_X1B), F.ws + WS_X1F8, WSP(float, WS_SSQ)};
        g8::gemm_phase<EpiWout, SchedWout, false>(F.lds, S, E, 2048u, 2048u, F.tid, F.wave);
    } SEAM(6);

    if (IN(7)) { route_phase(F); } SEAM(7);

    if (IN(8)) {
        moe_tables(F);
        const LAS int* tab = (const LAS int*)(F.lds + TAB_OFF);
        SchedMoe<8, true> S; S.T.init(__builtin_amdgcn_readfirstlane(tab[32]), 8, F.G, (int)blockIdx.x, WGM_P8); S.tab = tab; S.A = (const char*)(F.ws + WS_X1F8); S.B = (const char*)(F.ws + WS_W1); S.LIST = WSP(int, WS_LIST);
        EpiMoe1 E{WSP(float, WS_SRSTD), INP(I_B1), F.ws + WS_H};
        g8::gemm_phase<EpiMoe1, SchedMoe<8, true>, true, 1, G8_LATE_MOE>(F.lds, S, E, 1024u, 1024u, F.tid, F.wave);
    } SEAM(8);

    if (IN(9)) {
        if (lo == 9) moe_tables(F);
        const LAS int* tab = (const LAS int*)(F.lds + TAB_OFF);
        SchedMoe<4, false> S; S.T.init(__builtin_amdgcn_readfirstlane(tab[32]), 4, F.G, (int)blockIdx.x, WGM_P9); S.tab = tab; S.A = (const char*)(F.ws + WS_H); S.B = (const char*)(F.ws + WS_W2); S.LIST = WSP(int, WS_LIST);
        EpiMoe2 E{WSP(float, WS_GLIST), INP(I_B2), F.ws + WS_Y2};
        g8::gemm_phase<EpiMoe2, SchedMoe<4, false>, true, 1, G8_LATE_MOE>(F.lds, S, E, 1024u, 1024u, F.tid, F.wave);
    } SEAM(9);

    if (IN(10)) { if (lo == 10) moe_tables(F); combine_phase(F); }
#undef IN
#undef SEAM
}

extern "C" void kernel_launch(void* const* d_in, const int* in_sizes, int n_in, void* d_out, int out_size, void* d_ws, size_t ws_size, hipStream_t stream) {
    static int grid = 0;
    if (grid == 0) {
        if (n_in != 17 || out_size != NTOK * DM || ws_size < WS_NEED) { fprintf(stderr, "kernel_launch: unexpected problem (n_in %d, out %d, ws %zu, need %zu)\n", n_in, out_size, ws_size, (size_t)WS_NEED); grid = -1; return; }
        int dev = 0, cus = 0;
        if (hipGetDevice(&dev) != hipSuccess || hipDeviceGetAttribute(&cus, hipDeviceAttributeMultiprocessorCount, dev) != hipSuccess) { grid = -1; return; }
        if (hipFuncSetAttribute((const void*)hyb_fwd, hipFuncAttributeMaxDynamicSharedMemorySize, LDS_BYTES) != hipSuccess) { fprintf(stderr, "kernel_launch: hipFuncSetAttribute failed\n"); grid = -1; return; }
        int per_cu = 0;
        if (hipOccupancyMaxActiveBlocksPerMultiprocessor(&per_cu, (const void*)hyb_fwd, 512, LDS_BYTES) != hipSuccess || per_cu < 1) fprintf(stderr, "kernel_launch: occupancy query reports %d\n", per_cu);
        (void)hipGetLastError();
        grid = cus;
    }
    if (grid < 0) return;
    (void)hipMemsetAsync((char*)d_ws + WS_CTL, 0, CTL_ZERO_BYTES, stream);
    Args a{};
    for (int i = 0; i < 17; ++i) a.in[i] = (const float*)d_in[i];
    a.out = (float*)d_out; a.ws = (unsigned char*)d_ws;
    if (MK_N_LAUNCHES == 1) { a.ph_lo = 0; a.ph_hi = NPH; hipLaunchKernelGGL(hyb_fwd, dim3(grid), dim3(512), LDS_BYTES, stream, a); }
    else { for (int p = 0; p < (MAXPH < NPH ? MAXPH : NPH); ++p) { a.ph_lo = p; a.ph_hi = p + 1;
            if (p == DUP_PHASE && p == 7) { hipLaunchKernelGGL(hyb_fwd, dim3(grid), dim3(512), LDS_BYTES, stream, a); (void)hipMemsetAsync((char*)d_ws + WS_CTL + CW_CNT * 4, 0, 128, stream); }
            hipLaunchKernelGGL(hyb_fwd, dim3(grid), dim3(512), LDS_BYTES, stream, a);
            if (p == DUP_PHASE && p == 10) { Args a2 = a; a2.out = (float*)((unsigned char*)d_ws + WS_H); hipLaunchKernelGGL(hyb_fwd, dim3(grid), dim3(512), LDS_BYTES, stream, a2); }
            else if (p == DUP_PHASE && p != 7) { Args a2 = a; a2.ph_hi = a.ph_hi + 256 * DUP_VARIANT; hipLaunchKernelGGL(hyb_fwd, dim3(grid), dim3(512), LDS_BYTES, stream, a2); } } }
}
```

```cpp
#include <hip/hip_runtime.h>
#include <cstdio>
#include <cstdint>

#ifndef MK_N_LAUNCHES
#define MK_N_LAUNCHES 1
#endif

#ifndef MAXPH
#define MAXPH 99
#endif
#ifndef DUP_PHASE
#define DUP_PHASE -1
#endif
#ifndef DUP_VARIANT
#define DUP_VARIANT 0
#endif
#define LAS __attribute__((address_space(3)))
#define GAS __attribute__((address_space(1)))
typedef unsigned short bf16_t;
typedef short bf16x8 __attribute__((ext_vector_type(8)));
typedef short s16x4 __attribute__((ext_vector_type(4)));
typedef float f32x4 __attribute__((ext_vector_type(4)));
typedef float f32x2 __attribute__((ext_vector_type(2)));
typedef unsigned u32x4 __attribute__((ext_vector_type(4)));
typedef unsigned u32x2 __attribute__((ext_vector_type(2)));
typedef int v8i_t __attribute__((ext_vector_type(8)));
typedef int v4i_t __attribute__((ext_vector_type(4)));
template <int MODE> struct FragT { typedef bf16x8 type; };
template <> struct FragT<1> { typedef v4i_t type; };

constexpr int NTOK = 32768, SEQ = 16384, DM = 1024;
constexpr int NEXP = 32, DFF = 1024;
constexpr float EPS = 1e-6f;
constexpr float LOG2E = 1.4426950408889634f;
constexpr int NPH = 11;

constexpr size_t MiB = 1u << 20;
constexpr size_t WS_CTL = 0, CTL_ZERO_BYTES = 1 * MiB;
constexpr size_t WS_GATES = 1 * MiB;
constexpr size_t WS_SSQ = 2 * MiB;
constexpr size_t WS_LSE = 4 * MiB;
constexpr size_t WS_TOPE = 6 * MiB;
constexpr size_t WS_TOPPOS = 7 * MiB;
constexpr size_t WS_LIST = 8 * MiB;
constexpr size_t WS_GLIST = 12 * MiB;
constexpr size_t WS_SRSTD = 16 * MiB;
constexpr size_t WS_MSTAT = 20 * MiB;
constexpr size_t WS_RSTD1 = 20 * MiB + 512 * 1024;
constexpr size_t WS_WIN = 21 * MiB;
constexpr size_t WS_WM = 33 * MiB;
constexpr size_t WS_WA = 34 * MiB;
constexpr size_t WS_WO = 35 * MiB;
constexpr size_t WS_WR = 37 * MiB;
constexpr size_t WS_W1 = 38 * MiB;
constexpr size_t WS_W2 = 102 * MiB;
constexpr size_t WS_X1B = 134 * MiB;
constexpr size_t WS_X1F8 = 198 * MiB;
constexpr size_t WS_OVL = 230 * MiB;
constexpr size_t WS_XN = WS_OVL;
constexpr size_t WS_MQ = WS_XN + 64 * MiB;
constexpr size_t WS_MK = WS_MQ + 16 * MiB;
constexpr size_t WS_MV = WS_MK + 16 * MiB;
constexpr size_t WS_MO = WS_MV + 32 * MiB;
constexpr size_t WS_AQ = WS_MO + 32 * MiB;
constexpr size_t WS_AK = WS_AQ + 48 * MiB;
constexpr size_t WS_AV = WS_AK + 48 * MiB;
constexpr size_t WS_GM = WS_AV + 48 * MiB;
constexpr size_t WS_GA = WS_GM + 64 * MiB;
constexpr size_t WS_CLOC = WS_GA + 64 * MiB;
constexpr size_t WS_HM = WS_CLOC + 16 * MiB;
constexpr size_t WS_AO = WS_HM + 32 * MiB;
constexpr size_t WS_HA = WS_AO + 48 * MiB;
constexpr size_t WS_Y = WS_HA + 32 * MiB;
constexpr size_t WS_CINIT = WS_Y + 64 * MiB;
constexpr size_t WS_NINIT = WS_CINIT + 16 * MiB;
constexpr size_t WS_XN8 = WS_NINIT + 1 * MiB;
constexpr size_t WS_WIN8 = WS_XN8 + 32 * MiB;
constexpr size_t WS_END1 = WS_WIN8 + 6 * MiB;
constexpr size_t WS_H = WS_OVL;
constexpr size_t WS_Y2 = WS_OVL + 130 * MiB;
constexpr size_t WS_END2 = WS_Y2 + 256 * MiB;
constexpr size_t WS_NEED = (WS_END1 > WS_END2 ? WS_END1 : WS_END2);

constexpr int CW_CNT = 64;
constexpr int CW_BAR = 4096;

constexpr int RING_BYTES = 131072;
constexpr int TAB_OFF = RING_BYTES;
constexpr int ROWBUF_OFF = RING_BYTES + 1024;
constexpr int TAB_OFF_UNUSED = 0;
constexpr int LDS_BYTES = 163840;
constexpr int MISC_OFF = LDS_BYTES - 256;

#define LOG2E_ 1.4426950408889634f
#define LDS_WAIT() asm volatile("s_waitcnt lgkmcnt(0)" ::: "memory")
#define VM_WAIT() asm volatile("s_waitcnt vmcnt(0)" ::: "memory")
__device__ __forceinline__ unsigned f2bf(float f) { unsigned u = __builtin_bit_cast(unsigned, f); return (u + 0x7fffu + ((u >> 16) & 1u)) >> 16; }
typedef __bf16 bf16x2_hw __attribute__((ext_vector_type(2)));
__device__ __forceinline__ unsigned pk2(float lo, float hi) { const f32x2 v = {lo, hi}; return __builtin_bit_cast(unsigned, __builtin_convertvector(v, bf16x2_hw)); }
__device__ __forceinline__ float bflo(unsigned w) { return __builtin_bit_cast(float, w << 16); }
__device__ __forceinline__ float bfhi(unsigned w) { return __builtin_bit_cast(float, w & 0xffff0000u); }
__device__ __forceinline__ float bf2f(bf16_t h) { return __builtin_bit_cast(float, (unsigned)h << 16); }
__device__ __forceinline__ float sigmoidf_(float x) { return __builtin_amdgcn_rcpf(1.0f + __builtin_amdgcn_exp2f(-LOG2E_ * x)); }
__device__ __forceinline__ u32x4 pack8(const f32x4 a, const f32x4 b) { u32x4 w; w.x = pk2(a[0], a[1]); w.y = pk2(a[2], a[3]); w.z = pk2(b[0], b[1]); w.w = pk2(b[2], b[3]); return w; }
__device__ __forceinline__ void unpack8(const u32x4 w, f32x4& a, f32x4& b) { a[0] = bflo(w.x); a[1] = bfhi(w.x); a[2] = bflo(w.y); a[3] = bfhi(w.y); b[0] = bflo(w.z); b[1] = bfhi(w.z); b[2] = bflo(w.w); b[3] = bfhi(w.w); }
__device__ __forceinline__ u32x2 pack8_fp8(const f32x4 a, const f32x4 b) { int w0 = 0, w1 = 0;
    w0 = __builtin_amdgcn_cvt_pk_fp8_f32(a[0], a[1], w0, false); w0 = __builtin_amdgcn_cvt_pk_fp8_f32(a[2], a[3], w0, true);
    w1 = __builtin_amdgcn_cvt_pk_fp8_f32(b[0], b[1], w1, false); w1 = __builtin_amdgcn_cvt_pk_fp8_f32(b[2], b[3], w1, true); return (u32x2){(unsigned)w0, (unsigned)w1}; }
#ifndef ST_WT
#define ST_WT 0
#endif
__device__ __forceinline__ void st16(void* p, const u32x4 v) {
#if ST_WT
    asm volatile("global_store_dwordx4 %0, %1, off sc1\n\ts_nop 1" :: "v"(p), "v"(v) : "memory");
#else
    *(u32x4*)p = v;
#endif
}
typedef short v4i16_t __attribute__((ext_vector_type(4)));
__device__ __forceinline__ s16x4 trread(const LAS unsigned char* p) { return __builtin_bit_cast(s16x4, __builtin_amdgcn_ds_read_tr16_b64_v4i16((LAS v4i16_t*)p)); }
__device__ __forceinline__ bf16x8 cat4(s16x4 lo, s16x4 hi) { return (bf16x8){lo[0], lo[1], lo[2], lo[3], hi[0], hi[1], hi[2], hi[3]}; }
#define MFMA16(a, b, c) __builtin_amdgcn_mfma_f32_16x16x32_bf16((a), (b), (c), 0, 0, 0)

namespace g8 {
#ifndef G8_LATE_MOE
#define G8_LATE_MOE false
#endif
#ifndef G8_LATE_BF
#define G8_LATE_BF false
#endif
#ifndef FP8_FROM
#define FP8_FROM 4
#endif
#ifndef G8_WGM
#define G8_WGM 4
#endif
constexpr int BM = 256, BK = 64, HALF = 128, HTB = HALF * BK * 2, NXCD = 8, WGM = G8_WGM;
__device__ __forceinline__ int lds_byte(int r, int c) { const int st = (r >> 4) * 2 + (c >> 5), rr = r & 15, cc = c & 31, ob = rr * 64 + cc * 2; return st * 1024 + (ob ^ (((ob >> 9) & 1) << 5)); }
__device__ __forceinline__ void stage_rc(int b, int& R, int& C) { const int st = b / 1024, sb = b % 1024, swz = sb ^ (((sb >> 9) & 1) << 5); R = (st >> 1) * 16 + swz / 64; C = (st & 1) * 32 + (swz % 64) / 2; }
__device__ __forceinline__ int perm32(int rho) { const int n = rho >> 4, i = rho & 15; return 8 * (i >> 2) + 4 * n + (i & 3); }

struct GUnit { const char* A; const char* B; int nt; int pm, pn, sel, e, rt, x, y; };

struct TileOrder {
    int nM, nN, nwg, G, c;
    __device__ __forceinline__ void init(int nM_, int nN_, int G_, int c_) { nM = nM_; nN = nN_; nwg = nM * nN; G = G_; c = c_; }
    __device__ __forceinline__ bool tile(int i, int& pm, int& pn) const {
        const long L = (long)i * G + c; if (L >= nwg) return false;
        int wgid = (int)L; { const int q = nwg / NXCD, r = nwg % NXCD, xcd = wgid % NXCD, off = wgid / NXCD; wgid = (xcd < r ? xcd * (q + 1) : r * (q + 1) + (xcd - r) * q) + off; }
        const int nig = WGM * nN, gid = wgid / nig, fm = gid * WGM, gsz = (nM - fm) < WGM ? (nM - fm) : WGM;
        pm = fm + ((wgid % nig) % gsz); pn = (wgid % nig) / gsz; return true;
    }
};

template <class Epi, class Sched, bool GATHER, int MODE = 0, bool LATE = false>
__device__ __forceinline__ void gemm_phase(LAS unsigned char* lds, const Sched& S, const Epi& E, const unsigned pitchA, const unsigned pitchB, const int tid, const int wid) {
    const int lane = tid & 63, wr = wid >> 2, wc = wid & 3, fr = lane & 15, fq = lane >> 4;
    unsigned voffB[2]; unsigned offC[2][2];
    LAS unsigned* rowbuf = (LAS unsigned*)(lds + ROWBUF_OFF);
#pragma unroll
    for (int i = 0; i < 2; ++i) { int R, C; stage_rc(tid * 16 + i * 8192, R, C); const int Rb = (R & ~31) + perm32(R & 31);
        voffB[i] = (unsigned)Rb * pitchB + (unsigned)C * 2u; }
    const unsigned hstepB = (unsigned)HALF * pitchB, hstepA = (unsigned)HALF * pitchA;
    const size_t kstep = (size_t)(BK * 2);
    const unsigned ldsw = (unsigned)wid * 1024u;
    const int aoff = lds_byte(wr * 64 + fr, fq * 8), boff = lds_byte(wc * 32 + fr, fq * 8);
#define G8_SA(b, h) (((b) * 2 + (h)) * HTB)
#define G8_SB(b, h) ((4 + (b) * 2 + (h)) * HTB)
#define G8_STAGE_B(bufoff, gbase, h) do { const char* _gp = (const char*)(gbase) + (h) * hstepB; asm volatile("" : "+s"(_gp)); _Pragma("unroll") for (int _i = 0; _i < 2; ++_i) \
        __builtin_amdgcn_global_load_lds((const unsigned*)(_gp + voffB[_i]), (LAS unsigned*)(lds + (bufoff) + ldsw + _i * 8192), 16, 0, 0); } while (0)
#define G8_STAGE_A(bufoff, gbase, hh) do { const char* _gp = (const char*)(gbase) + (GATHER ? 0u : (hh) * hstepA); asm volatile("" : "+s"(_gp)); const unsigned* offs = offC[GATHER ? (hh) : 0]; _Pragma("unroll") for (int _i = 0; _i < 2; ++_i) \
        __builtin_amdgcn_global_load_lds((const unsigned*)(_gp + (offs)[_i]), (LAS unsigned*)(lds + (bufoff) + ldsw + _i * 8192), 16, 0, 0); } while (0)
#define G8_LDA(dst, b, h) do { _Pragma("unroll") for (int m = 0; m < 4; ++m) _Pragma("unroll") for (int k = 0; k < 2; ++k) dst[m][k] = *(const LAS frag_t*)(lds + G8_SA(b, h) + aoff + m * 2048 + k * 1024); } while (0)
#define G8_LDB(dst, b, h) do { _Pragma("unroll") for (int n = 0; n < 2; ++n) _Pragma("unroll") for (int k = 0; k < 2; ++k) dst[n][k] = *(const LAS frag_t*)(lds + G8_SB(b, h) + boff + n * 2048 + k * 1024); } while (0)
#define G8_CAT(x) __builtin_shufflevector((x)[0], (x)[1], 0, 1, 2, 3, 4, 5, 6, 7)
#define G8_MMA(ai, bj, At, Bt) do { __builtin_amdgcn_s_setprio(1); _Pragma("unroll") for (int m = 0; m < 4; ++m) _Pragma("unroll") for (int n = 0; n < 2; ++n) { \
        if constexpr (MODE == 0) { _Pragma("unroll") for (int k = 0; k < 2; ++k) acc[ai][bj][m][n] = __builtin_amdgcn_mfma_f32_16x16x32_bf16(Bt[n][k], At[m][k], acc[ai][bj][m][n], 0, 0, 0); } \
        else { const v8i_t _b8 = G8_CAT(Bt[n]), _a8 = G8_CAT(At[m]); asm volatile("v_mfma_f32_16x16x128_f8f6f4 %0, %1, %2, %0" : "+v"(acc[ai][bj][m][n]) : "v"(_b8), "v"(_a8)); } } \
        __builtin_amdgcn_s_setprio(0); } while (0)
#define G8_SWITCH() do { if constexpr (GATHER) { if (last && has_next) { int t2_ = tid; asm volatile("" : "+v"(t2_)); \
        _Pragma("unroll") for (int h = 0; h < 2; ++h) _Pragma("unroll") for (int i = 0; i < 2; ++i) { int R_, C_; stage_rc(t2_ * 16 + i * 8192, R_, C_); offC[h][i] = S.arow_lds(nxt, h * HALF + R_, rowbuf) + (unsigned)C_ * 2u; } \
        asm volatile("s_waitcnt lgkmcnt(0)" : "+v"(offC[0][0]), "+v"(offC[0][1]), "+v"(offC[1][0]), "+v"(offC[1][1]) :: "memory"); } } } while (0)
#define G8_WAIT_V(n) asm volatile("s_waitcnt vmcnt(" #n ")" ::: "memory")
#define G8_WAIT_L(n) asm volatile("s_waitcnt lgkmcnt(" #n ")" ::: "memory")
#define G8_BAR __builtin_amdgcn_s_barrier()
#define G8_SCHED __builtin_amdgcn_sched_barrier(0)
    GUnit cur, nxt; int ui = 0;
    if (!S.next(0, cur)) return;
    f32x4 acc[2][2][4][2];
#pragma unroll
    for (int a = 0; a < 2; ++a)
#pragma unroll
        for (int b = 0; b < 2; ++b)
#pragma unroll
            for (int m = 0; m < 4; ++m)
#pragma unroll
                for (int n = 0; n < 2; ++n) acc[a][b][m][n] = (f32x4){0.f, 0.f, 0.f, 0.f};
    typedef typename FragT<MODE>::type frag_t;
    frag_t At[4][2], B0[2][2], B1[2][2];
    const char* cA = cur.A; const char* cB = cur.B;
#pragma unroll
    for (int h = 0; h < 2; ++h)
#pragma unroll
        for (int i = 0; i < 2; ++i) { int R, C; stage_rc(tid * 16 + i * 8192, R, C);
            if constexpr (GATHER) offC[h][i] = S.arow(cur, h * HALF + R) + (unsigned)C * 2u;
            else offC[h][i] = (unsigned)R * pitchA + (unsigned)C * 2u;
        }
    if constexpr (GATHER) { asm volatile("s_waitcnt vmcnt(0)" : "+v"(offC[0][0]), "+v"(offC[0][1]), "+v"(offC[1][0]), "+v"(offC[1][1]) :: "memory"); }
    E.aux_dma(cur, lds + ROWBUF_OFF + 1024, 0, wid, lane);
    G8_STAGE_B(G8_SB(0, 0), cB, 0); G8_STAGE_B(G8_SB(0, 1), cB, 1); G8_STAGE_A(G8_SA(0, 0), cA, 0); G8_STAGE_A(G8_SA(0, 1), cA, 1);
    if (wr == 1) G8_BAR;
    G8_WAIT_V(2); G8_BAR;
    G8_STAGE_B(G8_SB(1, 0), cB + kstep, 0); G8_STAGE_A(G8_SA(1, 0), cA + kstep, 0); G8_STAGE_B(G8_SB(1, 1), cB + kstep, 1);
    G8_WAIT_V(6); G8_BAR;
    for (;;) {
        const bool has_next = S.next(ui + 1, nxt);
        const char* nA = has_next ? nxt.A : cA; const char* nB = has_next ? nxt.B : cB;
        if constexpr (GATHER) { if (has_next) S.rows_dma(nxt, rowbuf, wid, lane); }
        const int nt = cur.nt;
#pragma unroll 1
        for (int t = 0; t < nt; t += 2) {
            const bool last = (t == nt - 2);
            const char* a1 = cA + (size_t)(t + 1) * kstep;
            const char* a2 = last ? nA : cA + (size_t)(t + 2) * kstep; const char* b2 = last ? nB : cB + (size_t)(t + 2) * kstep;
            const char* a3 = a2 + kstep; const char* b3 = b2 + kstep;
            if constexpr (!LATE) {
            G8_LDB(B0, 0, 0); G8_LDB(B1, 0, 1); G8_SCHED; G8_LDA(At, 0, 0); G8_STAGE_A(G8_SA(1, 1), a1, 1);
            G8_WAIT_V(8); G8_WAIT_L(0); G8_BAR; G8_MMA(0, 0, At, B0); G8_MMA(0, 1, At, B1); G8_BAR; G8_SCHED;
            G8_SWITCH();
            G8_LDA(At, 0, 1); G8_STAGE_B(G8_SB(0, 0), b2, 0); G8_STAGE_B(G8_SB(0, 1), b2, 1); G8_STAGE_A(G8_SA(0, 0), a2, 0);
            G8_WAIT_V(8); G8_WAIT_L(0); G8_BAR; G8_MMA(1, 0, At, B0); G8_MMA(1, 1, At, B1); G8_BAR; G8_SCHED;
            G8_LDB(B0, 1, 0); G8_LDB(B1, 1, 1); G8_SCHED; G8_LDA(At, 1, 0); G8_STAGE_A(G8_SA(0, 1), a2, 1);
            G8_WAIT_V(8); G8_WAIT_L(0); G8_BAR; G8_MMA(0, 0, At, B0); G8_MMA(0, 1, At, B1); G8_BAR; G8_SCHED;
            G8_LDA(At, 1, 1); G8_STAGE_B(G8_SB(1, 0), b3, 0); G8_STAGE_B(G8_SB(1, 1), b3, 1); G8_STAGE_A(G8_SA(1, 0), a3, 0);
            G8_WAIT_V(8); G8_WAIT_L(0); G8_BAR; G8_MMA(1, 0, At, B0); G8_MMA(1, 1, At, B1); G8_BAR; G8_SCHED;
            } else {
            G8_LDB(B0, 0, 0); G8_LDB(B1, 0, 1); G8_SCHED; G8_LDA(At, 0, 0);
            G8_WAIT_V(6); G8_WAIT_L(0); G8_BAR; G8_MMA(0, 0, At, B0); G8_SCHED; G8_STAGE_A(G8_SA(1, 1), a1, 1); G8_SCHED; G8_MMA(0, 1, At, B1); G8_BAR; G8_SCHED;
            G8_SWITCH();
            G8_LDA(At, 0, 1);
            G8_WAIT_V(2); G8_WAIT_L(0); G8_BAR; G8_MMA(1, 0, At, B0); G8_SCHED; G8_STAGE_B(G8_SB(0, 0), b2, 0); G8_STAGE_B(G8_SB(0, 1), b2, 1); G8_SCHED; G8_MMA(1, 1, At, B1); G8_SCHED; G8_STAGE_A(G8_SA(0, 0), a2, 0); G8_BAR; G8_SCHED;
            G8_LDB(B0, 1, 0); G8_LDB(B1, 1, 1); G8_SCHED; G8_LDA(At, 1, 0);
            G8_WAIT_V(6); G8_WAIT_L(0); G8_BAR; G8_MMA(0, 0, At, B0); G8_SCHED; G8_STAGE_A(G8_SA(0, 1), a2, 1); G8_SCHED; G8_MMA(0, 1, At, B1); G8_BAR; G8_SCHED;
            G8_LDA(At, 1, 1);
            G8_WAIT_V(2); G8_WAIT_L(0); G8_BAR; G8_MMA(1, 0, At, B0); G8_SCHED; G8_STAGE_B(G8_SB(1, 0), b3, 0); G8_STAGE_B(G8_SB(1, 1), b3, 1); G8_SCHED; G8_MMA(1, 1, At, B1); G8_SCHED; G8_STAGE_A(G8_SA(1, 0), a3, 0); G8_BAR; G8_SCHED;
            }
        }
        if (wr == 0) G8_BAR;
        if constexpr (MODE == 1) asm volatile("s_nop 15\n\ts_nop 15" ::: "memory");
        const bool keep = E(acc, cur, wr, wc, fr, fq, lds + ROWBUF_OFF + 1024, ui & 1);
        if (!has_next) break;
        E.aux_dma(nxt, lds + ROWBUF_OFF + 1024, (ui + 1) & 1, wid, lane);
        if (!keep) {
#pragma unroll
            for (int a = 0; a < 2; ++a)
#pragma unroll
                for (int b = 0; b < 2; ++b)
#pragma unroll
                    for (int m = 0; m < 4; ++m)
#pragma unroll
                        for (int n = 0; n < 2; ++n) acc[a][b][m][n] = (f32x4){0.f, 0.f, 0.f, 0.f};
        }
        cur = nxt; cA = nA; cB = nB; ++ui;
        if (wr == 1) G8_BAR;
    }
    G8_WAIT_V(0);
    G8_BAR;
#undef G8_SA
#undef G8_SB
#undef G8_STAGE_A
#undef G8_STAGE_B
#undef G8_LDA
#undef G8_LDB
#undef G8_MMA
#undef G8_CAT
#undef G8_WAIT_V
#undef G8_SWITCH
#undef G8_WAIT_L
#undef G8_BAR
#undef G8_SCHED
}
}

typedef GAS unsigned gu32;
#define RLX_AGENT __ATOMIC_RELAXED, __HIP_MEMORY_SCOPE_AGENT
#define XB_TMO      128
#define XB_XCNT(j)  (256  + 64 * (j))
#define XB_XSUB(j)  (1280 + 64 * (j))
#define XB_XGEN(j)  (2304 + 64 * (j))
#define XB_TOP      3328
#define XB_TOPGEN   3392
#define XCD_BAR_WORDS 3456
#define XB_SPIN_CAP (1u << 22)
__device__ __forceinline__ unsigned xb_ld(unsigned* p)              { return __hip_atomic_load(p, __ATOMIC_RELAXED, __HIP_MEMORY_SCOPE_AGENT); }
__device__ __forceinline__ unsigned xb_add(unsigned* p, unsigned v) { return __hip_atomic_fetch_add(p, v, __ATOMIC_RELAXED, __HIP_MEMORY_SCOPE_AGENT); }
__device__ __forceinline__ unsigned xb_xcc_id() { return (unsigned)__builtin_amdgcn_s_getreg((3 << 11) | 20) & 0xFu; }
#define XB_SPIN(cond, bar) do { unsigned _sp = 0; while (cond) { __builtin_amdgcn_s_sleep(1); \
    if ((++_sp & 255u) == 0u) { if (xb_ld(&(bar)[XB_TMO])) break; if (_sp > XB_SPIN_CAP) { atomicAdd(&(bar)[XB_TMO], 1u); break; } } } } while (0)
struct XcdBarrier { unsigned* bar; unsigned x; volatile LAS unsigned* st; };
__device__ __forceinline__ XcdBarrier xcd_barrier_post(unsigned* bar, volatile LAS unsigned* st, const bool t0) {
    XcdBarrier b; b.bar = bar; b.x = xb_xcc_id(); b.st = st;
    if (t0) (void)xb_add(&bar[XB_XCNT(b.x)], 1u);
    return b;
}
__device__ __forceinline__ void xcd_barrier_complete(unsigned* bar, unsigned x, unsigned& nloc, unsigned& nx) {
    const unsigned G = gridDim.x * gridDim.y * gridDim.z;
    unsigned sum, cnt, mine, sp = 0u;
    for (;;) {
        sum = 0u; cnt = 0u; mine = 0u;
#pragma unroll
        for (unsigned j = 0; j < 16; ++j) { const unsigned c = xb_ld(&bar[XB_XCNT(j)]); sum += c; cnt += (c > 0u) ? 1u : 0u; mine = (j == x) ? c : mine; }
        if (sum == G) break;
        __builtin_amdgcn_s_sleep(1);
        if ((++sp & 255u) == 0u) { if (xb_ld(&bar[XB_TMO])) break; if (sp > XB_SPIN_CAP) { atomicAdd(&bar[XB_TMO], 1u); break; } }
    }
    nloc = mine > 0u ? mine : 1u; nx = cnt > 0u ? cnt : 1u;
}
__device__ __forceinline__ void xcd_barrier(const XcdBarrier& b, const bool t0) {
    asm volatile("s_waitcnt vmcnt(0)" ::: "memory");
    __syncthreads();
    if (t0) {
        unsigned* bar = b.bar;
        __builtin_amdgcn_s_waitcnt(0);
        unsigned nloc = b.st[0], nx = b.st[1];
        if (nloc == 0u) { xcd_barrier_complete(bar, b.x, nloc, nx); b.st[0] = nloc; b.st[1] = nx; }
        const unsigned old = xb_add(&bar[XB_XSUB(b.x)], 1u);
        const unsigned gen = old / nloc;
        if (old + 1u == (gen + 1u) * nloc) {
            __builtin_amdgcn_fence(__ATOMIC_RELEASE, "agent");
            asm volatile("s_waitcnt vmcnt(0)" ::: "memory");
            const unsigned og = xb_add(&bar[XB_TOP], 1u);
            const unsigned tg = og / nx;
            if (og + 1u == (tg + 1u) * nx) xb_add(&bar[XB_TOPGEN], 1u);
            else XB_SPIN(xb_ld(&bar[XB_TOPGEN]) == tg, bar);
            __builtin_amdgcn_fence(__ATOMIC_ACQUIRE, "agent");
            xb_add(&bar[XB_XGEN(b.x)], 1u);
            asm volatile("s_waitcnt vmcnt(0)" ::: "memory");
        } else {
            XB_SPIN(xb_ld(&bar[XB_XGEN(b.x)]) == gen, bar);
            __builtin_amdgcn_fence(__ATOMIC_ACQUIRE, "agent");
            asm volatile("s_waitcnt vmcnt(0)" ::: "memory");
        }
    }
    __syncthreads();
}

struct Args { const float* in[17]; float* out; unsigned char* ws; int ph_lo, ph_hi; };
typedef const __attribute__((address_space(4))) Args* KArgP;
struct Frame {
    LAS unsigned char* lds;
    int tid, lane, wave, vcu, G;
    KArgP ap;
    float* out; unsigned char* ws;
};
#define INP(k) ((const GAS float*)F.ap->in[k])
enum { I_X = 0, I_N1G, I_WIN, I_GATEB, I_MNG, I_AQG, I_AKG, I_WMB, I_WAB, I_WOUT, I_N2G, I_WR, I_BR, I_W1, I_B1, I_W2, I_B2 };
#define WSP(T, off) ((T*)(F.ws + (off)))

__device__ __forceinline__ float wave_sum(float v) {
#pragma unroll
    for (int o = 1; o < 64; o <<= 1) v += __shfl_xor(v, o);
    return v;
}

struct TItem { const GAS float* src; const GAS float* scale; unsigned char* dst; int srcpitch, dstpitchB, r0, r1, fmt, half; };
__device__ __forceinline__ TItem titem_decode(Frame& F, int it) {
    constexpr int NI_IN = 92 * 16, NI_WM = 16 * 8, NI_WA = 16 * 4, NI_WO = 16 * 16, NI_WR = 16, NI_W1 = 32 * 32 * 16;
    TItem t; t.scale = nullptr; t.fmt = 0; t.half = 0;
    int r = it;
    if (r < NI_IN) { const int q = r % 92, kb = r / 92, pn = q >> 2, wc = q & 3; const int colbase = pn < 6 ? 256 * pn : 1544 + 256 * (pn - 6);
        t.src = INP(I_WIN) + (size_t)(64 * kb) * 5896 + colbase + 64 * wc; t.srcpitch = 5896; t.r0 = 256 * pn + 32 * wc; t.r1 = t.r0 + 128; t.scale = INP(I_N1G) + 64 * kb;
        if (pn >= FP8_FROM) { t.dst = F.ws + WS_WIN8 + 64 * kb; t.dstpitchB = 1024; t.fmt = 1; } else { t.dst = F.ws + WS_WIN + 128 * kb; t.dstpitchB = 2048; }
        return t; } r -= NI_IN;
    if (r < NI_WM) { const int kb = r % 8, q = r / 8, pn = q >> 2, wc = q & 3;
        t.src = INP(I_WMB) + (size_t)(64 * kb) * 1024 + 256 * pn + 64 * wc; t.srcpitch = 1024; t.dst = F.ws + WS_WM + 128 * kb; t.dstpitchB = 1024; t.r0 = 256 * pn + 32 * wc; t.r1 = t.r0 + 128; return t; } r -= NI_WM;
    if (r < NI_WA) { const int kb = r % 4, q = r / 4, pn = q >> 2, wc = q & 3;
        t.src = INP(I_WAB) + (size_t)(64 * kb) * 1024 + 256 * pn + 64 * wc; t.srcpitch = 1024; t.dst = F.ws + WS_WA + 128 * kb; t.dstpitchB = 1024; t.r0 = 256 * pn + 32 * wc; t.r1 = t.r0 + 128; return t; } r -= NI_WA;
    if (r < NI_WO) { const int kb = r % 16, q = r / 16, pn = q >> 2, wc = q & 3;
        t.src = INP(I_WOUT) + (size_t)(64 * kb) * 1024 + 256 * pn + 64 * wc; t.srcpitch = 1024; t.dst = F.ws + WS_WO + 128 * kb; t.dstpitchB = 2048; t.r0 = 256 * pn + 32 * wc; t.r1 = t.r0 + 128; return t; } r -= NI_WO;
    if (r < NI_WR) { const int kb = r;
        t.src = INP(I_WR) + (size_t)(64 * kb) * 32; t.srcpitch = 32; t.dst = F.ws + WS_WR + 128 * kb; t.dstpitchB = 2048; t.r0 = 0; t.r1 = 0; t.scale = INP(I_N2G) + 64 * kb; t.half = 1; return t; } r -= NI_WR;
    if (r < NI_W1) { const int cb = r % 32; int q = r / 32; const int kb = q % 16, e = q / 16;
        const int q2 = cb & 15, rr = 256 * (q2 >> 1) + 64 * (q2 & 1) + (cb >= 16 ? 128 : 0);
        t.src = INP(I_W1) + (size_t)e * 1024 * 2048 + (size_t)(64 * kb) * 2048 + 64 * cb; t.srcpitch = 2048; t.dst = F.ws + WS_W1 + (size_t)e * 2048 * 1024 + 64 * kb; t.dstpitchB = 1024; t.r0 = rr; t.r1 = rr + 32;
        t.scale = INP(I_N2G) + 64 * kb; t.fmt = 1; return t; } r -= NI_W1;
    { const int cb = r % 16; int q = r / 16; const int kb = q % 16, e = q / 16, pn = cb >> 2, wc = cb & 3;
        t.src = INP(I_W2) + (size_t)e * 1024 * 1024 + (size_t)(64 * kb) * 1024 + 256 * pn + 64 * wc; t.srcpitch = 1024; t.dst = F.ws + WS_W2 + (size_t)e * 1024 * 1024 + 64 * kb; t.dstpitchB = 1024; t.r0 = 256 * pn + 32 * wc; t.r1 = t.r0 + 128; t.fmt = 1; return t; }
}
__device__ __forceinline__ void titem_load(const TItem& t, int lane, f32x4 (&v)[16], float (&sc)[16]) {
    const int cq = lane & 15, kq = lane >> 4;
#pragma unroll
    for (int i = 0; i < 16; ++i) { v[i] = (f32x4){0.f, 0.f, 0.f, 0.f}; if (!t.half || cq < 8) v[i] = *(const GAS f32x4*)(t.src + (size_t)(4 * i + kq) * t.srcpitch + 4 * cq); }
#pragma unroll
    for (int i = 0; i < 16; ++i) sc[i] = (t.scale ? t.scale[4 * i + kq] : 1.0f) * (t.fmt == 1 ? 32.0f : 1.0f);
}
__device__ __forceinline__ void titem_store(const TItem& t, int lane, const f32x4 (&v)[16], const float (&sc)[16], LAS float* scr) {
    const int cq = lane & 15, kq = lane >> 4;
#pragma unroll
    for (int i = 0; i < 16; ++i) { LAS float* s = scr + (4 * i + kq) * 65 + 4 * cq; s[0] = v[i][0] * sc[i]; s[1] = v[i][1] * sc[i]; s[2] = v[i][2] * sc[i]; s[3] = v[i][3] * sc[i]; }
    LDS_WAIT(); asm volatile("" ::: "memory");
    if (t.fmt == 0) {
        const int ch = lane & 7;
#pragma unroll
        for (int q = 0; q < 8; ++q) { const int n = (lane >> 3) + 8 * q; const LAS float* s = scr + (8 * ch) * 65 + n;
            u32x4 o; o.x = pk2(s[0 * 65], s[1 * 65]); o.y = pk2(s[2 * 65], s[3 * 65]); o.z = pk2(s[4 * 65], s[5 * 65]); o.w = pk2(s[6 * 65], s[7 * 65]);
            if (!t.half || n < 32) *(GAS u32x4*)(t.dst + (size_t)(n < 32 ? t.r0 + n : t.r1 + n - 32) * t.dstpitchB + ch * 16) = o; }
    } else {
        const int ch = lane & 3;
#pragma unroll
        for (int q = 0; q < 4; ++q) { const int n = (lane >> 2) + 16 * q; const LAS float* s = scr + (16 * ch) * 65 + n;
            f32x4 a0 = (f32x4){s[0 * 65], s[1 * 65], s[2 * 65], s[3 * 65]}, a1 = (f32x4){s[4 * 65], s[5 * 65], s[6 * 65], s[7 * 65]};
            f32x4 a2 = (f32x4){s[8 * 65], s[9 * 65], s[10 * 65], s[11 * 65]}, a3 = (f32x4){s[12 * 65], s[13 * 65], s[14 * 65], s[15 * 65]};
            const u32x2 lo = pack8_fp8(a0, a1), hi = pack8_fp8(a2, a3);
            *(GAS u32x4*)(t.dst + (size_t)(n < 32 ? t.r0 + n : t.r1 + n - 32) * t.dstpitchB + ch * 16) = (u32x4){lo.x, lo.y, hi.x, hi.y}; }
    }
    LDS_WAIT(); asm volatile("" ::: "memory");
}

__device__ __forceinline__ void p0_prologue(Frame& F) {
    LAS float* scr = (LAS float*)(F.lds + F.wave * 16640);
    const int gw = F.vcu * 8 + F.wave, NGW = F.G * 8;
    constexpr int NITEMS = 92 * 16 + 16 * 8 + 16 * 4 + 16 * 16 + 16 + 32 * 32 * 16 + 32 * 16 * 16;
    {
        int it = gw;
        if (it < NITEMS) {
            f32x4 vc[16], vn[16]; float sc_c[16], sc_n[16];
            TItem cur = titem_decode(F, it); titem_load(cur, F.lane, vc, sc_c);
            for (;;) {
                const int itn = it + NGW; const bool has_next = itn < NITEMS;
                TItem nxt = cur;
                if (has_next) { nxt = titem_decode(F, itn); titem_load(nxt, F.lane, vn, sc_n); }
                titem_store(cur, F.lane, vc, sc_c, scr);
                if (!has_next) break;
                cur = nxt; it = itn;
#pragma unroll
                for (int i = 0; i < 16; ++i) { vc[i] = vn[i]; sc_c[i] = sc_n[i]; }
            }
        }
    }
    __syncthreads();
    LAS float* WG = (LAS float*)(F.lds);
    for (int u = F.tid; u < 1024 * 8; u += 512) WG[(u & 7) * 1024 + (u >> 3)] = INP(I_WIN)[(size_t)(u >> 3) * 5896 + 1536 + (u & 7)];
    __syncthreads();
    f32x4 g1v[4];
#pragma unroll
    for (int j = 0; j < 4; ++j) g1v[j] = *(const GAS f32x4*)(INP(I_N1G) + 4 * F.lane + 256 * j);
    const float gb = INP(I_GATEB)[F.lane & 7];
    if (gw < NTOK) {
        f32x4 vn[4];
        { const GAS f32x4* xr = (const GAS f32x4*)(INP(I_X) + (size_t)gw * DM) + F.lane;
#pragma unroll
          for (int j = 0; j < 4; ++j) vn[j] = xr[64 * j]; }
        for (int m = gw; m < NTOK; m += NGW) {
            f32x4 v[4]; float s2 = 0.f;
#pragma unroll
            for (int j = 0; j < 4; ++j) { v[j] = vn[j]; s2 += (v[j].x * v[j].x + v[j].y * v[j].y) + (v[j].z * v[j].z + v[j].w * v[j].w); }
            if (m + NGW < NTOK) { const GAS f32x4* xr = (const GAS f32x4*)(INP(I_X) + (size_t)(m + NGW) * DM) + F.lane;
#pragma unroll
                for (int j = 0; j < 4; ++j) vn[j] = xr[64 * j]; }
            const float rstd = __builtin_amdgcn_rsqf(wave_sum(s2) * (1.f / DM) + EPS);
            GAS unsigned long long* o8 = (GAS unsigned long long*)(WSP(bf16_t, WS_XN) + (size_t)m * DM) + F.lane;
            float ga[8];
#pragma unroll
            for (int c = 0; c < 8; ++c) ga[c] = 0.f;
            if (F.lane == 0) WSP(float, WS_RSTD1)[m] = rstd;
#pragma unroll
            for (int j = 0; j < 4; ++j) {
                o8[64 * j] = (unsigned long long)pk2(v[j].x, v[j].y) | ((unsigned long long)pk2(v[j].z, v[j].w) << 32);
                { int w8 = 0; w8 = __builtin_amdgcn_cvt_pk_fp8_f32(v[j].x, v[j].y, w8, false); w8 = __builtin_amdgcn_cvt_pk_fp8_f32(v[j].z, v[j].w, w8, true);
                  ((GAS unsigned*)(F.ws + WS_XN8 + (size_t)m * DM))[F.lane + 64 * j] = (unsigned)w8; }
                v[j] = v[j] * rstd * g1v[j];
#pragma unroll
                for (int c = 0; c < 8; ++c) { const f32x4 w = *(const LAS f32x4*)(WG + c * 1024 + 4 * F.lane + 256 * j); ga[c] += (v[j].x * w.x + v[j].y * w.y) + (v[j].z * w.z + v[j].w * w.w); }
            }
#pragma unroll
            for (int c = 0; c < 4; ++c) { const float mine = (F.lane & 4) ? ga[c + 4] : ga[c], oth = (F.lane & 4) ? ga[c] : ga[c + 4]; ga[c] = mine + __shfl_xor(oth, 4); }
#pragma unroll
            for (int c = 0; c < 2; ++c) { const float mine = (F.lane & 2) ? ga[c + 2] : ga[c], oth = (F.lane & 2) ? ga[c] : ga[c + 2]; ga[c] = mine + __shfl_xor(oth, 2); }
            { const float mine = (F.lane & 1) ? ga[1] : ga[0], oth = (F.lane & 1) ? ga[0] : ga[1]; ga[0] = mine + __shfl_xor(oth, 1); }
            float t = ga[0];
            t += __shfl_xor(t, 8); t += __shfl_xor(t, 16); t += __shfl_xor(t, 32);
            if (F.lane < 8) { const float z = t + gb; WSP(float, WS_GATES)[(size_t)m * 8 + F.lane] = 15.0f * tanhf(z * (1.0f / 15.0f)); }
        }
    }
}

struct SchedInProj { g8::TileOrder T; const char* A; const char* B;
    __device__ __forceinline__ bool next(int i, g8::GUnit& u) const { int pm, pn; if (!T.tile(i, pm, pn)) return false; u.pm = pm; u.pn = pn; u.nt = 16; u.sel = 0; u.e = 0; u.rt = 0; u.x = 0; u.y = 0;
        u.A = A + (size_t)pm * 256 * 2048; u.B = B + (size_t)pn * 256 * 2048; return true; }
    __device__ __forceinline__ unsigned arow(const g8::GUnit&, int) const { return 0u; }
};
struct SchedInProj8 { g8::TileOrder T; const char* A; const char* B;
    __device__ __forceinline__ bool next(int i, g8::GUnit& u) const { int pm, pl; if (!T.tile(i, pm, pl)) return false; const int pn = FP8_FROM + pl; u.pm = pm; u.pn = pn; u.nt = 8; u.sel = 0; u.e = 0; u.rt = 0; u.x = 256 * pm; u.y = 256;
        u.A = A; u.B = B + (size_t)pn * 256 * 1024; return true; }
    __device__ __forceinline__ unsigned arow(const g8::GUnit& u, int r) const { return (unsigned)(u.x + r) * 1024u; }
    __device__ __forceinline__ void rows_dma(const g8::GUnit&, LAS unsigned*, int, int) const {}
    __device__ __forceinline__ unsigned arow_lds(const g8::GUnit& u, int r, const LAS unsigned*) const { return (unsigned)(u.x + r) * 1024u; }
};
struct EpiInProj {
    unsigned char* ws; const GAS float* gq; const GAS float* gk; float ascale;
    __device__ __forceinline__ void aux_dma(const g8::GUnit& u, LAS unsigned char* aux, int par, int wid, int lane) const {
        if (wid == 4) __builtin_amdgcn_global_load_lds((const unsigned*)((const float*)(ws + WS_RSTD1) + 256 * u.pm + 4 * lane), (LAS unsigned*)(aux + par * 2048), 16, 0, 0); }
    __device__ __forceinline__ bool operator()(f32x4 (&acc)[2][2][4][2], const g8::GUnit& u, int wr, int wc, int fr, int fq, LAS unsigned char* aux, int par) const {
        const int pn = u.pn;
        size_t base; int pitch, col0, kind = 0, grp = 0; float sc = 1.f;
        if (pn == 0)      { base = WS_MQ; pitch = 256; col0 = 0; }
        else if (pn == 1) { base = WS_MK; pitch = 256; col0 = 0; sc = 0.125f; }
        else if (pn < 4)  { base = WS_MV; pitch = 512; col0 = 256 * (pn - 2); }
        else if (pn < 6)  { base = WS_MO; pitch = 512; col0 = 256 * (pn - 4); kind = 1; }
        else if (pn < 9)  { base = WS_AQ; pitch = 768; col0 = 256 * (pn - 6); kind = 2; grp = pn - 6; sc = 0.125f * LOG2E; }
        else if (pn < 12) { base = WS_AK; pitch = 768; col0 = 256 * (pn - 9); kind = 3; grp = pn - 9; }
        else if (pn < 15) { base = WS_AV; pitch = 768; col0 = 256 * (pn - 12); }
        else if (pn < 19) { base = WS_GM; pitch = 1024; col0 = 256 * (pn - 15); kind = 1; }
        else              { base = WS_GA; pitch = 1024; col0 = 256 * (pn - 19); kind = 1; }
        bf16_t* dst = (bf16_t*)(ws + base);
        const int L0 = 64 * wc + 8 * fq;
        const int row0 = u.pm * 256 + wr * 64 + fr;
        f32x4 gn[2][2];
        if (kind >= 2) { const int go = grp * 64 + 8 * fq;
#pragma unroll
            for (int bj = 0; bj < 2; ++bj)
#pragma unroll
                for (int n = 0; n < 2; ++n) { const f32x4 a = *(const GAS f32x4*)(gq + go + 32 * bj + 4 * n), b = *(const GAS f32x4*)(gk + go + 32 * bj + 4 * n); gn[bj][n] = (kind == 2) ? a : b; } }
#pragma unroll
        for (int ai = 0; ai < 2; ++ai)
#pragma unroll
            for (int m = 0; m < 4; ++m) {
                const int row = row0 + 128 * ai + 16 * m;
                const float rs = ((const LAS float*)(aux + par * 2048))[128 * ai + 64 * wr + 16 * m + fr] * ascale;
                f32x4 v[2][2];
#pragma unroll
                for (int bj = 0; bj < 2; ++bj)
#pragma unroll
                    for (int n = 0; n < 2; ++n) v[bj][n] = acc[ai][bj][m][n] * rs;
                if (kind == 1) {
#pragma unroll
                    for (int bj = 0; bj < 2; ++bj)
#pragma unroll
                        for (int n = 0; n < 2; ++n)
#pragma unroll
                            for (int e = 0; e < 4; ++e) v[bj][n][e] = sigmoidf_(v[bj][n][e]);
                } else if (kind >= 2) {
                    float ss = 0.f;
#pragma unroll
                    for (int bj = 0; bj < 2; ++bj)
#pragma unroll
                        for (int n = 0; n < 2; ++n) ss += (v[bj][n][0] * v[bj][n][0] + v[bj][n][1] * v[bj][n][1]) + (v[bj][n][2] * v[bj][n][2] + v[bj][n][3] * v[bj][n][3]);
                    ss += __shfl_xor(ss, 16); ss += __shfl_xor(ss, 32);
                    const float r = sc * __builtin_amdgcn_rsqf(ss * (1.0f / 64.0f) + EPS);
#pragma unroll
                    for (int bj = 0; bj < 2; ++bj)
#pragma unroll
                        for (int n = 0; n < 2; ++n) v[bj][n] = v[bj][n] * gn[bj][n] * r;
                } else {
#pragma unroll
                    for (int bj = 0; bj < 2; ++bj)
#pragma unroll
                        for (int n = 0; n < 2; ++n) v[bj][n] = v[bj][n] * sc;
                }
#pragma unroll
                for (int bj = 0; bj < 2; ++bj) st16(dst + (size_t)row * pitch + col0 + L0 + 32 * bj, pack8(v[bj][0], v[bj][1]));
            }
        return false;
    }
};

struct SchedBranch { g8::TileOrder T; const char *A0, *B0, *A1, *B1;
    __device__ __forceinline__ bool next(int i, g8::GUnit& u) const { int pm, pn; if (!T.tile(i >> 1, pm, pn)) return false; u.pm = pm; u.pn = pn; u.sel = i & 1; u.e = 0; u.rt = 0; u.x = 0; u.y = 0;
        if (u.sel == 0) { u.nt = 8; u.A = A0 + (size_t)pm * 256 * 1024; u.B = B0 + (size_t)pn * 256 * 1024; }
        else            { u.nt = 4; u.A = A1 + (size_t)pm * 256 * 1024; u.B = B1 + (size_t)pn * 256 * 1024; }
        return true; }
    __device__ __forceinline__ unsigned arow(const g8::GUnit&, int) const { return 0u; }
};
struct EpiBranch {
    const bf16_t *GM, *GA; bf16_t* Y;
    __device__ __forceinline__ void aux_dma(const g8::GUnit&, LAS unsigned char*, int, int, int) const {}
    __device__ __forceinline__ bool operator()(f32x4 (&acc)[2][2][4][2], const g8::GUnit& u, int wr, int wc, int fr, int fq, LAS unsigned char* aux, int par) const {
        const int row0 = u.pm * 256 + wr * 64 + fr, c0 = 256 * u.pn + 64 * wc + 8 * fq;
        u32x4 gan[2], gmn[2], gac[2], gmc[2];
#pragma unroll
        for (int bj = 0; bj < 2; ++bj) { const size_t ro = (size_t)row0 * 1024 + c0 + 32 * bj; gan[bj] = *(const u32x4*)(GA + ro); gmn[bj] = gan[bj]; if (u.sel == 0) gmn[bj] = *(const u32x4*)(GM + ro); }
#pragma unroll
        for (int ai = 0; ai < 2; ++ai)
#pragma unroll
            for (int m = 0; m < 4; ++m) {
                const size_t ro = (size_t)(row0 + 128 * ai + 16 * m) * 1024 + c0;
#pragma unroll
                for (int bj = 0; bj < 2; ++bj) { gac[bj] = gan[bj]; gmc[bj] = gmn[bj]; }
                if (ai * 4 + m < 7) { const int it = ai * 4 + m + 1; const size_t rn = (size_t)(row0 + 128 * (it >> 2) + 16 * (it & 3)) * 1024 + c0;
#pragma unroll
                    for (int bj = 0; bj < 2; ++bj) { gan[bj] = *(const u32x4*)(GA + rn + 32 * bj); gmn[bj] = gan[bj]; if (u.sel == 0) gmn[bj] = *(const u32x4*)(GM + rn + 32 * bj); } }
#pragma unroll
                for (int bj = 0; bj < 2; ++bj) {
                    f32x4 a0, a1; unpack8(gac[bj], a0, a1);
                    if (u.sel == 0) { f32x4 m0, m1; unpack8(gmc[bj], m0, m1);
#pragma unroll
                        for (int e = 0; e < 4; ++e) { acc[ai][bj][m][0][e] *= m0[e] * __builtin_amdgcn_rcpf(a0[e]); acc[ai][bj][m][1][e] *= m1[e] * __builtin_amdgcn_rcpf(a1[e]); }
                    } else { st16(Y + ro + 32 * bj, pack8(acc[ai][bj][m][0] * a0, acc[ai][bj][m][1] * a1)); }
                }
            }
        return u.sel == 0;
    }
};

struct SchedWout { g8::TileOrder T; const char* A; const char* B;
    __device__ __forceinline__ bool next(int i, g8::GUnit& u) const { int pm, pn; if (!T.tile(i, pm, pn)) return false; u.pm = pm; u.pn = pn; u.nt = 16; u.sel = 0; u.e = 0; u.rt = 0; u.x = 0; u.y = 0;
        u.A = A + (size_t)pm * 256 * 2048; u.B = B + (size_t)pn * 256 * 2048; return true; }
    __device__ __forceinline__ unsigned arow(const g8::GUnit&, int) const { return 0u; }
};
struct EpiWout {
    const bf16_t* x; bf16_t* X1B; unsigned char* X1F8; float* SSQ;
    __device__ __forceinline__ void aux_dma(const g8::GUnit&, LAS unsigned char*, int, int, int) const {}
    __device__ __forceinline__ bool operator()(f32x4 (&acc)[2][2][4][2], const g8::GUnit& u, int wr, int wc, int fr, int fq, LAS unsigned char* aux, int par) const {
        const int row0 = u.pm * 256 + wr * 64 + fr, c0 = 256 * u.pn + 64 * wc + 8 * fq;
        const bool odd = fq & 1;
        u32x4 xn[2], xc[2];
#pragma unroll
        for (int bj = 0; bj < 2; ++bj) { const size_t ro = (size_t)row0 * 1024 + c0; xn[bj] = *(const u32x4*)(x + ro + 32 * bj); }
#pragma unroll
        for (int ai = 0; ai < 2; ++ai)
#pragma unroll
            for (int m = 0; m < 4; ++m) {
                const int row = row0 + 128 * ai + 16 * m; const size_t ro = (size_t)row * 1024 + c0; float ss = 0.f;
#pragma unroll
                for (int bj = 0; bj < 2; ++bj) xc[bj] = xn[bj];
                if (ai * 4 + m < 7) { const int it = ai * 4 + m + 1; const size_t rn = (size_t)(row0 + 128 * (it >> 2) + 16 * (it & 3)) * 1024 + c0;
#pragma unroll
                    for (int bj = 0; bj < 2; ++bj) xn[bj] = *(const u32x4*)(x + rn + 32 * bj); }
                u32x2 f8[2];
#pragma unroll
                for (int bj = 0; bj < 2; ++bj) {
                    f32x4 x0, x1; unpack8(xc[bj], x0, x1);
                    const f32x4 v0 = acc[ai][bj][m][0] + x0, v1 = acc[ai][bj][m][1] + x1;
                    st16(X1B + ro + 32 * bj, pack8(v0, v1)); f8[bj] = pack8_fp8(v0, v1);
                    ss += (v0[0] * v0[0] + v0[1] * v0[1]) + (v0[2] * v0[2] + v0[3] * v0[3]) + (v1[0] * v1[0] + v1[1] * v1[1]) + (v1[2] * v1[2] + v1[3] * v1[3]);
                }
                const u32x2 snd = odd ? f8[0] : f8[1];
                u32x2 rcv; rcv.x = (unsigned)__shfl_xor((int)snd.x, 16); rcv.y = (unsigned)__shfl_xor((int)snd.y, 16);
                const u32x4 w16 = odd ? (u32x4){rcv.x, rcv.y, f8[1].x, f8[1].y} : (u32x4){f8[0].x, f8[0].y, rcv.x, rcv.y};
                st16(X1F8 + (size_t)row * 1024 + 256 * u.pn + 64 * wc + (odd ? 32 + 8 * (fq - 1) : 8 * fq), w16);
                ss += __shfl_xor(ss, 16); ss += __shfl_xor(ss, 32);
                if (fq == 0) SSQ[(size_t)row * 16 + u.pn * 4 + wc] = ss;
            }
        return false;
    }
};

__device__ __forceinline__ void moe_tables(Frame& F) {
    LAS int* tab = (LAS int*)(F.lds + TAB_OFF);
    if (F.wave == 0) { const unsigned* cnt = WSP(unsigned, WS_CTL) + CW_CNT;
        const int c = F.lane < NEXP ? (int)__hip_atomic_load(cnt + (F.lane & 31), RLX_AGENT) : 0;
        const int t = (c + 255) >> 8; int ts = t, of = c;
#pragma unroll
        for (int o = 1; o < 32; o <<= 1) { const int a = __shfl_up(ts, o), b2 = __shfl_up(of, o); if (F.lane >= o) { ts += a; of += b2; } }
        if (F.lane < NEXP) { tab[F.lane] = ts - t; tab[40 + F.lane] = of - c; tab[80 + F.lane] = c; }
        if (F.lane == NEXP - 1) { tab[32] = ts; tab[72] = of; } }
    __syncthreads();
}
template <int NPN, bool G1>
struct SchedMoe { g8::TileOrder T; const LAS int* tab; const char* A; const char* B; const int* LIST;
    __device__ __forceinline__ bool next(int i, g8::GUnit& u) const { int pm, pn; if (!T.tile(i, pm, pn)) return false;
        int e = 0;
        for (int k = 1; k < NEXP; ++k) e = (tab[k] <= pm) ? k : e;
        e = __builtin_amdgcn_readfirstlane(e);
        const int ts = __builtin_amdgcn_readfirstlane(tab[e]), of = __builtin_amdgcn_readfirstlane(tab[40 + e]), cn = __builtin_amdgcn_readfirstlane(tab[80 + e]);
        const int rt = pm - ts; u.pm = pm; u.pn = pn; u.sel = 0; u.e = e; u.rt = rt; u.nt = 8; u.x = of + 256 * rt; u.y = cn - 256 * rt;
        if (G1) { u.A = A; u.B = B + ((size_t)e * 2048 + 256 * pn) * 1024; }
        else { u.A = A; u.B = B + ((size_t)e * 1024 + 256 * pn) * 1024; }
        return true; }
    __device__ __forceinline__ unsigned arow(const g8::GUnit& u, int r) const {
        if (G1) { const int rr = r < u.y ? r : u.y - 1; const int tok = LIST[(size_t)u.e * NTOK + 256 * u.rt + rr]; return (unsigned)tok * 1024u; }
        else return (unsigned)(u.x + r) * 1024u; }
    __device__ __forceinline__ void rows_dma(const g8::GUnit& u, LAS unsigned* buf, int wid, int lane) const {
        if (G1) { if (wid < 4) __builtin_amdgcn_global_load_lds((const unsigned*)(LIST + (size_t)u.e * NTOK + 256 * u.rt + 64 * wid + lane), (LAS unsigned*)(buf + 64 * wid), 4, 0, 0); } }
    __device__ __forceinline__ unsigned arow_lds(const g8::GUnit& u, int r, const LAS unsigned* buf) const {
        if (G1) { const unsigned tok = buf[r]; return (tok < (unsigned)NTOK ? tok : 0u) * 1024u; }
        else return (unsigned)(u.x + r) * 1024u; }
};
struct EpiMoe1 {
    const float* SRSTD; const GAS float* b1; unsigned char* H;
    __device__ __forceinline__ void aux_dma(const g8::GUnit& u, LAS unsigned char* aux, int par, int wid, int lane) const {
        if (wid == 4) __builtin_amdgcn_global_load_lds((const unsigned*)(SRSTD + (size_t)u.e * NTOK + 256 * u.rt + 4 * lane), (LAS unsigned*)(aux + par * 2048), 16, 0, 0);
        if (wid == 5) __builtin_amdgcn_global_load_lds((const unsigned*)((const float*)b1 + (size_t)u.e * 2048 + (lane < 32 ? 0 : 1024) + 128 * u.pn + 4 * (lane & 31)), (LAS unsigned*)(aux + par * 2048 + 1024), 16, 0, 0); }
    __device__ __forceinline__ bool operator()(f32x4 (&acc)[2][2][4][2], const g8::GUnit& u, int wr, int wc, int fr, int fq, LAS unsigned char* aux, int par) const {
        const int j0 = 128 * u.pn + 32 * wc + 8 * fq; const bool odd = fq & 1;
        const LAS float* sb = (const LAS float*)(aux + par * 2048); const LAS float* bbuf = sb + 256;
        f32x4 bg[2], bl[2];
#pragma unroll
        for (int n = 0; n < 2; ++n) { bg[n] = *(const LAS f32x4*)(bbuf + 32 * wc + 8 * fq + 4 * n); bl[n] = *(const LAS f32x4*)(bbuf + 128 + 32 * wc + 8 * fq + 4 * n); }
        float rsv[2][4];
#pragma unroll
        for (int ai = 0; ai < 2; ++ai)
#pragma unroll
            for (int m = 0; m < 4; ++m) { const int r = 128 * ai + 64 * wr + 16 * m + fr; rsv[ai][m] = (r < u.y) ? sb[r] * 0.03125f : 0.f; }
#pragma unroll
        for (int ai = 0; ai < 2; ++ai)
#pragma unroll
            for (int mp = 0; mp < 2; ++mp) {
                u32x2 h8[2]; int rr[2];
#pragma unroll
                for (int q = 0; q < 2; ++q) { const int m = 2 * mp + q;
                    const int r = 128 * ai + 64 * wr + 16 * m + fr; rr[q] = r;
                    const float rs = rsv[ai][m];
                    f32x4 o[2];
#pragma unroll
                    for (int n = 0; n < 2; ++n)
#pragma unroll
                        for (int e = 0; e < 4; ++e) {
                            float g = fminf(rs * acc[ai][0][m][n][e] + bg[n][e], 7.0f);
                            float l = fminf(fmaxf(rs * acc[ai][1][m][n][e] + bl[n][e], -7.0f), 7.0f);
                            o[n][e] = (l + 1.0f) * g * sigmoidf_(1.702f * g);
                        }
                    h8[q] = pack8_fp8(o[0], o[1]); }
                const u32x2 snd = odd ? h8[0] : h8[1];
                u32x2 rcv; rcv.x = (unsigned)__shfl_xor((int)snd.x, 16); rcv.y = (unsigned)__shfl_xor((int)snd.y, 16);
                const u32x4 w16 = odd ? (u32x4){rcv.x, rcv.y, h8[1].x, h8[1].y} : (u32x4){h8[0].x, h8[0].y, rcv.x, rcv.y};
                const int r = odd ? rr[1] : rr[0];
                if (r < u.y) st16(H + (size_t)(u.x + r) * 1024 + (odd ? j0 - 8 : j0), w16);
            }
        return false;
    }
};
struct EpiMoe2 {
    const float* GLIST; const GAS float* b2; unsigned char* Y2;
    __device__ __forceinline__ void aux_dma(const g8::GUnit& u, LAS unsigned char* aux, int par, int wid, int lane) const {
        if (wid == 4) __builtin_amdgcn_global_load_lds((const unsigned*)(GLIST + (size_t)u.e * NTOK + 256 * u.rt + 4 * lane), (LAS unsigned*)(aux + par * 2048), 16, 0, 0);
        if (wid == 5) __builtin_amdgcn_global_load_lds((const unsigned*)((const float*)b2 + (size_t)u.e * 1024 + 256 * u.pn + 4 * lane), (LAS unsigned*)(aux + par * 2048 + 1024), 16, 0, 0); }
    __device__ __forceinline__ bool operator()(f32x4 (&acc)[2][2][4][2], const g8::GUnit& u, int wr, int wc, int fr, int fq, LAS unsigned char* aux, int par) const {
        const int c0 = 256 * u.pn + 64 * wc + 8 * fq; const bool odd = fq & 1;
        const LAS float* sb = (const LAS float*)(aux + par * 2048); const LAS float* bbuf = sb + 256;
        f32x4 bb[2][2];
#pragma unroll
        for (int bj = 0; bj < 2; ++bj)
#pragma unroll
            for (int n = 0; n < 2; ++n) bb[bj][n] = *(const LAS f32x4*)(bbuf + 64 * wc + 8 * fq + 32 * bj + 4 * n);
        float gtv[2][4];
#pragma unroll
        for (int ai = 0; ai < 2; ++ai)
#pragma unroll
            for (int m = 0; m < 4; ++m) { const int r = 128 * ai + 64 * wr + 16 * m + fr; gtv[ai][m] = (r < u.y) ? sb[r] * 16.0f : 0.f; }
#pragma unroll
        for (int ai = 0; ai < 2; ++ai)
#pragma unroll
            for (int m = 0; m < 4; ++m) {
                const int r = 128 * ai + 64 * wr + 16 * m + fr; const bool valid = r < u.y;
                const float gt = gtv[ai][m];
                u32x2 f8[2];
#pragma unroll
                for (int bj = 0; bj < 2; ++bj) f8[bj] = pack8_fp8((acc[ai][bj][m][0] * 0.03125f + bb[bj][0]) * gt, (acc[ai][bj][m][1] * 0.03125f + bb[bj][1]) * gt);
                const u32x2 snd = odd ? f8[0] : f8[1];
                u32x2 rcv; rcv.x = (unsigned)__shfl_xor((int)snd.x, 16); rcv.y = (unsigned)__shfl_xor((int)snd.y, 16);
                const u32x4 w16 = odd ? (u32x4){rcv.x, rcv.y, f8[1].x, f8[1].y} : (u32x4){f8[0].x, f8[0].y, rcv.x, rcv.y};
                if (valid) st16(Y2 + (size_t)(u.x + r) * 1024 + 256 * u.pn + 64 * wc + (odd ? 32 + 8 * (fq - 1) : 8 * fq), w16);
            }
        return false;
    }
};

constexpr int KP = 160, VP = 288;
constexpr int ML_K = 0, ML_V = 256 * KP, ML_C = ML_V + 256 * VP, ML_F = ML_C + 64 * VP, ML_OST = ML_F + 3328;
__device__ __forceinline__ float logsigmoidf_(float f) { return fminf(f, 0.f) - log1pf(__expf(-fabsf(f))); }

__device__ __forceinline__ void ml_gates(Frame& F, int n0, int h, LAS float* Bc, LAS float* ig) {
    if (F.wave == 0) {
        const float* G = WSP(float, WS_GATES);
        float lf[4], iv[4];
#pragma unroll
        for (int e = 0; e < 4; ++e) { const size_t t = (size_t)(n0 + 4 * F.lane + e) * 8; iv[e] = G[t + h]; lf[e] = logsigmoidf_(G[t + 4 + h]); }
        lf[1] += lf[0]; lf[2] += lf[1]; lf[3] += lf[2];
        float tot = lf[3], inc = tot;
#pragma unroll
        for (int o = 1; o < 64; o <<= 1) { const float t = __shfl_up(inc, o); if (F.lane >= o) inc += t; }
        const float exc = inc - tot;
#pragma unroll
        for (int e = 0; e < 4; ++e) { Bc[4 * F.lane + e] = exc + lf[e]; ig[4 * F.lane + e] = iv[e]; }
    }
}

__device__ __forceinline__ void mlstm_state_unit(Frame& F, int u) {
    const int bh = u >> 6, sc = u & 63, b = bh >> 2, h = bh & 3;
    const int n0 = b * SEQ + sc * 256;
    LAS unsigned char* Ks = F.lds + ML_K; LAS unsigned char* Vs = F.lds + ML_V;
    LAS float* Bc = (LAS float*)(F.lds + ML_F); LAS float* ig = Bc + 256;
    const bf16_t* MK = WSP(bf16_t, WS_MK); const bf16_t* MV = WSP(bf16_t, WS_MV);
    u32x4 kreg[4], vreg[8];
#pragma unroll
    for (int t = 0; t < 4; ++t) { const int c = F.tid + 512 * t, s = c >> 3, ch = c & 7; kreg[t] = *(const u32x4*)(MK + (size_t)(n0 + s) * 256 + h * 64 + ch * 8); }
#pragma unroll
    for (int t = 0; t < 8; ++t) { const int c = F.tid + 512 * t, s = c >> 4, ch = c & 15; vreg[t] = *(const u32x4*)(MV + (size_t)(n0 + s) * 512 + h * 128 + ch * 8); }
    ml_gates(F, n0, h, Bc, ig);
    __syncthreads();
    const float Gt = Bc[255];
#pragma unroll
    for (int t = 0; t < 4; ++t) { const int c = F.tid + 512 * t, s = c >> 3, ch = c & 7; const float w = __expf(Gt - Bc[s] + ig[s]);
        f32x4 a0, a1; unpack8(kreg[t], a0, a1);
        *(LAS u32x4*)(Ks + s * KP + ch * 16) = pack8(a0 * w, a1 * w); }
#pragma unroll
    for (int t = 0; t < 8; ++t) { const int c = F.tid + 512 * t, s = c >> 4, ch = c & 15; *(LAS u32x4*)(Vs + s * VP + ch * 16) = vreg[t]; }
    __syncthreads();
    const int i = F.lane & 15, g = F.lane >> 4, w = F.wave;
    f32x4 acc[4], accn[4];
#pragma unroll
    for (int t = 0; t < 4; ++t) { acc[t] = (f32x4){0.f, 0.f, 0.f, 0.f}; accn[t] = (f32x4){0.f, 0.f, 0.f, 0.f}; }
    const bf16x8 ones = (bf16x8){0x3F80, 0x3F80, 0x3F80, 0x3F80, 0x3F80, 0x3F80, 0x3F80, 0x3F80};
    const int roff = (4 * g + (i >> 2));
    for (int ks = 0; ks < 8; ++ks) {
        const int s0 = 32 * ks;
        const LAS unsigned char* vp = Vs + (s0 + roff) * VP + (16 * w + 4 * (i & 3)) * 2;
        const bf16x8 bv = cat4(trread(vp), trread(vp + 16 * VP));
#pragma unroll
        for (int dk = 0; dk < 4; ++dk) {
            const LAS unsigned char* kp = Ks + (s0 + roff) * KP + (16 * dk + 4 * (i & 3)) * 2;
            const bf16x8 ak = cat4(trread(kp), trread(kp + 16 * KP));
            acc[dk] = MFMA16(ak, bv, acc[dk]);
            if (w == 0) accn[dk] = MFMA16(ak, ones, accn[dk]);
        }
    }
    float* CL = WSP(float, WS_CLOC) + (size_t)u * 8192;
#pragma unroll
    for (int dk = 0; dk < 4; ++dk)
#pragma unroll
        for (int r = 0; r < 4; ++r) CL[(16 * dk + 4 * g + r) * 128 + 16 * w + i] = acc[dk][r];
    if (w == 0 && i == 0) {
#pragma unroll
        for (int dk = 0; dk < 4; ++dk)
#pragma unroll
            for (int r = 0; r < 4; ++r) WSP(float, WS_MSTAT)[(size_t)u * 64 + 16 * dk + 4 * g + r] = accn[dk][r];
    }
    if (F.tid == 0) WSP(float, WS_MSTAT)[512 * 64 + u] = Gt;
    __syncthreads();
}

__device__ __forceinline__ void mlstm_scan(Frame& F) {
    const int gt = F.vcu * 512 + F.tid, NT = F.G * 512;
    const float* GT = WSP(float, WS_MSTAT) + 512 * 64;
    for (int idx = gt; idx < 8 * 8256; idx += NT) {
        const int bh = idx / 8256, el = idx % 8256;
        const float* p; float* q; size_t stride;
        if (el < 8192) { p = WSP(float, WS_CLOC) + (size_t)bh * 64 * 8192 + el; q = WSP(float, WS_CINIT) + (size_t)bh * 64 * 8192 + el; stride = 8192; }
        else { p = WSP(float, WS_MSTAT) + (size_t)bh * 64 * 64 + (el - 8192); q = WSP(float, WS_NINIT) + (size_t)bh * 64 * 64 + (el - 8192); stride = 64; }
        float st = 0.f;
#pragma unroll 1
        for (int s0 = 0; s0 < 64; s0 += 32) {
            float v[32], gv[32];
#pragma unroll
            for (int k = 0; k < 32; ++k) { v[k] = p[(size_t)(s0 + k) * stride]; gv[k] = GT[bh * 64 + s0 + k]; }
#pragma unroll
            for (int k = 0; k < 32; ++k) { q[(size_t)(s0 + k) * stride] = st; st = __expf(gv[k]) * st + v[k]; }
        }
    }
}

__device__ __forceinline__ void mlstm_out_unit(Frame& F, int u) {
    const int bh = u >> 6, sc = u & 63, b = bh >> 2, h = bh & 3;
    const int n0 = b * SEQ + sc * 256;
    LAS unsigned char* Ks = F.lds + ML_K; LAS unsigned char* Vs = F.lds + ML_V; LAS unsigned char* Cs = F.lds + ML_C;
    LAS float* Bc = (LAS float*)(F.lds + ML_F); LAS float* cS = Bc + 256; LAS float* eB = Bc + 512; LAS float* nI = Bc + 768;
    const bf16_t* MK = WSP(bf16_t, WS_MK); const bf16_t* MV = WSP(bf16_t, WS_MV);
    u32x4 kreg[4], vreg[8]; f32x4 creg[2][2];
#pragma unroll
    for (int t = 0; t < 4; ++t) { const int c = F.tid + 512 * t, s = c >> 3, ch = c & 7; kreg[t] = *(const u32x4*)(MK + (size_t)(n0 + s) * 256 + h * 64 + ch * 8); }
#pragma unroll
    for (int t = 0; t < 8; ++t) { const int c = F.tid + 512 * t, s = c >> 4, ch = c & 15; vreg[t] = *(const u32x4*)(MV + (size_t)(n0 + s) * 512 + h * 128 + ch * 8); }
    { const float* CL = WSP(float, WS_CINIT) + (size_t)u * 8192;
#pragma unroll
      for (int t = 0; t < 2; ++t) { const int c = F.tid + 512 * t, dk = c >> 4, ch = c & 15; creg[t][0] = *(const f32x4*)(CL + dk * 128 + ch * 8); creg[t][1] = *(const f32x4*)(CL + dk * 128 + ch * 8 + 4); } }
    const float nIv = (F.tid < 64) ? WSP(float, WS_NINIT)[(size_t)u * 64 + F.tid] : 0.f;
    ml_gates(F, n0, h, Bc, cS);
    __syncthreads();
    if (F.tid < 256) { const float bt = Bc[F.tid]; const float iv = cS[F.tid]; eB[F.tid] = __expf(bt); __builtin_amdgcn_s_waitcnt(0); cS[F.tid] = (iv - bt) * LOG2E; Bc[F.tid] = bt * LOG2E; }
    if (F.tid < 64) nI[F.tid] = nIv;
#pragma unroll
    for (int t = 0; t < 4; ++t) { const int c = F.tid + 512 * t, s = c >> 3, ch = c & 7; *(LAS u32x4*)(Ks + s * KP + ch * 16) = kreg[t]; }
#pragma unroll
    for (int t = 0; t < 8; ++t) { const int c = F.tid + 512 * t, s = c >> 4, ch = c & 15; *(LAS u32x4*)(Vs + s * VP + ch * 16) = vreg[t]; }
#pragma unroll
    for (int t = 0; t < 2; ++t) { const int c = F.tid + 512 * t, dk = c >> 4, ch = c & 15; *(LAS u32x4*)(Cs + dk * VP + ch * 16) = pack8(creg[t][0], creg[t][1]); }
    __syncthreads();
    const int i = F.lane & 15, g = F.lane >> 4, w = F.wave;
    const bf16_t* MQ = WSP(bf16_t, WS_MQ); const bf16_t* MO = WSP(bf16_t, WS_MO);
    const GAS float* mg = INP(I_MNG) + h * 128;
    LAS unsigned char* ost = F.lds + ML_OST + w * 2176;
    float gnv[8];
#pragma unroll
    for (int dv = 0; dv < 8; ++dv) gnv[dv] = mg[16 * dv + i];
#pragma unroll 1
    for (int half = 0; half < 2; ++half) {
        const int rt = half == 0 ? w : 15 - w;
        const int tq = 16 * rt + i;
        bf16x8 qf[2];
#pragma unroll
        for (int ks = 0; ks < 2; ++ks) qf[ks] = *(const bf16x8*)(MQ + (size_t)(n0 + tq) * 256 + h * 64 + 32 * ks + 8 * g);
        u32x4 mo[2][2];
#pragma unroll
        for (int hf = 0; hf < 2; ++hf)
#pragma unroll
            for (int q = 0; q < 2; ++q) mo[hf][q] = *(const u32x4*)(MO + (size_t)(n0 + 16 * rt + (F.lane >> 3) + 8 * q) * 512 + h * 128 + 64 * hf + 8 * (F.lane & 7));
        f32x4 acc[8];
#pragma unroll
        for (int t = 0; t < 8; ++t) acc[t] = (f32x4){0.f, 0.f, 0.f, 0.f};
        float dni = 0.f;
#pragma unroll
        for (int ks = 0; ks < 2; ++ks) {
#pragma unroll
            for (int j = 0; j < 8; ++j) dni += bf2f((bf16_t)qf[ks][j]) * nI[32 * ks + 8 * g + j];
#pragma unroll
            for (int dv = 0; dv < 8; ++dv) {
                const LAS unsigned char* cp = Cs + (32 * ks + 8 * g + (i >> 2)) * VP + (16 * dv + 4 * (i & 3)) * 2;
                acc[dv] = MFMA16(qf[ks], cat4(trread(cp), trread(cp + 4 * VP)), acc[dv]);
            }
        }
        dni += __shfl_xor(dni, 16); dni += __shfl_xor(dni, 32);
        float den = dni * eB[tq];
        { float er[4];
#pragma unroll
          for (int r = 0; r < 4; ++r) er[r] = eB[16 * rt + 4 * g + r];
#pragma unroll
          for (int dv = 0; dv < 8; ++dv)
#pragma unroll
            for (int r = 0; r < 4; ++r) acc[dv][r] *= er[r]; }
        const float bt2 = Bc[tq];
        float dpart = 0.f;
        const int nks = (rt >> 1) + 1;
        for (int ks = 0; ks < nks; ++ks) {
            const int s0 = 32 * ks;
            f32x4 s0v = (f32x4){0.f, 0.f, 0.f, 0.f}, s1v = (f32x4){0.f, 0.f, 0.f, 0.f};
#pragma unroll
            for (int kk = 0; kk < 2; ++kk) {
                const bf16x8 k0 = *(const LAS bf16x8*)(Ks + (s0 + i) * KP + (32 * kk + 8 * g) * 2);
                const bf16x8 k1 = *(const LAS bf16x8*)(Ks + (s0 + 16 + i) * KP + (32 * kk + 8 * g) * 2);
                s0v = MFMA16(k0, qf[kk], s0v); s1v = MFMA16(k1, qf[kk], s1v);
            }
            const f32x4 c0 = *(const LAS f32x4*)(cS + s0 + 4 * g), c1 = *(const LAS f32x4*)(cS + s0 + 16 + 4 * g);
            f32x4 p0, p1;
#pragma unroll
            for (int r = 0; r < 4; ++r) {
                const int sa = s0 + 4 * g + r, sb = sa + 16;
                p0[r] = (sa <= tq) ? s0v[r] * __builtin_amdgcn_exp2f(bt2 + c0[r]) : 0.f;
                p1[r] = (sb <= tq) ? s1v[r] * __builtin_amdgcn_exp2f(bt2 + c1[r]) : 0.f;
                dpart += p0[r] + p1[r];
            }
            const u32x4 pw = pack8(p0, p1); const bf16x8 pa = __builtin_bit_cast(bf16x8, pw);
#pragma unroll
            for (int dv = 0; dv < 8; ++dv) {
                const LAS unsigned char* vp = Vs + (s0 + 4 * g + (i >> 2)) * VP + (16 * dv + 4 * (i & 3)) * 2;
                acc[dv] = MFMA16(pa, cat4(trread(vp), trread(vp + 16 * VP)), acc[dv]);
            }
        }
        dpart += __shfl_xor(dpart, 16); dpart += __shfl_xor(dpart, 32);
        den += dpart;
        float ss[4], dn[4];
#pragma unroll
        for (int r = 0; r < 4; ++r) { const float d = __shfl(den, 4 * g + r); dn[r] = __builtin_amdgcn_rcpf(fmaxf(fabsf(d), 1.0f)); ss[r] = 0.f; }
#pragma unroll
        for (int dv = 0; dv < 8; ++dv)
#pragma unroll
            for (int r = 0; r < 4; ++r) { acc[dv][r] *= dn[r]; ss[r] += acc[dv][r] * acc[dv][r]; }
#pragma unroll
        for (int r = 0; r < 4; ++r) { float s = ss[r]; s += __shfl_xor(s, 1); s += __shfl_xor(s, 2); s += __shfl_xor(s, 4); s += __shfl_xor(s, 8); ss[r] = __builtin_amdgcn_rsqf(s * (1.0f / 128.0f) + EPS); }
#pragma unroll
        for (int hf = 0; hf < 2; ++hf) {
#pragma unroll
            for (int dq = 0; dq < 4; ++dq) { const int dv = 4 * hf + dq;
#pragma unroll
                for (int r = 0; r < 4; ++r) *(LAS bf16_t*)(ost + (4 * g + r) * 136 + (16 * dq + i) * 2) = (bf16_t)f2bf(acc[dv][r] * ss[r] * gnv[dv]); }
            LDS_WAIT();
#pragma unroll
            for (int q = 0; q < 2; ++q) { const int row = (F.lane >> 3) + 8 * q, ch = F.lane & 7;
                const LAS unsigned* sp = (const LAS unsigned*)(ost + row * 136 + ch * 16);
                const u32x4 hv = (u32x4){sp[0], sp[1], sp[2], sp[3]};
                f32x4 a0, a1, m0, m1; unpack8(hv, a0, a1); unpack8(mo[hf][q], m0, m1);
                *(u32x4*)(WSP(bf16_t, WS_HM) + (size_t)(n0 + 16 * rt + row) * 512 + h * 128 + 64 * hf + 8 * ch) = pack8(a0 * m0, a1 * m1); }
            LDS_WAIT();
        }
    }
    __syncthreads();
}

struct AUnit { int b, grp, h, d, rc, qb, cont; };
__device__ __forceinline__ AUnit attn_decode(int u) { AUnit a; a.b = u / 1536; int r_ = u % 1536; a.grp = r_ / 512; r_ %= 512; a.h = r_ / 128; const int j = r_ % 128;
    a.d = a.grp == 0 ? 1 : (a.grp == 1 ? 4 : 16); const int nb = 128 / a.d; a.rc = j / nb; a.qb = j % nb; a.cont = 0; return a; }
__device__ __forceinline__ void attn_fetch(Frame& F, const AUnit& a, u32x4 (&kr)[4], u32x4 (&vr)[4], bf16x8 (&qf)[2]) {
    const bf16_t* AK = WSP(bf16_t, WS_AK); const bf16_t* AV = WSP(bf16_t, WS_AV); const bf16_t* AQ = WSP(bf16_t, WS_AQ);
    const size_t hoff = (size_t)a.grp * 256 + a.h * 64; const int kk0 = a.qb == 0 ? 128 : 0;
#pragma unroll
    for (int t = 0; t < 4; ++t) { const int c = F.tid + 512 * t, kk = c >> 3, ch = c & 7;
        kr[t] = (u32x4){0u, 0u, 0u, 0u}; vr[t] = kr[t];
        if (kk >= kk0 && !(a.cont && t < 2)) { const int tok = (128 * (a.qb - 1) + kk) * a.d + a.rc; const size_t o = (size_t)(a.b * SEQ + tok) * 768 + hoff + ch * 8; kr[t] = *(const u32x4*)(AK + o); vr[t] = *(const u32x4*)(AV + o); } }
    const int i = F.lane & 15, g = F.lane >> 4; const int tokq = (128 * a.qb + 16 * F.wave + i) * a.d + a.rc;
#pragma unroll
    for (int ks = 0; ks < 2; ++ks) qf[ks] = *(const bf16x8*)(AQ + (size_t)(a.b * SEQ + tokq) * 768 + hoff + 32 * ks + 8 * g);
}
__device__ __forceinline__ void attn_compute(Frame& F, const AUnit& a, const bf16x8 (&qf)[2]) {
    const int b = a.b, grp = a.grp, h = a.h, d = a.d, rc = a.rc, qb = a.qb;
    LAS unsigned char* Ks = F.lds; LAS unsigned char* Vs = F.lds + 256 * KP;
    const int kk0 = qb == 0 ? 128 : 0;
    const int i = F.lane & 15, g = F.lane >> 4, w = F.wave;
    const int qi = 16 * w + i;
    const int tokq = (128 * qb + qi) * d + rc;
    const float slope2 = exp2f(-8.0f * (float)(grp * 4 + h + 1) / 12.0f) * (float)d * LOG2E;
    const int slo = w >> 1;
    f32x4 s0v[5], s1v[5];
    float mx = -INFINITY;
    const int dbase = qi + 128 - 32 * slo - 4 * g;
    const float nb0 = -slope2 * (float)dbase;
#pragma unroll
    for (int si = 0; si < 5; ++si) {
        const int kb = 32 * (slo + si);
        const int pb = (((qb - 1 + (kb >> 7)) & 1) << 7) | (kb & 127);
        f32x4 a0, a1;
#pragma unroll
        for (int r = 0; r < 4; ++r) { a0[r] = nb0 + slope2 * (float)(32 * si + r); a1[r] = nb0 + slope2 * (float)(32 * si + r + 16); }
#pragma unroll
        for (int kk = 0; kk < 2; ++kk) {
            const bf16x8 k0 = *(const LAS bf16x8*)(Ks + (pb + i) * KP + (32 * kk + 8 * g) * 2);
            const bf16x8 k1 = *(const LAS bf16x8*)(Ks + (pb + 16 + i) * KP + (32 * kk + 8 * g) * 2);
            a0 = MFMA16(k0, qf[kk], a0); a1 = MFMA16(k1, qf[kk], a1);
        }
        if (si == 0 || si == 4 || kk0) {
#pragma unroll
            for (int r = 0; r < 4; ++r) {
                const int ka = kb + 4 * g + r, kc = ka + 16;
                const int da = dbase - 32 * si - r, dc = da - 16;
                if (!(da >= 0 && da <= 128 && ka >= kk0)) a0[r] = -INFINITY;
                if (!(dc >= 0 && dc <= 128 && kc >= kk0)) a1[r] = -INFINITY;
            }
        }
#pragma unroll
        for (int r = 0; r < 4; ++r) mx = fmaxf(mx, fmaxf(a0[r], a1[r]));
        s0v[si] = a0; s1v[si] = a1;
    }
    mx = fmaxf(mx, __shfl_xor(mx, 16)); mx = fmaxf(mx, __shfl_xor(mx, 32));
    float den = 0.f;
    f32x4 o[4];
#pragma unroll
    for (int t = 0; t < 4; ++t) o[t] = (f32x4){0.f, 0.f, 0.f, 0.f};
#pragma unroll
    for (int si = 0; si < 5; ++si) {
        const int kb = 32 * (slo + si);
        const int pb = (((qb - 1 + (kb >> 7)) & 1) << 7) | (kb & 127);
        f32x4 p0, p1;
#pragma unroll
        for (int r = 0; r < 4; ++r) { p0[r] = __builtin_amdgcn_exp2f(s0v[si][r] - mx); p1[r] = __builtin_amdgcn_exp2f(s1v[si][r] - mx); den += p0[r] + p1[r]; }
        const u32x4 pw = pack8(p0, p1); const bf16x8 pa = __builtin_bit_cast(bf16x8, pw);
#pragma unroll
        for (int dt = 0; dt < 4; ++dt) {
            const LAS unsigned char* vp = Vs + (pb + 4 * g + (i >> 2)) * KP + (16 * dt + 4 * (i & 3)) * 2;
            o[dt] = MFMA16(pa, cat4(trread(vp), trread(vp + 16 * KP)), o[dt]);
        }
    }
    den += __shfl_xor(den, 16); den += __shfl_xor(den, 32);
    if (g == 0) WSP(float, WS_LSE)[((size_t)grp * NTOK + b * SEQ + tokq) * 4 + h] = mx + __log2f(den);
    bf16_t* AO = WSP(bf16_t, WS_AO) + (size_t)grp * NTOK * 256;
    LAS unsigned char* ost = F.lds + 2 * 256 * KP + w * 2176;
#pragma unroll
    for (int r = 0; r < 4; ++r) {
        const float dn = __builtin_amdgcn_rcpf(__shfl(den, 4 * g + r));
#pragma unroll
        for (int dt = 0; dt < 4; ++dt) *(LAS bf16_t*)(ost + (4 * g + r) * 136 + (16 * dt + i) * 2) = (bf16_t)f2bf(o[dt][r] * dn);
    }
    LDS_WAIT();
#pragma unroll
    for (int q = 0; q < 2; ++q) { const int row = (F.lane >> 3) + 8 * q, ch = F.lane & 7;
        const LAS unsigned* sp = (const LAS unsigned*)(ost + row * 136 + ch * 16);
        const u32x4 hv = (u32x4){sp[0], sp[1], sp[2], sp[3]};
        const int tk = (128 * qb + 16 * w + row) * d + rc;
        *(u32x4*)(AO + (size_t)(b * SEQ + tk) * 256 + h * 64 + 8 * ch) = hv; }
    LDS_WAIT();
}
__device__ __forceinline__ void attn_phase(Frame& F) {
    LAS unsigned char* Ks = F.lds; LAS unsigned char* Vs = F.lds + 256 * KP;
    u32x4 k0[4], v0[4], k1[4], v1[4]; bf16x8 q0[2], q1[2], qc[2];
    const int per = (3072 + F.G - 1) / F.G; const int ub = F.vcu * per, ue = (ub + per < 3072) ? ub + per : 3072;
    int u = ub;
    if (u >= ue) return;
#define ATTN_DEC(A, U) do { A = attn_decode(U); A.cont = ((U) > ub && A.qb != 0) ? 1 : 0; } while (0)
    AUnit c0, c1; ATTN_DEC(c0, u); c1 = c0;
    attn_fetch(F, c0, k0, v0, q0);
    bool has1 = (u + 1) < ue;
    if (has1) { ATTN_DEC(c1, u + 1); attn_fetch(F, c1, k1, v1, q1); }
#define ATTN_STEP(KR, VR, QR, CU, UN) do { \
        _Pragma("unroll") for (int t = 0; t < 4; ++t) { const int c = F.tid + 512 * t, kk = c >> 3, ch = c & 7; \
            const int pr = (((CU.qb - 1 + (kk >> 7)) & 1) << 7) | (kk & 127); \
            if (!(CU.cont && t < 2)) { *(LAS u32x4*)(Ks + pr * KP + ch * 16) = KR[t]; *(LAS u32x4*)(Vs + pr * KP + ch * 16) = VR[t]; } } \
        qc[0] = QR[0]; qc[1] = QR[1]; \
        __syncthreads(); \
        const AUnit cur_ = CU; const int un_ = (UN); const bool hn_ = un_ < ue; \
        if (hn_) { ATTN_DEC(CU, un_); attn_fetch(F, CU, KR, VR, QR); } \
        attn_compute(F, cur_, qc); \
        __syncthreads(); } while (0)
    for (;;) {
        ATTN_STEP(k0, v0, q0, c0, u + 2);
        if (!has1) break;
        ATTN_STEP(k1, v1, q1, c1, u + 3);
        u += 2;
        if (u >= ue) break;
        has1 = (u + 1) < ue;
    }
#undef ATTN_STEP
#undef ATTN_DEC
}

__device__ __forceinline__ void attn_merge(Frame& F) {
    const int gt = F.vcu * 512 + F.tid, NT = F.G * 512;
    const float* LSE = WSP(float, WS_LSE); const bf16_t* AO = WSP(bf16_t, WS_AO);
    for (int idx = gt; idx < NTOK * 32; idx += NT) {
        const int n = idx >> 5, ch = idx & 31, h = ch >> 3;
        const float l0 = LSE[((size_t)0 * NTOK + n) * 4 + h], l1 = LSE[((size_t)1 * NTOK + n) * 4 + h], l2 = LSE[((size_t)2 * NTOK + n) * 4 + h];
        const float m = fmaxf(l0, fmaxf(l1, l2));
        float w0 = __builtin_amdgcn_exp2f(l0 - m), w1 = __builtin_amdgcn_exp2f(l1 - m), w2 = __builtin_amdgcn_exp2f(l2 - m);
        const float inv = 1.0f / (w0 + w1 + w2); w0 *= inv; w1 *= inv; w2 *= inv;
        f32x4 a0, a1, b0, b1, c0, c1;
        unpack8(*(const u32x4*)(AO + ((size_t)0 * NTOK + n) * 256 + ch * 8), a0, a1);
        unpack8(*(const u32x4*)(AO + ((size_t)1 * NTOK + n) * 256 + ch * 8), b0, b1);
        unpack8(*(const u32x4*)(AO + ((size_t)2 * NTOK + n) * 256 + ch * 8), c0, c1);
        *(u32x4*)(WSP(bf16_t, WS_HA) + (size_t)n * 512 + ch * 8) = pack8(a0 * w0 + b0 * w1 + c0 * w2, a1 * w0 + b1 * w1 + c1 * w2);
    }
}

__device__ __forceinline__ void route_phase(Frame& F) {
    constexpr int WP = 2064;
    LAS unsigned char* WRs = F.lds;
    LAS int* lcnt = (LAS int*)(F.lds + 32 * WP); LAS int* lbase = lcnt + 32;
    const int i = F.lane & 15, g = F.lane >> 4, w = F.wave;
    const bf16_t* X1B = WSP(bf16_t, WS_X1B); const bf16_t* WR = WSP(bf16_t, WS_WR);
    bool staged = false;
    for (int blk = F.vcu; blk < NTOK / 128; blk += F.G) {
        const int row0 = blk * 128 + 16 * w;
        bf16x8 af[32];
#pragma unroll
        for (int ks = 0; ks < 32; ++ks) af[ks] = *(const bf16x8*)(X1B + (size_t)(row0 + i) * DM + 32 * ks + 8 * g);
        if (!staged) { for (int c = F.tid; c < 32 * 128; c += 512) { const int e = c >> 7, ch = c & 127; *(LAS u32x4*)(WRs + e * WP + ch * 16) = *(const u32x4*)(WR + (size_t)e * DM + ch * 8); } staged = true; }
        if (F.tid < 32) lcnt[F.tid] = 0;
        __syncthreads();
        float ssq;
        { const f32x4* sp = (const f32x4*)(WSP(float, WS_SSQ) + (size_t)(row0 + i) * 16); const f32x4 a = sp[0], b = sp[1], c = sp[2], d4 = sp[3];
          ssq = (a[0] + a[1] + a[2] + a[3]) + (b[0] + b[1] + b[2] + b[3]) + (c[0] + c[1] + c[2] + c[3]) + (d4[0] + d4[1] + d4[2] + d4[3]); }
        const float rstd = __builtin_amdgcn_rsqf(ssq * (1.0f / DM) + EPS);
        f32x4 acc[2]; acc[0] = (f32x4){0.f, 0.f, 0.f, 0.f}; acc[1] = acc[0];
#pragma unroll
        for (int ks = 0; ks < 32; ++ks) {
            const bf16x8 b0 = *(const LAS bf16x8*)(WRs + i * WP + (32 * ks + 8 * g) * 2);
            const bf16x8 b1 = *(const LAS bf16x8*)(WRs + (16 + i) * WP + (32 * ks + 8 * g) * 2);
            acc[0] = MFMA16(af[ks], b0, acc[0]); acc[1] = MFMA16(af[ks], b1, acc[1]);
        }
        const float br0 = INP(I_BR)[i], br1 = INP(I_BR)[16 + i];
        float tv[4][4]; int ti[4][4];
#pragma unroll
        for (int r = 0; r < 4; ++r) {
            const float rs = __shfl(rstd, 4 * g + r);
            float v0 = rs * acc[0][r] + br0, v1 = rs * acc[1][r] + br1;
#pragma unroll
            for (int k = 0; k < 4; ++k) {
                float bv = v0; int bi = i; if (v1 > bv) { bv = v1; bi = 16 + i; }
#pragma unroll
                for (int o = 1; o < 16; o <<= 1) { const float ov = __shfl_xor(bv, o); const int oi = __shfl_xor(bi, o); if (ov > bv || (ov == bv && oi < bi)) { bv = ov; bi = oi; } }
                tv[r][k] = bv; ti[r][k] = bi;
                if (bi == i) v0 = -INFINITY; if (bi == 16 + i) v1 = -INFINITY;
            }
        }
        float mv = 0.f, ssum = 0.f; int me = 0;
#pragma unroll
        for (int r = 0; r < 4; ++r) {
            const float e0 = 1.0f, e1 = __expf(tv[r][1] - tv[r][0]), e2 = __expf(tv[r][2] - tv[r][0]), e3 = __expf(tv[r][3] - tv[r][0]);
            const float s = e0 + e1 + e2 + e3;
            if ((i >> 2) == r) { ssum = s;
                const int k = i & 3; mv = k == 0 ? e0 : (k == 1 ? e1 : (k == 2 ? e2 : e3)); me = k == 0 ? ti[r][0] : (k == 1 ? ti[r][1] : (k == 2 ? ti[r][2] : ti[r][3])); }
        }
        const float gate = mv / ssum;
        const int tok = row0 + 4 * g + (i >> 2);
        const float myrstd = __shfl(rstd, 4 * g + (i >> 2));
        const int rank = __hip_atomic_fetch_add(lcnt + me, 1, __ATOMIC_RELAXED, __HIP_MEMORY_SCOPE_WORKGROUP);
        __syncthreads();
        if (F.tid < 32) lbase[F.tid] = (int)__hip_atomic_fetch_add(WSP(unsigned, WS_CTL) + CW_CNT + F.tid, (unsigned)lcnt[F.tid], RLX_AGENT);
        __syncthreads();
        const int pos = lbase[me] + rank;
        WSP(int, WS_TOPE)[(size_t)tok * 4 + (i & 3)] = me;
        WSP(int, WS_TOPPOS)[(size_t)tok * 4 + (i & 3)] = pos;
        WSP(int, WS_LIST)[(size_t)me * NTOK + pos] = tok;
        WSP(float, WS_GLIST)[(size_t)me * NTOK + pos] = gate;
        WSP(float, WS_SRSTD)[(size_t)me * NTOK + pos] = myrstd;
        __syncthreads();
    }
}

__device__ __forceinline__ void combine_phase(Frame& F) {
    const LAS int* tab = (const LAS int*)(F.lds + TAB_OFF);
    const int gw = F.vcu * 8 + F.wave, NGW = F.G * 8;
    const unsigned char* Y2 = F.ws + WS_Y2;
    const int c = F.lane * 16;
    for (int n0 = gw * 2; n0 < NTOK; n0 += NGW * 2) {
        size_t ro[2][4];
#pragma unroll
        for (int t = 0; t < 2; ++t) { const u32x4 ev = *(const u32x4*)(WSP(int, WS_TOPE) + (size_t)(n0 + t) * 4), pv = *(const u32x4*)(WSP(int, WS_TOPPOS) + (size_t)(n0 + t) * 4);
#pragma unroll
            for (int k = 0; k < 4; ++k) ro[t][k] = (size_t)(tab[40 + (int)ev[k]] + (int)pv[k]) * 1024 + c; }
        f32x4 s[2][4]; u32x4 y[2][4];
#pragma unroll
        for (int t = 0; t < 2; ++t) {
            { const bf16_t* xb = WSP(bf16_t, WS_X1B) + (size_t)(n0 + t) * DM + c; unpack8(*(const u32x4*)xb, s[t][0], s[t][1]); unpack8(*(const u32x4*)(xb + 8), s[t][2], s[t][3]); }
#pragma unroll
            for (int k = 0; k < 4; ++k) y[t][k] = *(const u32x4*)(Y2 + ro[t][k]); }
#pragma unroll
        for (int t = 0; t < 2; ++t) {
            f32x4 m4[4];
#pragma unroll
            for (int q = 0; q < 4; ++q) m4[q] = (f32x4){0.f, 0.f, 0.f, 0.f};
#pragma unroll
            for (int k = 0; k < 4; ++k)
#pragma unroll
                for (int q = 0; q < 4; ++q) { const f32x2 lo = __builtin_amdgcn_cvt_pk_f32_fp8((int)y[t][k][q], false), hi = __builtin_amdgcn_cvt_pk_f32_fp8((int)y[t][k][q], true);
                    m4[q][0] += lo[0]; m4[q][1] += lo[1]; m4[q][2] += hi[0]; m4[q][3] += hi[1]; }
#pragma unroll
            for (int q = 0; q < 4; ++q) *(f32x4*)(F.out + (size_t)(n0 + t) * DM + c + 4 * q) = s[t][q] + m4[q] * 0.0625f; }
    }
}

__global__ void __launch_bounds__(512, 2) hyb_fwd(Args args) {
    extern __shared__ __attribute__((aligned(16))) unsigned char lds[];
    Frame F;
    F.lds = (LAS unsigned char*)lds;
    F.tid = threadIdx.x; F.lane = F.tid & 63; F.wave = __builtin_amdgcn_readfirstlane(F.tid >> 6);
#define REFRESH_IDS() do { } while (0)
    F.G = gridDim.x; { const int bx = blockIdx.x; F.vcu = (F.G % 8 == 0) ? (bx % 8) * (F.G / 8) + bx / 8 : bx; }
    F.ap = (KArgP)__builtin_amdgcn_kernarg_segment_ptr(); F.out = args.out; F.ws = args.ws;
    volatile LAS unsigned* MISC = (volatile LAS unsigned*)(F.lds + MISC_OFF);
    for (int u = F.tid; u < 32; u += 512) MISC[u] = 0u;
    __syncthreads();
    const int lo = args.ph_lo, hi = args.ph_hi & 255, variant = args.ph_hi >> 8;
    XcdBarrier bar; bar.bar = WSP(unsigned, WS_CTL) + CW_BAR; bar.x = 0; bar.st = nullptr;
    if (hi - lo > 1) bar = xcd_barrier_post(WSP(unsigned, WS_CTL) + CW_BAR, MISC + 8, F.tid == 0);
#define IN(k) (lo <= (k) && (k) < hi)
#define SEAM(k) do { if (IN(k) && IN((k) + 1)) { REFRESH_IDS(); xcd_barrier(bar, F.tid == 0); } REFRESH_IDS(); } while (0)

    if (IN(0)) { p0_prologue(F); } SEAM(0);

    if (IN(1)) {
        { SchedInProj S; S.T.init(NTOK / 256, FP8_FROM, F.G, (int)blockIdx.x); S.A = (const char*)WSP(bf16_t, WS_XN); S.B = (const char*)WSP(bf16_t, WS_WIN);
          EpiInProj E{F.ws, INP(I_AQG), INP(I_AKG), 1.0f};
          g8::gemm_phase<EpiInProj, SchedInProj, false>(F.lds, S, E, 2048u, 2048u, F.tid, F.wave); }
        { SchedInProj8 S; S.T.init(NTOK / 256, 23 - FP8_FROM, F.G, (int)blockIdx.x); S.A = (const char*)(F.ws + WS_XN8); S.B = (const char*)(F.ws + WS_WIN8);
          EpiInProj E{F.ws, INP(I_AQG), INP(I_AKG), 0.03125f};
          g8::gemm_phase<EpiInProj, SchedInProj8, true, 1>(F.lds, S, E, 1024u, 1024u, F.tid, F.wave); }
    } SEAM(1);

    if (IN(2)) {
        if (variant != 2) for (int u = F.vcu; u < 512; u += F.G) mlstm_state_unit(F, u);
        if (variant != 1) attn_phase(F);
    } SEAM(2);

    if (IN(3)) { mlstm_scan(F); } SEAM(3);

    if (IN(4)) {
        for (int u = F.vcu; u < 512; u += F.G) mlstm_out_unit(F, u);
        attn_merge(F);
    } SEAM(4);

    if (IN(5)) {
        SchedBranch S; S.T.init(NTOK / 256, 4, F.G, (int)blockIdx.x);
        S.A0 = (const char*)WSP(bf16_t, WS_HM); S.B0 = (const char*)WSP(bf16_t, WS_WM); S.A1 = (const char*)WSP(bf16_t, WS_HA); S.B1 = (const char*)WSP(bf16_t, WS_WA);
        EpiBranch E{WSP(bf16_t, WS_GM), WSP(bf16_t, WS_GA), WSP(bf16_t, WS_Y)};
        g8::gemm_phase<EpiBranch, SchedBranch, false>(F.lds, S, E, 1024u, 1024u, F.tid, F.wave);
    } SEAM(5);

    if (IN(6)) {
        SchedWout S; S.T.init(NTOK / 256, 4, F.G, (int)blockIdx.x); S.A = (const char*)WSP(bf16_t, WS_Y); S.B = (const char*)WSP(bf16_t, WS_WO);
        EpiWout E{WSP(bf16_t, WS_XN), WSP(bf16_t, WS_X1B), F.ws + WS_X1F8, WSP(float, WS_SSQ)};
        g8::gemm_phase<EpiWout, SchedWout, false>(F.lds, S, E, 2048u, 2048u, F.tid, F.wave);
    } SEAM(6);

    if (IN(7)) { route_phase(F); } SEAM(7);

    if (IN(8)) {
        moe_tables(F);
        const LAS int* tab = (const LAS int*)(F.lds + TAB_OFF);
        SchedMoe<8, true> S; S.T.init(__builtin_amdgcn_readfirstlane(tab[32]), 8, F.G, (int)blockIdx.x); S.tab = tab; S.A = (const char*)(F.ws + WS_X1F8); S.B = (const char*)(F.ws + WS_W1); S.LIST = WSP(int, WS_LIST);
        EpiMoe1 E{WSP(float, WS_SRSTD), INP(I_B1), F.ws + WS_H};
        g8::gemm_phase<EpiMoe1, SchedMoe<8, true>, true, 1, G8_LATE_MOE>(F.lds, S, E, 1024u, 1024u, F.tid, F.wave);
    } SEAM(8);

    if (IN(9)) {
        if (lo == 9) moe_tables(F);
        const LAS int* tab = (const LAS int*)(F.lds + TAB_OFF);
        SchedMoe<4, false> S; S.T.init(__builtin_amdgcn_readfirstlane(tab[32]), 4, F.G, (int)blockIdx.x); S.tab = tab; S.A = (const char*)(F.ws + WS_H); S.B = (const char*)(F.ws + WS_W2); S.LIST = WSP(int, WS_LIST);
        EpiMoe2 E{WSP(float, WS_GLIST), INP(I_B2), F.ws + WS_Y2};
        g8::gemm_phase<EpiMoe2, SchedMoe<4, false>, true, 1, G8_LATE_MOE>(F.lds, S, E, 1024u, 1024u, F.tid, F.wave);
    } SEAM(9);

    if (IN(10)) { if (lo == 10) moe_tables(F); combine_phase(F); }
#undef IN
#undef SEAM
}

extern "C" void kernel_launch(void* const* d_in, const int* in_sizes, int n_in, void* d_out, int out_size, void* d_ws, size_t ws_size, hipStream_t stream) {
    static int grid = 0;
    if (grid == 0) {
        if (n_in != 17 || out_size != NTOK * DM || ws_size < WS_NEED) { fprintf(stderr, "kernel_launch: unexpected problem (n_in %d, out %d, ws %zu, need %zu)\n", n_in, out_size, ws_size, (size_t)WS_NEED); grid = -1; return; }
        int dev = 0, cus = 0;
        if (hipGetDevice(&dev) != hipSuccess || hipDeviceGetAttribute(&cus, hipDeviceAttributeMultiprocessorCount, dev) != hipSuccess) { grid = -1; return; }
        if (hipFuncSetAttribute((const void*)hyb_fwd, hipFuncAttributeMaxDynamicSharedMemorySize, LDS_BYTES) != hipSuccess) { fprintf(stderr, "kernel_launch: hipFuncSetAttribute failed\n"); grid = -1; return; }
        int per_cu = 0;
        if (hipOccupancyMaxActiveBlocksPerMultiprocessor(&per_cu, (const void*)hyb_fwd, 512, LDS_BYTES) != hipSuccess || per_cu < 1) fprintf(stderr, "kernel_launch: occupancy query reports %d\n", per_cu);
        (void)hipGetLastError();
        grid = cus;
    }
    if (grid < 0) return;
    (void)hipMemsetAsync((char*)d_ws + WS_CTL, 0, CTL_ZERO_BYTES, stream);
    Args a{};
    for (int i = 0; i < 17; ++i) a.in[i] = (const float*)d_in[i];
    a.out = (float*)d_out; a.ws = (unsigned char*)d_ws;
    if (MK_N_LAUNCHES == 1) { a.ph_lo = 0; a.ph_hi = NPH; hipLaunchKernelGGL(hyb_fwd, dim3(grid), dim3(512), LDS_BYTES, stream, a); }
    else { for (int p = 0; p < (MAXPH < NPH ? MAXPH : NPH); ++p) { a.ph_lo = p; a.ph_hi = p + 1;
            if (p == DUP_PHASE && p == 7) { hipLaunchKernelGGL(hyb_fwd, dim3(grid), dim3(512), LDS_BYTES, stream, a); (void)hipMemsetAsync((char*)d_ws + WS_CTL + CW_CNT * 4, 0, 128, stream); }
            hipLaunchKernelGGL(hyb_fwd, dim3(grid), dim3(512), LDS_BYTES, stream, a);
            if (p == DUP_PHASE && p == 10) { Args a2 = a; a2.out = (float*)((unsigned char*)d_ws + WS_H); hipLaunchKernelGGL(hyb_fwd, dim3(grid), dim3(512), LDS_BYTES, stream, a2); }
            else if (p == DUP_PHASE && p != 7) { Args a2 = a; a2.ph_hi = a.ph_hi + 256 * DUP_VARIANT; hipLaunchKernelGGL(hyb_fwd, dim3(grid), dim3(512), LDS_BYTES, stream, a2); } } }
}
```

```cpp
#include <hip/hip_runtime.h>
#include <cstdio>
#include <cstdint>

#ifndef MK_N_LAUNCHES
#define MK_N_LAUNCHES 1
#endif

#ifndef MAXPH
#define MAXPH 99
#endif
#ifndef DUP_PHASE
#define DUP_PHASE -1
#endif
#ifndef DUP_VARIANT
#define DUP_VARIANT 0
#endif
#define LAS __attribute__((address_space(3)))
#define GAS __attribute__((address_space(1)))
typedef unsigned short bf16_t;
typedef short bf16x8 __attribute__((ext_vector_type(8)));
typedef short s16x4 __attribute__((ext_vector_type(4)));
typedef float f32x4 __attribute__((ext_vector_type(4)));
typedef float f32x2 __attribute__((ext_vector_type(2)));
typedef unsigned u32x4 __attribute__((ext_vector_type(4)));
typedef unsigned u32x2 __attribute__((ext_vector_type(2)));
typedef int v8i_t __attribute__((ext_vector_type(8)));
typedef int v4i_t __attribute__((ext_vector_type(4)));
template <int MODE> struct FragT { typedef bf16x8 type; };
template <> struct FragT<1> { typedef v4i_t type; };

constexpr int NTOK = 32768, SEQ = 16384, DM = 1024;
constexpr int NEXP = 32, DFF = 1024;
constexpr float EPS = 1e-6f;
constexpr float LOG2E = 1.4426950408889634f;
constexpr int NPH = 11;

constexpr size_t MiB = 1u << 20;
constexpr size_t WS_CTL = 0, CTL_ZERO_BYTES = 1 * MiB;
constexpr size_t WS_GATES = 1 * MiB;
constexpr size_t WS_SSQ = 2 * MiB;
constexpr size_t WS_LSE = 4 * MiB;
constexpr size_t WS_TOPE = 6 * MiB;
constexpr size_t WS_TOPPOS = 7 * MiB;
constexpr size_t WS_LIST = 8 * MiB;
constexpr size_t WS_GLIST = 12 * MiB;
constexpr size_t WS_SRSTD = 16 * MiB;
constexpr size_t WS_MSTAT = 20 * MiB;
constexpr size_t WS_RSTD1 = 20 * MiB + 512 * 1024;
constexpr size_t WS_WIN = 21 * MiB;
constexpr size_t WS_WM = 33 * MiB;
constexpr size_t WS_WA = 34 * MiB;
constexpr size_t WS_WO = 35 * MiB;
constexpr size_t WS_WR = 37 * MiB;
constexpr size_t WS_W1 = 38 * MiB;
constexpr size_t WS_W2 = 102 * MiB;
constexpr size_t WS_X1B = 134 * MiB;
constexpr size_t WS_X1F8 = 198 * MiB;
constexpr size_t WS_OVL = 230 * MiB;
constexpr size_t WS_XN = WS_OVL;
constexpr size_t WS_MQ = WS_XN + 64 * MiB;
constexpr size_t WS_MK = WS_MQ + 16 * MiB;
constexpr size_t WS_MV = WS_MK + 16 * MiB;
constexpr size_t WS_MO = WS_MV + 32 * MiB;
constexpr size_t WS_AQ = WS_MO + 32 * MiB;
constexpr size_t WS_AK = WS_AQ + 48 * MiB;
constexpr size_t WS_AV = WS_AK + 48 * MiB;
constexpr size_t WS_GM = WS_AV + 48 * MiB;
constexpr size_t WS_GA = WS_GM + 64 * MiB;
constexpr size_t WS_CLOC = WS_GA + 64 * MiB;
constexpr size_t WS_HM = WS_CLOC + 16 * MiB;
constexpr size_t WS_AO = WS_HM + 32 * MiB;
constexpr size_t WS_HA = WS_AO + 48 * MiB;
constexpr size_t WS_Y = WS_HA + 32 * MiB;
constexpr size_t WS_CINIT = WS_Y + 64 * MiB;
constexpr size_t WS_NINIT = WS_CINIT + 16 * MiB;
constexpr size_t WS_XN8 = WS_NINIT + 1 * MiB;
constexpr size_t WS_WIN8 = WS_XN8 + 32 * MiB;
constexpr size_t WS_END1 = WS_WIN8 + 6 * MiB;
constexpr size_t WS_H = WS_OVL;
constexpr size_t WS_Y2 = WS_OVL + 130 * MiB;
constexpr size_t WS_END2 = WS_Y2 + 256 * MiB;
constexpr size_t WS_NEED = (WS_END1 > WS_END2 ? WS_END1 : WS_END2);

constexpr int CW_CNT = 64;
constexpr int CW_BAR = 4096;

constexpr int RING_BYTES = 131072;
constexpr int TAB_OFF = RING_BYTES;
constexpr int ROWBUF_OFF = RING_BYTES + 1024;
constexpr int TAB_OFF_UNUSED = 0;
constexpr int LDS_BYTES = 163840;
constexpr int MISC_OFF = LDS_BYTES - 256;

#define LOG2E_ 1.4426950408889634f
#define LDS_WAIT() asm volatile("s_waitcnt lgkmcnt(0)" ::: "memory")
#define VM_WAIT() asm volatile("s_waitcnt vmcnt(0)" ::: "memory")
__device__ __forceinline__ unsigned f2bf(float f) { unsigned u = __builtin_bit_cast(unsigned, f); return (u + 0x7fffu + ((u >> 16) & 1u)) >> 16; }
typedef __bf16 bf16x2_hw __attribute__((ext_vector_type(2)));
__device__ __forceinline__ unsigned pk2(float lo, float hi) { const f32x2 v = {lo, hi}; return __builtin_bit_cast(unsigned, __builtin_convertvector(v, bf16x2_hw)); }
__device__ __forceinline__ float bflo(unsigned w) { return __builtin_bit_cast(float, w << 16); }
__device__ __forceinline__ float bfhi(unsigned w) { return __builtin_bit_cast(float, w & 0xffff0000u); }
__device__ __forceinline__ float bf2f(bf16_t h) { return __builtin_bit_cast(float, (unsigned)h << 16); }
__device__ __forceinline__ float sigmoidf_(float x) { return __builtin_amdgcn_rcpf(1.0f + __builtin_amdgcn_exp2f(-LOG2E_ * x)); }
__device__ __forceinline__ u32x4 pack8(const f32x4 a, const f32x4 b) { u32x4 w; w.x = pk2(a[0], a[1]); w.y = pk2(a[2], a[3]); w.z = pk2(b[0], b[1]); w.w = pk2(b[2], b[3]); return w; }
__device__ __forceinline__ void unpack8(const u32x4 w, f32x4& a, f32x4& b) { a[0] = bflo(w.x); a[1] = bfhi(w.x); a[2] = bflo(w.y); a[3] = bfhi(w.y); b[0] = bflo(w.z); b[1] = bfhi(w.z); b[2] = bflo(w.w); b[3] = bfhi(w.w); }
__device__ __forceinline__ u32x2 pack8_fp8(const f32x4 a, const f32x4 b) { int w0 = 0, w1 = 0;
    w0 = __builtin_amdgcn_cvt_pk_fp8_f32(a[0], a[1], w0, false); w0 = __builtin_amdgcn_cvt_pk_fp8_f32(a[2], a[3], w0, true);
    w1 = __builtin_amdgcn_cvt_pk_fp8_f32(b[0], b[1], w1, false); w1 = __builtin_amdgcn_cvt_pk_fp8_f32(b[2], b[3], w1, true); return (u32x2){(unsigned)w0, (unsigned)w1}; }
#ifndef ST_WT
#define ST_WT 0
#endif
__device__ __forceinline__ void st16(void* p, const u32x4 v) {
#if ST_WT
    asm volatile("global_store_dwordx4 %0, %1, off sc1\n\ts_nop 1" :: "v"(p), "v"(v) : "memory");
#else
    *(u32x4*)p = v;
#endif
}
typedef short v4i16_t __attribute__((ext_vector_type(4)));
__device__ __forceinline__ s16x4 trread(const LAS unsigned char* p) { return __builtin_bit_cast(s16x4, __builtin_amdgcn_ds_read_tr16_b64_v4i16((LAS v4i16_t*)p)); }
__device__ __forceinline__ bf16x8 cat4(s16x4 lo, s16x4 hi) { return (bf16x8){lo[0], lo[1], lo[2], lo[3], hi[0], hi[1], hi[2], hi[3]}; }
#define MFMA16(a, b, c) __builtin_amdgcn_mfma_f32_16x16x32_bf16((a), (b), (c), 0, 0, 0)

namespace g8 {
#ifndef G8_LATE_MOE
#define G8_LATE_MOE false
#endif
#ifndef G8_LATE_BF
#define G8_LATE_BF false
#endif
#ifndef FP8_FROM
#define FP8_FROM 4
#endif
#ifndef G8_WGM
#define G8_WGM 4
#endif
constexpr int BM = 256, BK = 64, HALF = 128, HTB = HALF * BK * 2, NXCD = 8, WGM = G8_WGM;
__device__ __forceinline__ int lds_byte(int r, int c) { const int st = (r >> 4) * 2 + (c >> 5), rr = r & 15, cc = c & 31, ob = rr * 64 + cc * 2; return st * 1024 + (ob ^ (((ob >> 9) & 1) << 5)); }
__device__ __forceinline__ void stage_rc(int b, int& R, int& C) { const int st = b / 1024, sb = b % 1024, swz = sb ^ (((sb >> 9) & 1) << 5); R = (st >> 1) * 16 + swz / 64; C = (st & 1) * 32 + (swz % 64) / 2; }
__device__ __forceinline__ int perm32(int rho) { const int n = rho >> 4, i = rho & 15; return 8 * (i >> 2) + 4 * n + (i & 3); }

struct GUnit { const char* A; const char* B; int nt; int pm, pn, sel, e, rt, x, y; };

struct TileOrder {
    int nM, nN, nwg, G, c;
    __device__ __forceinline__ void init(int nM_, int nN_, int G_, int c_) { nM = nM_; nN = nN_; nwg = nM * nN; G = G_; c = c_; }
    __device__ __forceinline__ bool tile(int i, int& pm, int& pn) const {
        const long L = (long)i * G + c; if (L >= nwg) return false;
        int wgid = (int)L; { const int q = nwg / NXCD, r = nwg % NXCD, xcd = wgid % NXCD, off = wgid / NXCD; wgid = (xcd < r ? xcd * (q + 1) : r * (q + 1) + (xcd - r) * q) + off; }
        const int nig = WGM * nN, gid = wgid / nig, fm = gid * WGM, gsz = (nM - fm) < WGM ? (nM - fm) : WGM;
        pm = fm + ((wgid % nig) % gsz); pn = (wgid % nig) / gsz; return true;
    }
};

template <class Epi, class Sched, bool GATHER, int MODE = 0, bool LATE = false>
__device__ __forceinline__ void gemm_phase(LAS unsigned char* lds, const Sched& S, const Epi& E, const unsigned pitchA, const unsigned pitchB, const int tid, const int wid) {
    const int lane = tid & 63, wr = wid >> 2, wc = wid & 3, fr = lane & 15, fq = lane >> 4;
    unsigned voffB[2]; unsigned offC[2][2];
    LAS unsigned* rowbuf = (LAS unsigned*)(lds + ROWBUF_OFF);
#pragma unroll
    for (int i = 0; i < 2; ++i) { int R, C; stage_rc(tid * 16 + i * 8192, R, C); const int Rb = (R & ~31) + perm32(R & 31);
        voffB[i] = (unsigned)Rb * pitchB + (unsigned)C * 2u; }
    const unsigned hstepB = (unsigned)HALF * pitchB, hstepA = (unsigned)HALF * pitchA;
    const size_t kstep = (size_t)(BK * 2);
    const unsigned ldsw = (unsigned)wid * 1024u;
    const int aoff = lds_byte(wr * 64 + fr, fq * 8), boff = lds_byte(wc * 32 + fr, fq * 8);
#define G8_SA(b, h) (((b) * 2 + (h)) * HTB)
#define G8_SB(b, h) ((4 + (b) * 2 + (h)) * HTB)
#define G8_STAGE_B(bufoff, gbase, h) do { const char* _gp = (const char*)(gbase) + (h) * hstepB; asm volatile("" : "+s"(_gp)); _Pragma("unroll") for (int _i = 0; _i < 2; ++_i) \
        __builtin_amdgcn_global_load_lds((const unsigned*)(_gp + voffB[_i]), (LAS unsigned*)(lds + (bufoff) + ldsw + _i * 8192), 16, 0, 0); } while (0)
#define G8_STAGE_A(bufoff, gbase, hh) do { const char* _gp = (const char*)(gbase) + (GATHER ? 0u : (hh) * hstepA); asm volatile("" : "+s"(_gp)); const unsigned* offs = offC[GATHER ? (hh) : 0]; _Pragma("unroll") for (int _i = 0; _i < 2; ++_i) \
        __builtin_amdgcn_global_load_lds((const unsigned*)(_gp + (offs)[_i]), (LAS unsigned*)(lds + (bufoff) + ldsw + _i * 8192), 16, 0, 0); } while (0)
#define G8_LDA(dst, b, h) do { _Pragma("unroll") for (int m = 0; m < 4; ++m) _Pragma("unroll") for (int k = 0; k < 2; ++k) dst[m][k] = *(const LAS frag_t*)(lds + G8_SA(b, h) + aoff + m * 2048 + k * 1024); } while (0)
#define G8_LDB(dst, b, h) do { _Pragma("unroll") for (int n = 0; n < 2; ++n) _Pragma("unroll") for (int k = 0; k < 2; ++k) dst[n][k] = *(const LAS frag_t*)(lds + G8_SB(b, h) + boff + n * 2048 + k * 1024); } while (0)
#define G8_CAT(x) __builtin_shufflevector((x)[0], (x)[1], 0, 1, 2, 3, 4, 5, 6, 7)
#define G8_MMA(ai, bj, At, Bt) do { __builtin_amdgcn_s_setprio(1); _Pragma("unroll") for (int m = 0; m < 4; ++m) _Pragma("unroll") for (int n = 0; n < 2; ++n) { \
        if constexpr (MODE == 0) { _Pragma("unroll") for (int k = 0; k < 2; ++k) acc[ai][bj][m][n] = __builtin_amdgcn_mfma_f32_16x16x32_bf16(Bt[n][k], At[m][k], acc[ai][bj][m][n], 0, 0, 0); } \
        else { const v8i_t _b8 = G8_CAT(Bt[n]), _a8 = G8_CAT(At[m]); asm volatile("v_mfma_f32_16x16x128_f8f6f4 %0, %1, %2, %0" : "+v"(acc[ai][bj][m][n]) : "v"(_b8), "v"(_a8)); } } \
        __builtin_amdgcn_s_setprio(0); } while (0)
#define G8_SWITCH() do { if constexpr (GATHER) { if (last && has_next) { int t2_ = tid; asm volatile("" : "+v"(t2_)); \
        _Pragma("unroll") for (int h = 0; h < 2; ++h) _Pragma("unroll") for (int i = 0; i < 2; ++i) { int R_, C_; stage_rc(t2_ * 16 + i * 8192, R_, C_); offC[h][i] = S.arow_lds(nxt, h * HALF + R_, rowbuf) + (unsigned)C_ * 2u; } \
        asm volatile("s_waitcnt lgkmcnt(0)" : "+v"(offC[0][0]), "+v"(offC[0][1]), "+v"(offC[1][0]), "+v"(offC[1][1]) :: "memory"); } } } while (0)
#define G8_WAIT_V(n) asm volatile("s_waitcnt vmcnt(" #n ")" ::: "memory")
#define G8_WAIT_L(n) asm volatile("s_waitcnt lgkmcnt(" #n ")" ::: "memory")
#define G8_BAR __builtin_amdgcn_s_barrier()
#define G8_SCHED __builtin_amdgcn_sched_barrier(0)
    GUnit cur, nxt; int ui = 0;
    if (!S.next(0, cur)) return;
    f32x4 acc[2][2][4][2];
#pragma unroll
    for (int a = 0; a < 2; ++a)
#pragma unroll
        for (int b = 0; b < 2; ++b)
#pragma unroll
            for (int m = 0; m < 4; ++m)
#pragma unroll
                for (int n = 0; n < 2; ++n) acc[a][b][m][n] = (f32x4){0.f, 0.f, 0.f, 0.f};
    typedef typename FragT<MODE>::type frag_t;
    frag_t At[4][2], B0[2][2], B1[2][2];
    const char* cA = cur.A; const char* cB = cur.B;
#pragma unroll
    for (int h = 0; h < 2; ++h)
#pragma unroll
        for (int i = 0; i < 2; ++i) { int R, C; stage_rc(tid * 16 + i * 8192, R, C);
            if constexpr (GATHER) offC[h][i] = S.arow(cur, h * HALF + R) + (unsigned)C * 2u;
            else offC[h][i] = (unsigned)R * pitchA + (unsigned)C * 2u;
        }
    if constexpr (GATHER) { asm volatile("s_waitcnt vmcnt(0)" : "+v"(offC[0][0]), "+v"(offC[0][1]), "+v"(offC[1][0]), "+v"(offC[1][1]) :: "memory"); }
    E.aux_dma(cur, lds + ROWBUF_OFF + 1024, 0, wid, lane);
    G8_STAGE_B(G8_SB(0, 0), cB, 0); G8_STAGE_B(G8_SB(0, 1), cB, 1); G8_STAGE_A(G8_SA(0, 0), cA, 0); G8_STAGE_A(G8_SA(0, 1), cA, 1);
    if (wr == 1) G8_BAR;
    G8_WAIT_V(2); G8_BAR;
    G8_STAGE_B(G8_SB(1, 0), cB + kstep, 0); G8_STAGE_A(G8_SA(1, 0), cA + kstep, 0); G8_STAGE_B(G8_SB(1, 1), cB + kstep, 1);
    G8_WAIT_V(6); G8_BAR;
    for (;;) {
        const bool has_next = S.next(ui + 1, nxt);
        const char* nA = has_next ? nxt.A : cA; const char* nB = has_next ? nxt.B : cB;
        if constexpr (GATHER) { if (has_next) S.rows_dma(nxt, rowbuf, wid, lane); }
        const int nt = cur.nt;
#pragma unroll 1
        for (int t = 0; t < nt; t += 2) {
            const bool last = (t == nt - 2);
            const char* a1 = cA + (size_t)(t + 1) * kstep;
            const char* a2 = last ? nA : cA + (size_t)(t + 2) * kstep; const char* b2 = last ? nB : cB + (size_t)(t + 2) * kstep;
            const char* a3 = a2 + kstep; const char* b3 = b2 + kstep;
            if constexpr (!LATE) {
            G8_LDB(B0, 0, 0); G8_LDB(B1, 0, 1); G8_SCHED; G8_LDA(At, 0, 0); G8_STAGE_A(G8_SA(1, 1), a1, 1);
            G8_WAIT_V(8); G8_WAIT_L(0); G8_BAR; G8_MMA(0, 0, At, B0); G8_MMA(0, 1, At, B1); G8_BAR; G8_SCHED;
            G8_SWITCH();
            G8_LDA(At, 0, 1); G8_STAGE_B(G8_SB(0, 0), b2, 0); G8_STAGE_B(G8_SB(0, 1), b2, 1); G8_STAGE_A(G8_SA(0, 0), a2, 0);
            G8_WAIT_V(8); G8_WAIT_L(0); G8_BAR; G8_MMA(1, 0, At, B0); G8_MMA(1, 1, At, B1); G8_BAR; G8_SCHED;
            G8_LDB(B0, 1, 0); G8_LDB(B1, 1, 1); G8_SCHED; G8_LDA(At, 1, 0); G8_STAGE_A(G8_SA(0, 1), a2, 1);
            G8_WAIT_V(8); G8_WAIT_L(0); G8_BAR; G8_MMA(0, 0, At, B0); G8_MMA(0, 1, At, B1); G8_BAR; G8_SCHED;
            G8_LDA(At, 1, 1); G8_STAGE_B(G8_SB(1, 0), b3, 0); G8_STAGE_B(G8_SB(1, 1), b3, 1); G8_STAGE_A(G8_SA(1, 0), a3, 0);
            G8_WAIT_V(8); G8_WAIT_L(0); G8_BAR; G8_MMA(1, 0, At, B0); G8_MMA(1, 1, At, B1); G8_BAR; G8_SCHED;
            } else {
            G8_LDB(B0, 0, 0); G8_LDB(B1, 0, 1); G8_SCHED; G8_LDA(At, 0, 0);
            G8_WAIT_V(6); G8_WAIT_L(0); G8_BAR; G8_MMA(0, 0, At, B0); G8_SCHED; G8_STAGE_A(G8_SA(1, 1), a1, 1); G8_SCHED; G8_MMA(0, 1, At, B1); G8_BAR; G8_SCHED;
            G8_SWITCH();
            G8_LDA(At, 0, 1);
            G8_WAIT_V(2); G8_WAIT_L(0); G8_BAR; G8_MMA(1, 0, At, B0); G8_SCHED; G8_STAGE_B(G8_SB(0, 0), b2, 0); G8_STAGE_B(G8_SB(0, 1), b2, 1); G8_SCHED; G8_MMA(1, 1, At, B1); G8_SCHED; G8_STAGE_A(G8_SA(0, 0), a2, 0); G8_BAR; G8_SCHED;
            G8_LDB(B0, 1, 0); G8_LDB(B1, 1, 1); G8_SCHED; G8_LDA(At, 1, 0);
            G8_WAIT_V(6); G8_WAIT_L(0); G8_BAR; G8_MMA(0, 0, At, B0); G8_SCHED; G8_STAGE_A(G8_SA(0, 1), a2, 1); G8_SCHED; G8_MMA(0, 1, At, B1); G8_BAR; G8_SCHED;
            G8_LDA(At, 1, 1);
            G8_WAIT_V(2); G8_WAIT_L(0); G8_BAR; G8_MMA(1, 0, At, B0); G8_SCHED; G8_STAGE_B(G8_SB(1, 0), b3, 0); G8_STAGE_B(G8_SB(1, 1), b3, 1); G8_SCHED; G8_MMA(1, 1, At, B1); G8_SCHED; G8_STAGE_A(G8_SA(1, 0), a3, 0); G8_BAR; G8_SCHED;
            }
        }
        if (wr == 0) G8_BAR;
        if constexpr (MODE == 1) asm volatile("s_nop 15\n\ts_nop 15" ::: "memory");
        const bool keep = E(acc, cur, wr, wc, fr, fq, lds + ROWBUF_OFF + 1024, ui & 1);
        if (!has_next) break;
        E.aux_dma(nxt, lds + ROWBUF_OFF + 1024, (ui + 1) & 1, wid, lane);
        if (!keep) {
#pragma unroll
            for (int a = 0; a < 2; ++a)
#pragma unroll
                for (int b = 0; b < 2; ++b)
#pragma unroll
                    for (int m = 0; m < 4; ++m)
#pragma unroll
                        for (int n = 0; n < 2; ++n) acc[a][b][m][n] = (f32x4){0.f, 0.f, 0.f, 0.f};
        }
        cur = nxt; cA = nA; cB = nB; ++ui;
        if (wr == 1) G8_BAR;
    }
    G8_WAIT_V(0);
    G8_BAR;
#undef G8_SA
#undef G8_SB
#undef G8_STAGE_A
#undef G8_STAGE_B
#undef G8_LDA
#undef G8_LDB
#undef G8_MMA
#undef G8_CAT
#undef G8_WAIT_V
#undef G8_SWITCH
#undef G8_WAIT_L
#undef G8_BAR
#undef G8_SCHED
}
}

typedef GAS unsigned gu32;
#define RLX_AGENT __ATOMIC_RELAXED, __HIP_MEMORY_SCOPE_AGENT
#define XB_TMO      128
#define XB_XCNT(j)  (256  + 64 * (j))
#define XB_XSUB(j)  (1280 + 64 * (j))
#define XB_XGEN(j)  (2304 + 64 * (j))
#define XB_TOP      3328
#define XB_TOPGEN   3392
#define XCD_BAR_WORDS 3456
#define XB_SPIN_CAP (1u << 22)
__device__ __forceinline__ unsigned xb_ld(unsigned* p)              { return __hip_atomic_load(p, __ATOMIC_RELAXED, __HIP_MEMORY_SCOPE_AGENT); }
__device__ __forceinline__ unsigned xb_add(unsigned* p, unsigned v) { return __hip_atomic_fetch_add(p, v, __ATOMIC_RELAXED, __HIP_MEMORY_SCOPE_AGENT); }
__device__ __forceinline__ unsigned xb_xcc_id() { return (unsigned)__builtin_amdgcn_s_getreg((3 << 11) | 20) & 0xFu; }
#define XB_SPIN(cond, bar) do { unsigned _sp = 0; while (cond) { __builtin_amdgcn_s_sleep(1); \
    if ((++_sp & 255u) == 0u) { if (xb_ld(&(bar)[XB_TMO])) break; if (_sp > XB_SPIN_CAP) { atomicAdd(&(bar)[XB_TMO], 1u); break; } } } } while (0)
struct XcdBarrier { unsigned* bar; unsigned x; volatile LAS unsigned* st; };
__device__ __forceinline__ XcdBarrier xcd_barrier_post(unsigned* bar, volatile LAS unsigned* st, const bool t0) {
    XcdBarrier b; b.bar = bar; b.x = xb_xcc_id(); b.st = st;
    if (t0) (void)xb_add(&bar[XB_XCNT(b.x)], 1u);
    return b;
}
__device__ __forceinline__ void xcd_barrier_complete(unsigned* bar, unsigned x, unsigned& nloc, unsigned& nx) {
    const unsigned G = gridDim.x * gridDim.y * gridDim.z;
    unsigned sum, cnt, mine, sp = 0u;
    for (;;) {
        sum = 0u; cnt = 0u; mine = 0u;
#pragma unroll
        for (unsigned j = 0; j < 16; ++j) { const unsigned c = xb_ld(&bar[XB_XCNT(j)]); sum += c; cnt += (c > 0u) ? 1u : 0u; mine = (j == x) ? c : mine; }
        if (sum == G) break;
        __builtin_amdgcn_s_sleep(1);
        if ((++sp & 255u) == 0u) { if (xb_ld(&bar[XB_TMO])) break; if (sp > XB_SPIN_CAP) { atomicAdd(&bar[XB_TMO], 1u); break; } }
    }
    nloc = mine > 0u ? mine : 1u; nx = cnt > 0u ? cnt : 1u;
}
__device__ __forceinline__ void xcd_barrier(const XcdBarrier& b, const bool t0) {
    asm volatile("s_waitcnt vmcnt(0)" ::: "memory");
    __syncthreads();
    if (t0) {
        unsigned* bar = b.bar;
        __builtin_amdgcn_s_waitcnt(0);
        unsigned nloc = b.st[0], nx = b.st[1];
        if (nloc == 0u) { xcd_barrier_complete(bar, b.x, nloc, nx); b.st[0] = nloc; b.st[1] = nx; }
        const unsigned old = xb_add(&bar[XB_XSUB(b.x)], 1u);
        const unsigned gen = old / nloc;
        if (old + 1u == (gen + 1u) * nloc) {
            __builtin_amdgcn_fence(__ATOMIC_RELEASE, "agent");
            asm volatile("s_waitcnt vmcnt(0)" ::: "memory");
            const unsigned og = xb_add(&bar[XB_TOP], 1u);
            const unsigned tg = og / nx;
            if (og + 1u == (tg + 1u) * nx) xb_add(&bar[XB_TOPGEN], 1u);
            else XB_SPIN(xb_ld(&bar[XB_TOPGEN]) == tg, bar);
            __builtin_amdgcn_fence(__ATOMIC_ACQUIRE, "agent");
            xb_add(&bar[XB_XGEN(b.x)], 1u);
            asm volatile("s_waitcnt vmcnt(0)" ::: "memory");
        } else {
            XB_SPIN(xb_ld(&bar[XB_XGEN(b.x)]) == gen, bar);
            __builtin_amdgcn_fence(__ATOMIC_ACQUIRE, "agent");
            asm volatile("s_waitcnt vmcnt(0)" ::: "memory");
        }
    }
    __syncthreads();
}

struct Args { const float* in[17]; float* out; unsigned char* ws; int ph_lo, ph_hi; };
typedef const __attribute__((address_space(4))) Args* KArgP;
struct Frame {
    LAS unsigned char* lds;
    int tid, lane, wave, vcu, G;
    KArgP ap;
    float* out; unsigned char* ws;
};
#define INP(k) ((const GAS float*)F.ap->in[k])
enum { I_X = 0, I_N1G, I_WIN, I_GATEB, I_MNG, I_AQG, I_AKG, I_WMB, I_WAB, I_WOUT, I_N2G, I_WR, I_BR, I_W1, I_B1, I_W2, I_B2 };
#define WSP(T, off) ((T*)(F.ws + (off)))

__device__ __forceinline__ float wave_sum(float v) {
#pragma unroll
    for (int o = 1; o < 64; o <<= 1) v += __shfl_xor(v, o);
    return v;
}

struct TItem { const GAS float* src; const GAS float* scale; unsigned char* dst; int srcpitch, dstpitchB, r0, r1, fmt, half; };
__device__ __forceinline__ TItem titem_decode(Frame& F, int it) {
    constexpr int NI_IN = 92 * 16, NI_WM = 16 * 8, NI_WA = 16 * 4, NI_WO = 16 * 16, NI_WR = 16, NI_W1 = 32 * 32 * 16;
    TItem t; t.scale = nullptr; t.fmt = 0; t.half = 0;
    int r = it;
    if (r < NI_IN) { const int q = r % 92, kb = r / 92, pn = q >> 2, wc = q & 3; const int colbase = pn < 6 ? 256 * pn : 1544 + 256 * (pn - 6);
        t.src = INP(I_WIN) + (size_t)(64 * kb) * 5896 + colbase + 64 * wc; t.srcpitch = 5896; t.r0 = 256 * pn + 32 * wc; t.r1 = t.r0 + 128; t.scale = INP(I_N1G) + 64 * kb;
        if (pn >= FP8_FROM) { t.dst = F.ws + WS_WIN8 + 64 * kb; t.dstpitchB = 1024; t.fmt = 1; } else { t.dst = F.ws + WS_WIN + 128 * kb; t.dstpitchB = 2048; }
        return t; } r -= NI_IN;
    if (r < NI_WM) { const int kb = r % 8, q = r / 8, pn = q >> 2, wc = q & 3;
        t.src = INP(I_WMB) + (size_t)(64 * kb) * 1024 + 256 * pn + 64 * wc; t.srcpitch = 1024; t.dst = F.ws + WS_WM + 128 * kb; t.dstpitchB = 1024; t.r0 = 256 * pn + 32 * wc; t.r1 = t.r0 + 128; return t; } r -= NI_WM;
    if (r < NI_WA) { const int kb = r % 4, q = r / 4, pn = q >> 2, wc = q & 3;
        t.src = INP(I_WAB) + (size_t)(64 * kb) * 1024 + 256 * pn + 64 * wc; t.srcpitch = 1024; t.dst = F.ws + WS_WA + 128 * kb; t.dstpitchB = 1024; t.r0 = 256 * pn + 32 * wc; t.r1 = t.r0 + 128; return t; } r -= NI_WA;
    if (r < NI_WO) { const int kb = r % 16, q = r / 16, pn = q >> 2, wc = q & 3;
        t.src = INP(I_WOUT) + (size_t)(64 * kb) * 1024 + 256 * pn + 64 * wc; t.srcpitch = 1024; t.dst = F.ws + WS_WO + 128 * kb; t.dstpitchB = 2048; t.r0 = 256 * pn + 32 * wc; t.r1 = t.r0 + 128; return t; } r -= NI_WO;
    if (r < NI_WR) { const int kb = r;
        t.src = INP(I_WR) + (size_t)(64 * kb) * 32; t.srcpitch = 32; t.dst = F.ws + WS_WR + 128 * kb; t.dstpitchB = 2048; t.r0 = 0; t.r1 = 0; t.scale = INP(I_N2G) + 64 * kb; t.half = 1; return t; } r -= NI_WR;
    if (r < NI_W1) { const int cb = r % 32; int q = r / 32; const int kb = q % 16, e = q / 16;
        const int q2 = cb & 15, rr = 256 * (q2 >> 1) + 64 * (q2 & 1) + (cb >= 16 ? 128 : 0);
        t.src = INP(I_W1) + (size_t)e * 1024 * 2048 + (size_t)(64 * kb) * 2048 + 64 * cb; t.srcpitch = 2048; t.dst = F.ws + WS_W1 + (size_t)e * 2048 * 1024 + 64 * kb; t.dstpitchB = 1024; t.r0 = rr; t.r1 = rr + 32;
        t.scale = INP(I_N2G) + 64 * kb; t.fmt = 1; return t; } r -= NI_W1;
    { const int cb = r % 16; int q = r / 16; const int kb = q % 16, e = q / 16, pn = cb >> 2, wc = cb & 3;
        t.src = INP(I_W2) + (size_t)e * 1024 * 1024 + (size_t)(64 * kb) * 1024 + 256 * pn + 64 * wc; t.srcpitch = 1024; t.dst = F.ws + WS_W2 + (size_t)e * 1024 * 1024 + 64 * kb; t.dstpitchB = 1024; t.r0 = 256 * pn + 32 * wc; t.r1 = t.r0 + 128; t.fmt = 1; return t; }
}
__device__ __forceinline__ void titem_load(const TItem& t, int lane, f32x4 (&v)[16], float (&sc)[16]) {
    const int cq = lane & 15, kq = lane >> 4;
#pragma unroll
    for (int i = 0; i < 16; ++i) { v[i] = (f32x4){0.f, 0.f, 0.f, 0.f}; if (!t.half || cq < 8) v[i] = __builtin_nontemporal_load((const GAS f32x4*)(t.src + (size_t)(4 * i + kq) * t.srcpitch + 4 * cq)); }
#pragma unroll
    for (int i = 0; i < 16; ++i) sc[i] = (t.scale ? t.scale[4 * i + kq] : 1.0f) * (t.fmt == 1 ? 32.0f : 1.0f);
}
__device__ __forceinline__ void titem_store(const TItem& t, int lane, const f32x4 (&v)[16], const float (&sc)[16], LAS float* scr) {
    const int cq = lane & 15, kq = lane >> 4;
#pragma unroll
    for (int i = 0; i < 16; ++i) { LAS float* s = scr + (4 * i + kq) * 65 + 4 * cq; s[0] = v[i][0] * sc[i]; s[1] = v[i][1] * sc[i]; s[2] = v[i][2] * sc[i]; s[3] = v[i][3] * sc[i]; }
    LDS_WAIT(); asm volatile("" ::: "memory");
    if (t.fmt == 0) {
        const int ch = lane & 7;
#pragma unroll
        for (int q = 0; q < 8; ++q) { const int n = (lane >> 3) + 8 * q; const LAS float* s = scr + (8 * ch) * 65 + n;
            u32x4 o; o.x = pk2(s[0 * 65], s[1 * 65]); o.y = pk2(s[2 * 65], s[3 * 65]); o.z = pk2(s[4 * 65], s[5 * 65]); o.w = pk2(s[6 * 65], s[7 * 65]);
            if (!t.half || n < 32) *(GAS u32x4*)(t.dst + (size_t)(n < 32 ? t.r0 + n : t.r1 + n - 32) * t.dstpitchB + ch * 16) = o; }
    } else {
        const int ch = lane & 3;
#pragma unroll
        for (int q = 0; q < 4; ++q) { const int n = (lane >> 2) + 16 * q; const LAS float* s = scr + (16 * ch) * 65 + n;
            f32x4 a0 = (f32x4){s[0 * 65], s[1 * 65], s[2 * 65], s[3 * 65]}, a1 = (f32x4){s[4 * 65], s[5 * 65], s[6 * 65], s[7 * 65]};
            f32x4 a2 = (f32x4){s[8 * 65], s[9 * 65], s[10 * 65], s[11 * 65]}, a3 = (f32x4){s[12 * 65], s[13 * 65], s[14 * 65], s[15 * 65]};
            const u32x2 lo = pack8_fp8(a0, a1), hi = pack8_fp8(a2, a3);
            *(GAS u32x4*)(t.dst + (size_t)(n < 32 ? t.r0 + n : t.r1 + n - 32) * t.dstpitchB + ch * 16) = (u32x4){lo.x, lo.y, hi.x, hi.y}; }
    }
    LDS_WAIT(); asm volatile("" ::: "memory");
}

__device__ __forceinline__ void p0_prologue(Frame& F) {
    LAS float* scr = (LAS float*)(F.lds + F.wave * 16640);
    const int gw = F.vcu * 8 + F.wave, NGW = F.G * 8;
    constexpr int NITEMS = 92 * 16 + 16 * 8 + 16 * 4 + 16 * 16 + 16 + 32 * 32 * 16 + 32 * 16 * 16;
    {
        int it = gw;
        if (it < NITEMS) {
            f32x4 vc[16], vn[16]; float sc_c[16], sc_n[16];
            TItem cur = titem_decode(F, it); titem_load(cur, F.lane, vc, sc_c);
            for (;;) {
                const int itn = it + NGW; const bool has_next = itn < NITEMS;
                TItem nxt = cur;
                if (has_next) { nxt = titem_decode(F, itn); titem_load(nxt, F.lane, vn, sc_n); }
                titem_store(cur, F.lane, vc, sc_c, scr);
                if (!has_next) break;
                cur = nxt; it = itn;
#pragma unroll
                for (int i = 0; i < 16; ++i) { vc[i] = vn[i]; sc_c[i] = sc_n[i]; }
            }
        }
    }
    __syncthreads();
    LAS float* WG = (LAS float*)(F.lds);
    for (int u = F.tid; u < 1024 * 8; u += 512) WG[(u & 7) * 1024 + (u >> 3)] = INP(I_WIN)[(size_t)(u >> 3) * 5896 + 1536 + (u & 7)];
    __syncthreads();
    f32x4 g1v[4];
#pragma unroll
    for (int j = 0; j < 4; ++j) g1v[j] = *(const GAS f32x4*)(INP(I_N1G) + 4 * F.lane + 256 * j);
    const float gb = INP(I_GATEB)[F.lane & 7];
    if (gw < NTOK) {
        f32x4 vn[4];
        { const GAS f32x4* xr = (const GAS f32x4*)(INP(I_X) + (size_t)gw * DM) + F.lane;
#pragma unroll
          for (int j = 0; j < 4; ++j) vn[j] = __builtin_nontemporal_load(xr + 64 * j); }
        for (int m = gw; m < NTOK; m += NGW) {
            f32x4 v[4]; float s2 = 0.f;
#pragma unroll
            for (int j = 0; j < 4; ++j) { v[j] = vn[j]; s2 += (v[j].x * v[j].x + v[j].y * v[j].y) + (v[j].z * v[j].z + v[j].w * v[j].w); }
            if (m + NGW < NTOK) { const GAS f32x4* xr = (const GAS f32x4*)(INP(I_X) + (size_t)(m + NGW) * DM) + F.lane;
#pragma unroll
                for (int j = 0; j < 4; ++j) vn[j] = __builtin_nontemporal_load(xr + 64 * j); }
            const float rstd = __builtin_amdgcn_rsqf(wave_sum(s2) * (1.f / DM) + EPS);
            GAS unsigned long long* o8 = (GAS unsigned long long*)(WSP(bf16_t, WS_XN) + (size_t)m * DM) + F.lane;
            float ga[8];
#pragma unroll
            for (int c = 0; c < 8; ++c) ga[c] = 0.f;
            if (F.lane == 0) WSP(float, WS_RSTD1)[m] = rstd;
#pragma unroll
            for (int j = 0; j < 4; ++j) {
                o8[64 * j] = (unsigned long long)pk2(v[j].x, v[j].y) | ((unsigned long long)pk2(v[j].z, v[j].w) << 32);
                { int w8 = 0; w8 = __builtin_amdgcn_cvt_pk_fp8_f32(v[j].x, v[j].y, w8, false); w8 = __builtin_amdgcn_cvt_pk_fp8_f32(v[j].z, v[j].w, w8, true);
                  ((GAS unsigned*)(F.ws + WS_XN8 + (size_t)m * DM))[F.lane + 64 * j] = (unsigned)w8; }
                v[j] = v[j] * rstd * g1v[j];
#pragma unroll
                for (int c = 0; c < 8; ++c) { const f32x4 w = *(const LAS f32x4*)(WG + c * 1024 + 4 * F.lane + 256 * j); ga[c] += (v[j].x * w.x + v[j].y * w.y) + (v[j].z * w.z + v[j].w * w.w); }
            }
#pragma unroll
            for (int c = 0; c < 4; ++c) { const float mine = (F.lane & 4) ? ga[c + 4] : ga[c], oth = (F.lane & 4) ? ga[c] : ga[c + 4]; ga[c] = mine + __shfl_xor(oth, 4); }
#pragma unroll
            for (int c = 0; c < 2; ++c) { const float mine = (F.lane & 2) ? ga[c + 2] : ga[c], oth = (F.lane & 2) ? ga[c] : ga[c + 2]; ga[c] = mine + __shfl_xor(oth, 2); }
            { const float mine = (F.lane & 1) ? ga[1] : ga[0], oth = (F.lane & 1) ? ga[0] : ga[1]; ga[0] = mine + __shfl_xor(oth, 1); }
            float t = ga[0];
            t += __shfl_xor(t, 8); t += __shfl_xor(t, 16); t += __shfl_xor(t, 32);
            if (F.lane < 8) { const float z = t + gb; WSP(float, WS_GATES)[(size_t)m * 8 + F.lane] = 15.0f * tanhf(z * (1.0f / 15.0f)); }
        }
    }
}

struct SchedInProj { g8::TileOrder T; const char* A; const char* B;
    __device__ __forceinline__ bool next(int i, g8::GUnit& u) const { int pm, pn; if (!T.tile(i, pm, pn)) return false; u.pm = pm; u.pn = pn; u.nt = 16; u.sel = 0; u.e = 0; u.rt = 0; u.x = 0; u.y = 0;
        u.A = A + (size_t)pm * 256 * 2048; u.B = B + (size_t)pn * 256 * 2048; return true; }
    __device__ __forceinline__ unsigned arow(const g8::GUnit&, int) const { return 0u; }
};
struct SchedInProj8 { g8::TileOrder T; const char* A; const char* B;
    __device__ __forceinline__ bool next(int i, g8::GUnit& u) const { int pm, pl; if (!T.tile(i, pm, pl)) return false; const int pn = FP8_FROM + pl; u.pm = pm; u.pn = pn; u.nt = 8; u.sel = 0; u.e = 0; u.rt = 0; u.x = 256 * pm; u.y = 256;
        u.A = A; u.B = B + (size_t)pn * 256 * 1024; return true; }
    __device__ __forceinline__ unsigned arow(const g8::GUnit& u, int r) const { return (unsigned)(u.x + r) * 1024u; }
    __device__ __forceinline__ void rows_dma(const g8::GUnit&, LAS unsigned*, int, int) const {}
    __device__ __forceinline__ unsigned arow_lds(const g8::GUnit& u, int r, const LAS unsigned*) const { return (unsigned)(u.x + r) * 1024u; }
};
struct EpiInProj {
    unsigned char* ws; const GAS float* gq; const GAS float* gk; float ascale;
    __device__ __forceinline__ void aux_dma(const g8::GUnit& u, LAS unsigned char* aux, int par, int wid, int lane) const {
        if (wid == 4) __builtin_amdgcn_global_load_lds((const unsigned*)((const float*)(ws + WS_RSTD1) + 256 * u.pm + 4 * lane), (LAS unsigned*)(aux + par * 2048), 16, 0, 0); }
    __device__ __forceinline__ bool operator()(f32x4 (&acc)[2][2][4][2], const g8::GUnit& u, int wr, int wc, int fr, int fq, LAS unsigned char* aux, int par) const {
        const int pn = u.pn;
        size_t base; int pitch, col0, kind = 0, grp = 0; float sc = 1.f;
        if (pn == 0)      { base = WS_MQ; pitch = 256; col0 = 0; }
        else if (pn == 1) { base = WS_MK; pitch = 256; col0 = 0; sc = 0.125f; }
        else if (pn < 4)  { base = WS_MV; pitch = 512; col0 = 256 * (pn - 2); }
        else if (pn < 6)  { base = WS_MO; pitch = 512; col0 = 256 * (pn - 4); kind = 1; }
        else if (pn < 9)  { base = WS_AQ; pitch = 768; col0 = 256 * (pn - 6); kind = 2; grp = pn - 6; sc = 0.125f * LOG2E; }
        else if (pn < 12) { base = WS_AK; pitch = 768; col0 = 256 * (pn - 9); kind = 3; grp = pn - 9; }
        else if (pn < 15) { base = WS_AV; pitch = 768; col0 = 256 * (pn - 12); }
        else if (pn < 19) { base = WS_GM; pitch = 1024; col0 = 256 * (pn - 15); kind = 1; }
        else              { base = WS_GA; pitch = 1024; col0 = 256 * (pn - 19); kind = 1; }
        bf16_t* dst = (bf16_t*)(ws + base);
        const int L0 = 64 * wc + 8 * fq;
        const int row0 = u.pm * 256 + wr * 64 + fr;
        f32x4 gn[2][2];
        if (kind >= 2) { const int go = grp * 64 + 8 * fq;
#pragma unroll
            for (int bj = 0; bj < 2; ++bj)
#pragma unroll
                for (int n = 0; n < 2; ++n) { const f32x4 a = *(const GAS f32x4*)(gq + go + 32 * bj + 4 * n), b = *(const GAS f32x4*)(gk + go + 32 * bj + 4 * n); gn[bj][n] = (kind == 2) ? a : b; } }
#pragma unroll
        for (int ai = 0; ai < 2; ++ai)
#pragma unroll
            for (int m = 0; m < 4; ++m) {
                const int row = row0 + 128 * ai + 16 * m;
                const float rs = ((const LAS float*)(aux + par * 2048))[128 * ai + 64 * wr + 16 * m + fr] * ascale;
                f32x4 v[2][2];
#pragma unroll
                for (int bj = 0; bj < 2; ++bj)
#pragma unroll
                    for (int n = 0; n < 2; ++n) v[bj][n] = acc[ai][bj][m][n] * rs;
                if (kind == 1) {
#pragma unroll
                    for (int bj = 0; bj < 2; ++bj)
#pragma unroll
                        for (int n = 0; n < 2; ++n)
#pragma unroll
                            for (int e = 0; e < 4; ++e) v[bj][n][e] = sigmoidf_(v[bj][n][e]);
                } else if (kind >= 2) {
                    float ss = 0.f;
#pragma unroll
                    for (int bj = 0; bj < 2; ++bj)
#pragma unroll
                        for (int n = 0; n < 2; ++n) ss += (v[bj][n][0] * v[bj][n][0] + v[bj][n][1] * v[bj][n][1]) + (v[bj][n][2] * v[bj][n][2] + v[bj][n][3] * v[bj][n][3]);
                    ss += __shfl_xor(ss, 16); ss += __shfl_xor(ss, 32);
                    const float r = sc * __builtin_amdgcn_rsqf(ss * (1.0f / 64.0f) + EPS);
#pragma unroll
                    for (int bj = 0; bj < 2; ++bj)
#pragma unroll
                        for (int n = 0; n < 2; ++n) v[bj][n] = v[bj][n] * gn[bj][n] * r;
                } else {
#pragma unroll
                    for (int bj = 0; bj < 2; ++bj)
#pragma unroll
                        for (int n = 0; n < 2; ++n) v[bj][n] = v[bj][n] * sc;
                }
#pragma unroll
                for (int bj = 0; bj < 2; ++bj) st16(dst + (size_t)row * pitch + col0 + L0 + 32 * bj, pack8(v[bj][0], v[bj][1]));
            }
        return false;
    }
};

struct SchedBranch { g8::TileOrder T; const char *A0, *B0, *A1, *B1;
    __device__ __forceinline__ bool next(int i, g8::GUnit& u) const { int pm, pn; if (!T.tile(i >> 1, pm, pn)) return false; u.pm = pm; u.pn = pn; u.sel = i & 1; u.e = 0; u.rt = 0; u.x = 0; u.y = 0;
        if (u.sel == 0) { u.nt = 8; u.A = A0 + (size_t)pm * 256 * 1024; u.B = B0 + (size_t)pn * 256 * 1024; }
        else            { u.nt = 4; u.A = A1 + (size_t)pm * 256 * 1024; u.B = B1 + (size_t)pn * 256 * 1024; }
        return true; }
    __device__ __forceinline__ unsigned arow(const g8::GUnit&, int) const { return 0u; }
};
struct EpiBranch {
    const bf16_t *GM, *GA; bf16_t* Y;
    __device__ __forceinline__ void aux_dma(const g8::GUnit&, LAS unsigned char*, int, int, int) const {}
    __device__ __forceinline__ bool operator()(f32x4 (&acc)[2][2][4][2], const g8::GUnit& u, int wr, int wc, int fr, int fq, LAS unsigned char* aux, int par) const {
        const int row0 = u.pm * 256 + wr * 64 + fr, c0 = 256 * u.pn + 64 * wc + 8 * fq;
        u32x4 gan[2], gmn[2], gac[2], gmc[2];
#pragma unroll
        for (int bj = 0; bj < 2; ++bj) { const size_t ro = (size_t)row0 * 1024 + c0 + 32 * bj; gan[bj] = *(const u32x4*)(GA + ro); gmn[bj] = gan[bj]; if (u.sel == 0) gmn[bj] = *(const u32x4*)(GM + ro); }
#pragma unroll
        for (int ai = 0; ai < 2; ++ai)
#pragma unroll
            for (int m = 0; m < 4; ++m) {
                const size_t ro = (size_t)(row0 + 128 * ai + 16 * m) * 1024 + c0;
#pragma unroll
                for (int bj = 0; bj < 2; ++bj) { gac[bj] = gan[bj]; gmc[bj] = gmn[bj]; }
                if (ai * 4 + m < 7) { const int it = ai * 4 + m + 1; const size_t rn = (size_t)(row0 + 128 * (it >> 2) + 16 * (it & 3)) * 1024 + c0;
#pragma unroll
                    for (int bj = 0; bj < 2; ++bj) { gan[bj] = *(const u32x4*)(GA + rn + 32 * bj); gmn[bj] = gan[bj]; if (u.sel == 0) gmn[bj] = *(const u32x4*)(GM + rn + 32 * bj); } }
#pragma unroll
                for (int bj = 0; bj < 2; ++bj) {
                    f32x4 a0, a1; unpack8(gac[bj], a0, a1);
                    if (u.sel == 0) { f32x4 m0, m1; unpack8(gmc[bj], m0, m1);
#pragma unroll
                        for (int e = 0; e < 4; ++e) { acc[ai][bj][m][0][e] *= m0[e] * __builtin_amdgcn_rcpf(a0[e]); acc[ai][bj][m][1][e] *= m1[e] * __builtin_amdgcn_rcpf(a1[e]); }
                    } else { st16(Y + ro + 32 * bj, pack8(acc[ai][bj][m][0] * a0, acc[ai][bj][m][1] * a1)); }
                }
            }
        return u.sel == 0;
    }
};

struct SchedWout { g8::TileOrder T; const char* A; const char* B;
    __device__ __forceinline__ bool next(int i, g8::GUnit& u) const { int pm, pn; if (!T.tile(i, pm, pn)) return false; u.pm = pm; u.pn = pn; u.nt = 16; u.sel = 0; u.e = 0; u.rt = 0; u.x = 0; u.y = 0;
        u.A = A + (size_t)pm * 256 * 2048; u.B = B + (size_t)pn * 256 * 2048; return true; }
    __device__ __forceinline__ unsigned arow(const g8::GUnit&, int) const { return 0u; }
};
struct EpiWout {
    const bf16_t* x; bf16_t* X1B; unsigned char* X1F8; float* SSQ;
    __device__ __forceinline__ void aux_dma(const g8::GUnit&, LAS unsigned char*, int, int, int) const {}
    __device__ __forceinline__ bool operator()(f32x4 (&acc)[2][2][4][2], const g8::GUnit& u, int wr, int wc, int fr, int fq, LAS unsigned char* aux, int par) const {
        const int row0 = u.pm * 256 + wr * 64 + fr, c0 = 256 * u.pn + 64 * wc + 8 * fq;
        const bool odd = fq & 1;
        u32x4 xn[2], xc[2];
#pragma unroll
        for (int bj = 0; bj < 2; ++bj) { const size_t ro = (size_t)row0 * 1024 + c0; xn[bj] = *(const u32x4*)(x + ro + 32 * bj); }
#pragma unroll
        for (int ai = 0; ai < 2; ++ai)
#pragma unroll
            for (int m = 0; m < 4; ++m) {
                const int row = row0 + 128 * ai + 16 * m; const size_t ro = (size_t)row * 1024 + c0; float ss = 0.f;
#pragma unroll
                for (int bj = 0; bj < 2; ++bj) xc[bj] = xn[bj];
                if (ai * 4 + m < 7) { const int it = ai * 4 + m + 1; const size_t rn = (size_t)(row0 + 128 * (it >> 2) + 16 * (it & 3)) * 1024 + c0;
#pragma unroll
                    for (int bj = 0; bj < 2; ++bj) xn[bj] = *(const u32x4*)(x + rn + 32 * bj); }
                u32x2 f8[2];
#pragma unroll
                for (int bj = 0; bj < 2; ++bj) {
                    f32x4 x0, x1; unpack8(xc[bj], x0, x1);
                    const f32x4 v0 = acc[ai][bj][m][0] + x0, v1 = acc[ai][bj][m][1] + x1;
                    st16(X1B + ro + 32 * bj, pack8(v0, v1)); f8[bj] = pack8_fp8(v0, v1);
                    ss += (v0[0] * v0[0] + v0[1] * v0[1]) + (v0[2] * v0[2] + v0[3] * v0[3]) + (v1[0] * v1[0] + v1[1] * v1[1]) + (v1[2] * v1[2] + v1[3] * v1[3]);
                }
                const u32x2 snd = odd ? f8[0] : f8[1];
                u32x2 rcv; rcv.x = (unsigned)__shfl_xor((int)snd.x, 16); rcv.y = (unsigned)__shfl_xor((int)snd.y, 16);
                const u32x4 w16 = odd ? (u32x4){rcv.x, rcv.y, f8[1].x, f8[1].y} : (u32x4){f8[0].x, f8[0].y, rcv.x, rcv.y};
                st16(X1F8 + (size_t)row * 1024 + 256 * u.pn + 64 * wc + (odd ? 32 + 8 * (fq - 1) : 8 * fq), w16);
                ss += __shfl_xor(ss, 16); ss += __shfl_xor(ss, 32);
                if (fq == 0) SSQ[(size_t)row * 16 + u.pn * 4 + wc] = ss;
            }
        return false;
    }
};

__device__ __forceinline__ void moe_tables(Frame& F) {
    LAS int* tab = (LAS int*)(F.lds + TAB_OFF);
    if (F.wave == 0) { const unsigned* cnt = WSP(unsigned, WS_CTL) + CW_CNT;
        const int c = F.lane < NEXP ? (int)__hip_atomic_load(cnt + (F.lane & 31), RLX_AGENT) : 0;
        const int t = (c + 255) >> 8; int ts = t, of = c;
#pragma unroll
        for (int o = 1; o < 32; o <<= 1) { const int a = __shfl_up(ts, o), b2 = __shfl_up(of, o); if (F.lane >= o) { ts += a; of += b2; } }
        if (F.lane < NEXP) { tab[F.lane] = ts - t; tab[40 + F.lane] = of - c; tab[80 + F.lane] = c; }
        if (F.lane == NEXP - 1) { tab[32] = ts; tab[72] = of; } }
    __syncthreads();
}
template <int NPN, bool G1>
struct SchedMoe { g8::TileOrder T; const LAS int* tab; const char* A; const char* B; const int* LIST;
    __device__ __forceinline__ bool next(int i, g8::GUnit& u) const { int pm, pn; if (!T.tile(i, pm, pn)) return false;
        int e = 0;
        for (int k = 1; k < NEXP; ++k) e = (tab[k] <= pm) ? k : e;
        e = __builtin_amdgcn_readfirstlane(e);
        const int ts = __builtin_amdgcn_readfirstlane(tab[e]), of = __builtin_amdgcn_readfirstlane(tab[40 + e]), cn = __builtin_amdgcn_readfirstlane(tab[80 + e]);
        const int rt = pm - ts; u.pm = pm; u.pn = pn; u.sel = 0; u.e = e; u.rt = rt; u.nt = 8; u.x = of + 256 * rt; u.y = cn - 256 * rt;
        if (G1) { u.A = A; u.B = B + ((size_t)e * 2048 + 256 * pn) * 1024; }
        else { u.A = A; u.B = B + ((size_t)e * 1024 + 256 * pn) * 1024; }
        return true; }
    __device__ __forceinline__ unsigned arow(const g8::GUnit& u, int r) const {
        if (G1) { const int rr = r < u.y ? r : u.y - 1; const int tok = LIST[(size_t)u.e * NTOK + 256 * u.rt + rr]; return (unsigned)tok * 1024u; }
        else return (unsigned)(u.x + r) * 1024u; }
    __device__ __forceinline__ void rows_dma(const g8::GUnit& u, LAS unsigned* buf, int wid, int lane) const {
        if (G1) { if (wid < 4) __builtin_amdgcn_global_load_lds((const unsigned*)(LIST + (size_t)u.e * NTOK + 256 * u.rt + 64 * wid + lane), (LAS unsigned*)(buf + 64 * wid), 4, 0, 0); } }
    __device__ __forceinline__ unsigned arow_lds(const g8::GUnit& u, int r, const LAS unsigned* buf) const {
        if (G1) { const unsigned tok = buf[r]; return (tok < (unsigned)NTOK ? tok : 0u) * 1024u; }
        else return (unsigned)(u.x + r) * 1024u; }
};
struct EpiMoe1 {
    const float* SRSTD; const GAS float* b1; unsigned char* H;
    __device__ __forceinline__ void aux_dma(const g8::GUnit& u, LAS unsigned char* aux, int par, int wid, int lane) const {
        if (wid == 4) __builtin_amdgcn_global_load_lds((const unsigned*)(SRSTD + (size_t)u.e * NTOK + 256 * u.rt + 4 * lane), (LAS unsigned*)(aux + par * 2048), 16, 0, 0);
        if (wid == 5) __builtin_amdgcn_global_load_lds((const unsigned*)((const float*)b1 + (size_t)u.e * 2048 + (lane < 32 ? 0 : 1024) + 128 * u.pn + 4 * (lane & 31)), (LAS unsigned*)(aux + par * 2048 + 1024), 16, 0, 0); }
    __device__ __forceinline__ bool operator()(f32x4 (&acc)[2][2][4][2], const g8::GUnit& u, int wr, int wc, int fr, int fq, LAS unsigned char* aux, int par) const {
        const int j0 = 128 * u.pn + 32 * wc + 8 * fq; const bool odd = fq & 1;
        const LAS float* sb = (const LAS float*)(aux + par * 2048); const LAS float* bbuf = sb + 256;
        f32x4 bg[2], bl[2];
#pragma unroll
        for (int n = 0; n < 2; ++n) { bg[n] = *(const LAS f32x4*)(bbuf + 32 * wc + 8 * fq + 4 * n); bl[n] = *(const LAS f32x4*)(bbuf + 128 + 32 * wc + 8 * fq + 4 * n); }
        float rsv[2][4];
#pragma unroll
        for (int ai = 0; ai < 2; ++ai)
#pragma unroll
            for (int m = 0; m < 4; ++m) { const int r = 128 * ai + 64 * wr + 16 * m + fr; rsv[ai][m] = (r < u.y) ? sb[r] * 0.03125f : 0.f; }
#pragma unroll
        for (int ai = 0; ai < 2; ++ai)
#pragma unroll
            for (int mp = 0; mp < 2; ++mp) {
                u32x2 h8[2]; int rr[2];
#pragma unroll
                for (int q = 0; q < 2; ++q) { const int m = 2 * mp + q;
                    const int r = 128 * ai + 64 * wr + 16 * m + fr; rr[q] = r;
                    const float rs = rsv[ai][m];
                    f32x4 o[2];
#pragma unroll
                    for (int n = 0; n < 2; ++n)
#pragma unroll
                        for (int e = 0; e < 4; ++e) {
                            float g = fminf(rs * acc[ai][0][m][n][e] + bg[n][e], 7.0f);
                            float l = fminf(fmaxf(rs * acc[ai][1][m][n][e] + bl[n][e], -7.0f), 7.0f);
                            o[n][e] = (l + 1.0f) * g * sigmoidf_(1.702f * g);
                        }
                    h8[q] = pack8_fp8(o[0], o[1]); }
                const u32x2 snd = odd ? h8[0] : h8[1];
                u32x2 rcv; rcv.x = (unsigned)__shfl_xor((int)snd.x, 16); rcv.y = (unsigned)__shfl_xor((int)snd.y, 16);
                const u32x4 w16 = odd ? (u32x4){rcv.x, rcv.y, h8[1].x, h8[1].y} : (u32x4){h8[0].x, h8[0].y, rcv.x, rcv.y};
                const int r = odd ? rr[1] : rr[0];
                if (r < u.y) st16(H + (size_t)(u.x + r) * 1024 + (odd ? j0 - 8 : j0), w16);
            }
        return false;
    }
};
struct EpiMoe2 {
    const float* GLIST; const GAS float* b2; unsigned char* Y2;
    __device__ __forceinline__ void aux_dma(const g8::GUnit& u, LAS unsigned char* aux, int par, int wid, int lane) const {
        if (wid == 4) __builtin_amdgcn_global_load_lds((const unsigned*)(GLIST + (size_t)u.e * NTOK + 256 * u.rt + 4 * lane), (LAS unsigned*)(aux + par * 2048), 16, 0, 0);
        if (wid == 5) __builtin_amdgcn_global_load_lds((const unsigned*)((const float*)b2 + (size_t)u.e * 1024 + 256 * u.pn + 4 * lane), (LAS unsigned*)(aux + par * 2048 + 1024), 16, 0, 0); }
    __device__ __forceinline__ bool operator()(f32x4 (&acc)[2][2][4][2], const g8::GUnit& u, int wr, int wc, int fr, int fq, LAS unsigned char* aux, int par) const {
        const int c0 = 256 * u.pn + 64 * wc + 8 * fq; const bool odd = fq & 1;
        const LAS float* sb = (const LAS float*)(aux + par * 2048); const LAS float* bbuf = sb + 256;
        f32x4 bb[2][2];
#pragma unroll
        for (int bj = 0; bj < 2; ++bj)
#pragma unroll
            for (int n = 0; n < 2; ++n) bb[bj][n] = *(const LAS f32x4*)(bbuf + 64 * wc + 8 * fq + 32 * bj + 4 * n);
        float gtv[2][4];
#pragma unroll
        for (int ai = 0; ai < 2; ++ai)
#pragma unroll
            for (int m = 0; m < 4; ++m) { const int r = 128 * ai + 64 * wr + 16 * m + fr; gtv[ai][m] = (r < u.y) ? sb[r] * 16.0f : 0.f; }
#pragma unroll
        for (int ai = 0; ai < 2; ++ai)
#pragma unroll
            for (int m = 0; m < 4; ++m) {
                const int r = 128 * ai + 64 * wr + 16 * m + fr; const bool valid = r < u.y;
                const float gt = gtv[ai][m];
                u32x2 f8[2];
#pragma unroll
                for (int bj = 0; bj < 2; ++bj) f8[bj] = pack8_fp8((acc[ai][bj][m][0] * 0.03125f + bb[bj][0]) * gt, (acc[ai][bj][m][1] * 0.03125f + bb[bj][1]) * gt);
                const u32x2 snd = odd ? f8[0] : f8[1];
                u32x2 rcv; rcv.x = (unsigned)__shfl_xor((int)snd.x, 16); rcv.y = (unsigned)__shfl_xor((int)snd.y, 16);
                const u32x4 w16 = odd ? (u32x4){rcv.x, rcv.y, f8[1].x, f8[1].y} : (u32x4){f8[0].x, f8[0].y, rcv.x, rcv.y};
                if (valid) st16(Y2 + (size_t)(u.x + r) * 1024 + 256 * u.pn + 64 * wc + (odd ? 32 + 8 * (fq - 1) : 8 * fq), w16);
            }
        return false;
    }
};

constexpr int KP = 160, VP = 288;
constexpr int ML_K = 0, ML_V = 256 * KP, ML_C = ML_V + 256 * VP, ML_F = ML_C + 64 * VP, ML_OST = ML_F + 3328;
__device__ __forceinline__ float logsigmoidf_(float f) { return fminf(f, 0.f) - log1pf(__expf(-fabsf(f))); }

__device__ __forceinline__ void ml_gates(Frame& F, int n0, int h, LAS float* Bc, LAS float* ig) {
    if (F.wave == 0) {
        const float* G = WSP(float, WS_GATES);
        float lf[4], iv[4];
#pragma unroll
        for (int e = 0; e < 4; ++e) { const size_t t = (size_t)(n0 + 4 * F.lane + e) * 8; iv[e] = G[t + h]; lf[e] = logsigmoidf_(G[t + 4 + h]); }
        lf[1] += lf[0]; lf[2] += lf[1]; lf[3] += lf[2];
        float tot = lf[3], inc = tot;
#pragma unroll
        for (int o = 1; o < 64; o <<= 1) { const float t = __shfl_up(inc, o); if (F.lane >= o) inc += t; }
        const float exc = inc - tot;
#pragma unroll
        for (int e = 0; e < 4; ++e) { Bc[4 * F.lane + e] = exc + lf[e]; ig[4 * F.lane + e] = iv[e]; }
    }
}

__device__ __forceinline__ void mlstm_state_unit(Frame& F, int u) {
    const int bh = u >> 6, sc = u & 63, b = bh >> 2, h = bh & 3;
    const int n0 = b * SEQ + sc * 256;
    LAS unsigned char* Ks = F.lds + ML_K; LAS unsigned char* Vs = F.lds + ML_V;
    LAS float* Bc = (LAS float*)(F.lds + ML_F); LAS float* ig = Bc + 256;
    const bf16_t* MK = WSP(bf16_t, WS_MK); const bf16_t* MV = WSP(bf16_t, WS_MV);
    u32x4 kreg[4], vreg[8];
#pragma unroll
    for (int t = 0; t < 4; ++t) { const int c = F.tid + 512 * t, s = c >> 3, ch = c & 7; kreg[t] = *(const u32x4*)(MK + (size_t)(n0 + s) * 256 + h * 64 + ch * 8); }
#pragma unroll
    for (int t = 0; t < 8; ++t) { const int c = F.tid + 512 * t, s = c >> 4, ch = c & 15; vreg[t] = *(const u32x4*)(MV + (size_t)(n0 + s) * 512 + h * 128 + ch * 8); }
    ml_gates(F, n0, h, Bc, ig);
    __syncthreads();
    const float Gt = Bc[255];
#pragma unroll
    for (int t = 0; t < 4; ++t) { const int c = F.tid + 512 * t, s = c >> 3, ch = c & 7; const float w = __expf(Gt - Bc[s] + ig[s]);
        f32x4 a0, a1; unpack8(kreg[t], a0, a1);
        *(LAS u32x4*)(Ks + s * KP + ch * 16) = pack8(a0 * w, a1 * w); }
#pragma unroll
    for (int t = 0; t < 8; ++t) { const int c = F.tid + 512 * t, s = c >> 4, ch = c & 15; *(LAS u32x4*)(Vs + s * VP + ch * 16) = vreg[t]; }
    __syncthreads();
    const int i = F.lane & 15, g = F.lane >> 4, w = F.wave;
    f32x4 acc[4], accn[4];
#pragma unroll
    for (int t = 0; t < 4; ++t) { acc[t] = (f32x4){0.f, 0.f, 0.f, 0.f}; accn[t] = (f32x4){0.f, 0.f, 0.f, 0.f}; }
    const bf16x8 ones = (bf16x8){0x3F80, 0x3F80, 0x3F80, 0x3F80, 0x3F80, 0x3F80, 0x3F80, 0x3F80};
    const int roff = (4 * g + (i >> 2));
    for (int ks = 0; ks < 8; ++ks) {
        const int s0 = 32 * ks;
        const LAS unsigned char* vp = Vs + (s0 + roff) * VP + (16 * w + 4 * (i & 3)) * 2;
        const bf16x8 bv = cat4(trread(vp), trread(vp + 16 * VP));
#pragma unroll
        for (int dk = 0; dk < 4; ++dk) {
            const LAS unsigned char* kp = Ks + (s0 + roff) * KP + (16 * dk + 4 * (i & 3)) * 2;
            const bf16x8 ak = cat4(trread(kp), trread(kp + 16 * KP));
            acc[dk] = MFMA16(ak, bv, acc[dk]);
            if (w == 0) accn[dk] = MFMA16(ak, ones, accn[dk]);
        }
    }
    float* CL = WSP(float, WS_CLOC) + (size_t)u * 8192;
#pragma unroll
    for (int dk = 0; dk < 4; ++dk)
#pragma unroll
        for (int r = 0; r < 4; ++r) CL[(16 * dk + 4 * g + r) * 128 + 16 * w + i] = acc[dk][r];
    if (w == 0 && i == 0) {
#pragma unroll
        for (int dk = 0; dk < 4; ++dk)
#pragma unroll
            for (int r = 0; r < 4; ++r) WSP(float, WS_MSTAT)[(size_t)u * 64 + 16 * dk + 4 * g + r] = accn[dk][r];
    }
    if (F.tid == 0) WSP(float, WS_MSTAT)[512 * 64 + u] = Gt;
    __syncthreads();
}

__device__ __forceinline__ void mlstm_scan(Frame& F) {
    const int gt = F.vcu * 512 + F.tid, NT = F.G * 512;
    const float* GT = WSP(float, WS_MSTAT) + 512 * 64;
    for (int idx = gt; idx < 8 * 8256; idx += NT) {
        const int bh = idx / 8256, el = idx % 8256;
        const float* p; float* q; size_t stride;
        if (el < 8192) { p = WSP(float, WS_CLOC) + (size_t)bh * 64 * 8192 + el; q = WSP(float, WS_CINIT) + (size_t)bh * 64 * 8192 + el; stride = 8192; }
        else { p = WSP(float, WS_MSTAT) + (size_t)bh * 64 * 64 + (el - 8192); q = WSP(float, WS_NINIT) + (size_t)bh * 64 * 64 + (el - 8192); stride = 64; }
        float st = 0.f;
#pragma unroll 1
        for (int s0 = 0; s0 < 64; s0 += 32) {
            float v[32], gv[32];
#pragma unroll
            for (int k = 0; k < 32; ++k) { v[k] = p[(size_t)(s0 + k) * stride]; gv[k] = GT[bh * 64 + s0 + k]; }
#pragma unroll
            for (int k = 0; k < 32; ++k) { q[(size_t)(s0 + k) * stride] = st; st = __expf(gv[k]) * st + v[k]; }
        }
    }
}

__device__ __forceinline__ void mlstm_out_unit(Frame& F, int u) {
    const int bh = u >> 6, sc = u & 63, b = bh >> 2, h = bh & 3;
    const int n0 = b * SEQ + sc * 256;
    LAS unsigned char* Ks = F.lds + ML_K; LAS unsigned char* Vs = F.lds + ML_V; LAS unsigned char* Cs = F.lds + ML_C;
    LAS float* Bc = (LAS float*)(F.lds + ML_F); LAS float* cS = Bc + 256; LAS float* eB = Bc + 512; LAS float* nI = Bc + 768;
    const bf16_t* MK = WSP(bf16_t, WS_MK); const bf16_t* MV = WSP(bf16_t, WS_MV);
    u32x4 kreg[4], vreg[8]; f32x4 creg[2][2];
#pragma unroll
    for (int t = 0; t < 4; ++t) { const int c = F.tid + 512 * t, s = c >> 3, ch = c & 7; kreg[t] = *(const u32x4*)(MK + (size_t)(n0 + s) * 256 + h * 64 + ch * 8); }
#pragma unroll
    for (int t = 0; t < 8; ++t) { const int c = F.tid + 512 * t, s = c >> 4, ch = c & 15; vreg[t] = *(const u32x4*)(MV + (size_t)(n0 + s) * 512 + h * 128 + ch * 8); }
    { const float* CL = WSP(float, WS_CINIT) + (size_t)u * 8192;
#pragma unroll
      for (int t = 0; t < 2; ++t) { const int c = F.tid + 512 * t, dk = c >> 4, ch = c & 15; creg[t][0] = *(const f32x4*)(CL + dk * 128 + ch * 8); creg[t][1] = *(const f32x4*)(CL + dk * 128 + ch * 8 + 4); } }
    const float nIv = (F.tid < 64) ? WSP(float, WS_NINIT)[(size_t)u * 64 + F.tid] : 0.f;
    ml_gates(F, n0, h, Bc, cS);
    __syncthreads();
    if (F.tid < 256) { const float bt = Bc[F.tid]; const float iv = cS[F.tid]; eB[F.tid] = __expf(bt); __builtin_amdgcn_s_waitcnt(0); cS[F.tid] = (iv - bt) * LOG2E; Bc[F.tid] = bt * LOG2E; }
    if (F.tid < 64) nI[F.tid] = nIv;
#pragma unroll
    for (int t = 0; t < 4; ++t) { const int c = F.tid + 512 * t, s = c >> 3, ch = c & 7; *(LAS u32x4*)(Ks + s * KP + ch * 16) = kreg[t]; }
#pragma unroll
    for (int t = 0; t < 8; ++t) { const int c = F.tid + 512 * t, s = c >> 4, ch = c & 15; *(LAS u32x4*)(Vs + s * VP + ch * 16) = vreg[t]; }
#pragma unroll
    for (int t = 0; t < 2; ++t) { const int c = F.tid + 512 * t, dk = c >> 4, ch = c & 15; *(LAS u32x4*)(Cs + dk * VP + ch * 16) = pack8(creg[t][0], creg[t][1]); }
    __syncthreads();
    const int i = F.lane & 15, g = F.lane >> 4, w = F.wave;
    const bf16_t* MQ = WSP(bf16_t, WS_MQ); const bf16_t* MO = WSP(bf16_t, WS_MO);
    const GAS float* mg = INP(I_MNG) + h * 128;
    LAS unsigned char* ost = F.lds + ML_OST + w * 2176;
    float gnv[8];
#pragma unroll
    for (int dv = 0; dv < 8; ++dv) gnv[dv] = mg[16 * dv + i];
#pragma unroll 1
    for (int half = 0; half < 2; ++half) {
        const int rt = half == 0 ? w : 15 - w;
        const int tq = 16 * rt + i;
        bf16x8 qf[2];
#pragma unroll
        for (int ks = 0; ks < 2; ++ks) qf[ks] = *(const bf16x8*)(MQ + (size_t)(n0 + tq) * 256 + h * 64 + 32 * ks + 8 * g);
        u32x4 mo[2][2];
#pragma unroll
        for (int hf = 0; hf < 2; ++hf)
#pragma unroll
            for (int q = 0; q < 2; ++q) mo[hf][q] = *(const u32x4*)(MO + (size_t)(n0 + 16 * rt + (F.lane >> 3) + 8 * q) * 512 + h * 128 + 64 * hf + 8 * (F.lane & 7));
        f32x4 acc[8];
#pragma unroll
        for (int t = 0; t < 8; ++t) acc[t] = (f32x4){0.f, 0.f, 0.f, 0.f};
        float dni = 0.f;
#pragma unroll
        for (int ks = 0; ks < 2; ++ks) {
#pragma unroll
            for (int j = 0; j < 8; ++j) dni += bf2f((bf16_t)qf[ks][j]) * nI[32 * ks + 8 * g + j];
#pragma unroll
            for (int dv = 0; dv < 8; ++dv) {
                const LAS unsigned char* cp = Cs + (32 * ks + 8 * g + (i >> 2)) * VP + (16 * dv + 4 * (i & 3)) * 2;
                acc[dv] = MFMA16(qf[ks], cat4(trread(cp), trread(cp + 4 * VP)), acc[dv]);
            }
        }
        dni += __shfl_xor(dni, 16); dni += __shfl_xor(dni, 32);
        float den = dni * eB[tq];
        { float er[4];
#pragma unroll
          for (int r = 0; r < 4; ++r) er[r] = eB[16 * rt + 4 * g + r];
#pragma unroll
          for (int dv = 0; dv < 8; ++dv)
#pragma unroll
            for (int r = 0; r < 4; ++r) acc[dv][r] *= er[r]; }
        const float bt2 = Bc[tq];
        float dpart = 0.f;
        const int nks = (rt >> 1) + 1;
        for (int ks = 0; ks < nks; ++ks) {
            const int s0 = 32 * ks;
            f32x4 s0v = (f32x4){0.f, 0.f, 0.f, 0.f}, s1v = (f32x4){0.f, 0.f, 0.f, 0.f};
#pragma unroll
            for (int kk = 0; kk < 2; ++kk) {
                const bf16x8 k0 = *(const LAS bf16x8*)(Ks + (s0 + i) * KP + (32 * kk + 8 * g) * 2);
                const bf16x8 k1 = *(const LAS bf16x8*)(Ks + (s0 + 16 + i) * KP + (32 * kk + 8 * g) * 2);
                s0v = MFMA16(k0, qf[kk], s0v); s1v = MFMA16(k1, qf[kk], s1v);
            }
            const f32x4 c0 = *(const LAS f32x4*)(cS + s0 + 4 * g), c1 = *(const LAS f32x4*)(cS + s0 + 16 + 4 * g);
            f32x4 p0, p1;
#pragma unroll
            for (int r = 0; r < 4; ++r) {
                const int sa = s0 + 4 * g + r, sb = sa + 16;
                p0[r] = (sa <= tq) ? s0v[r] * __builtin_amdgcn_exp2f(bt2 + c0[r]) : 0.f;
                p1[r] = (sb <= tq) ? s1v[r] * __builtin_amdgcn_exp2f(bt2 + c1[r]) : 0.f;
                dpart += p0[r] + p1[r];
            }
            const u32x4 pw = pack8(p0, p1); const bf16x8 pa = __builtin_bit_cast(bf16x8, pw);
#pragma unroll
            for (int dv = 0; dv < 8; ++dv) {
                const LAS unsigned char* vp = Vs + (s0 + 4 * g + (i >> 2)) * VP + (16 * dv + 4 * (i & 3)) * 2;
                acc[dv] = MFMA16(pa, cat4(trread(vp), trread(vp + 16 * VP)), acc[dv]);
            }
        }
        dpart += __shfl_xor(dpart, 16); dpart += __shfl_xor(dpart, 32);
        den += dpart;
        float ss[4], dn[4];
#pragma unroll
        for (int r = 0; r < 4; ++r) { const float d = __shfl(den, 4 * g + r); dn[r] = __builtin_amdgcn_rcpf(fmaxf(fabsf(d), 1.0f)); ss[r] = 0.f; }
#pragma unroll
        for (int dv = 0; dv < 8; ++dv)
#pragma unroll
            for (int r = 0; r < 4; ++r) { acc[dv][r] *= dn[r]; ss[r] += acc[dv][r] * acc[dv][r]; }
#pragma unroll
        for (int r = 0; r < 4; ++r) { float s = ss[r]; s += __shfl_xor(s, 1); s += __shfl_xor(s, 2); s += __shfl_xor(s, 4); s += __shfl_xor(s, 8); ss[r] = __builtin_amdgcn_rsqf(s * (1.0f / 128.0f) + EPS); }
#pragma unroll
        for (int hf = 0; hf < 2; ++hf) {
#pragma unroll
            for (int dq = 0; dq < 4; ++dq) { const int dv = 4 * hf + dq;
#pragma unroll
                for (int r = 0; r < 4; ++r) *(LAS bf16_t*)(ost + (4 * g + r) * 136 + (16 * dq + i) * 2) = (bf16_t)f2bf(acc[dv][r] * ss[r] * gnv[dv]); }
            LDS_WAIT();
#pragma unroll
            for (int q = 0; q < 2; ++q) { const int row = (F.lane >> 3) + 8 * q, ch = F.lane & 7;
                const LAS unsigned* sp = (const LAS unsigned*)(ost + row * 136 + ch * 16);
                const u32x4 hv = (u32x4){sp[0], sp[1], sp[2], sp[3]};
                f32x4 a0, a1, m0, m1; unpack8(hv, a0, a1); unpack8(mo[hf][q], m0, m1);
                *(u32x4*)(WSP(bf16_t, WS_HM) + (size_t)(n0 + 16 * rt + row) * 512 + h * 128 + 64 * hf + 8 * ch) = pack8(a0 * m0, a1 * m1); }
            LDS_WAIT();
        }
    }
    __syncthreads();
}

struct AUnit { int b, grp, h, d, rc, qb, cont; };
__device__ __forceinline__ AUnit attn_decode(int u) { AUnit a; a.b = u / 1536; int r_ = u % 1536; a.grp = r_ / 512; r_ %= 512; a.h = r_ / 128; const int j = r_ % 128;
    a.d = a.grp == 0 ? 1 : (a.grp == 1 ? 4 : 16); const int nb = 128 / a.d; a.rc = j / nb; a.qb = j % nb; a.cont = 0; return a; }
__device__ __forceinline__ void attn_fetch(Frame& F, const AUnit& a, u32x4 (&kr)[4], u32x4 (&vr)[4], bf16x8 (&qf)[2]) {
    const bf16_t* AK = WSP(bf16_t, WS_AK); const bf16_t* AV = WSP(bf16_t, WS_AV); const bf16_t* AQ = WSP(bf16_t, WS_AQ);
    const size_t hoff = (size_t)a.grp * 256 + a.h * 64; const int kk0 = a.qb == 0 ? 128 : 0;
#pragma unroll
    for (int t = 0; t < 4; ++t) { const int c = F.tid + 512 * t, kk = c >> 3, ch = c & 7;
        kr[t] = (u32x4){0u, 0u, 0u, 0u}; vr[t] = kr[t];
        if (kk >= kk0 && !(a.cont && t < 2)) { const int tok = (128 * (a.qb - 1) + kk) * a.d + a.rc; const size_t o = (size_t)(a.b * SEQ + tok) * 768 + hoff + ch * 8; kr[t] = *(const u32x4*)(AK + o); vr[t] = *(const u32x4*)(AV + o); } }
    const int i = F.lane & 15, g = F.lane >> 4; const int tokq = (128 * a.qb + 16 * F.wave + i) * a.d + a.rc;
#pragma unroll
    for (int ks = 0; ks < 2; ++ks) qf[ks] = *(const bf16x8*)(AQ + (size_t)(a.b * SEQ + tokq) * 768 + hoff + 32 * ks + 8 * g);
}
__device__ __forceinline__ void attn_compute(Frame& F, const AUnit& a, const bf16x8 (&qf)[2]) {
    const int b = a.b, grp = a.grp, h = a.h, d = a.d, rc = a.rc, qb = a.qb;
    LAS unsigned char* Ks = F.lds; LAS unsigned char* Vs = F.lds + 256 * KP;
    const int kk0 = qb == 0 ? 128 : 0;
    const int i = F.lane & 15, g = F.lane >> 4, w = F.wave;
    const int qi = 16 * w + i;
    const int tokq = (128 * qb + qi) * d + rc;
    const float slope2 = exp2f(-8.0f * (float)(grp * 4 + h + 1) / 12.0f) * (float)d * LOG2E;
    const int slo = w >> 1;
    f32x4 s0v[5], s1v[5];
    float mx = -INFINITY;
    const int dbase = qi + 128 - 32 * slo - 4 * g;
    const float nb0 = -slope2 * (float)dbase;
#pragma unroll
    for (int si = 0; si < 5; ++si) {
        const int kb = 32 * (slo + si);
        const int pb = (((qb - 1 + (kb >> 7)) & 1) << 7) | (kb & 127);
        f32x4 a0, a1;
#pragma unroll
        for (int r = 0; r < 4; ++r) { a0[r] = nb0 + slope2 * (float)(32 * si + r); a1[r] = nb0 + slope2 * (float)(32 * si + r + 16); }
#pragma unroll
        for (int kk = 0; kk < 2; ++kk) {
            const bf16x8 k0 = *(const LAS bf16x8*)(Ks + (pb + i) * KP + (32 * kk + 8 * g) * 2);
            const bf16x8 k1 = *(const LAS bf16x8*)(Ks + (pb + 16 + i) * KP + (32 * kk + 8 * g) * 2);
            a0 = MFMA16(k0, qf[kk], a0); a1 = MFMA16(k1, qf[kk], a1);
        }
        if (si == 0 || si == 4 || kk0) {
#pragma unroll
            for (int r = 0; r < 4; ++r) {
                const int ka = kb + 4 * g + r, kc = ka + 16;
                const int da = dbase - 32 * si - r, dc = da - 16;
                if (!(da >= 0 && da <= 128 && ka >= kk0)) a0[r] = -INFINITY;
                if (!(dc >= 0 && dc <= 128 && kc >= kk0)) a1[r] = -INFINITY;
            }
        }
#pragma unroll
        for (int r = 0; r < 4; ++r) mx = fmaxf(mx, fmaxf(a0[r], a1[r]));
        s0v[si] = a0; s1v[si] = a1;
    }
    mx = fmaxf(mx, __shfl_xor(mx, 16)); mx = fmaxf(mx, __shfl_xor(mx, 32));
    float den = 0.f;
    f32x4 o[4];
#pragma unroll
    for (int t = 0; t < 4; ++t) o[t] = (f32x4){0.f, 0.f, 0.f, 0.f};
#pragma unroll
    for (int si = 0; si < 5; ++si) {
        const int kb = 32 * (slo + si);
        const int pb = (((qb - 1 + (kb >> 7)) & 1) << 7) | (kb & 127);
        f32x4 p0, p1;
#pragma unroll
        for (int r = 0; r < 4; ++r) { p0[r] = __builtin_amdgcn_exp2f(s0v[si][r] - mx); p1[r] = __builtin_amdgcn_exp2f(s1v[si][r] - mx); den += p0[r] + p1[r]; }
        const u32x4 pw = pack8(p0, p1); const bf16x8 pa = __builtin_bit_cast(bf16x8, pw);
#pragma unroll
        for (int dt = 0; dt < 4; ++dt) {
            const LAS unsigned char* vp = Vs + (pb + 4 * g + (i >> 2)) * KP + (16 * dt + 4 * (i & 3)) * 2;
            o[dt] = MFMA16(pa, cat4(trread(vp), trread(vp + 16 * KP)), o[dt]);
        }
    }
    den += __shfl_xor(den, 16); den += __shfl_xor(den, 32);
    if (g == 0) WSP(float, WS_LSE)[((size_t)grp * NTOK + b * SEQ + tokq) * 4 + h] = mx + __log2f(den);
    bf16_t* AO = WSP(bf16_t, WS_AO) + (size_t)grp * NTOK * 256;
    LAS unsigned char* ost = F.lds + 2 * 256 * KP + w * 2176;
#pragma unroll
    for (int r = 0; r < 4; ++r) {
        const float dn = __builtin_amdgcn_rcpf(__shfl(den, 4 * g + r));
#pragma unroll
        for (int dt = 0; dt < 4; ++dt) *(LAS bf16_t*)(ost + (4 * g + r) * 136 + (16 * dt + i) * 2) = (bf16_t)f2bf(o[dt][r] * dn);
    }
    LDS_WAIT();
#pragma unroll
    for (int q = 0; q < 2; ++q) { const int row = (F.lane >> 3) + 8 * q, ch = F.lane & 7;
        const LAS unsigned* sp = (const LAS unsigned*)(ost + row * 136 + ch * 16);
        const u32x4 hv = (u32x4){sp[0], sp[1], sp[2], sp[3]};
        const int tk = (128 * qb + 16 * w + row) * d + rc;
        *(u32x4*)(AO + (size_t)(b * SEQ + tk) * 256 + h * 64 + 8 * ch) = hv; }
    LDS_WAIT();
}
__device__ __forceinline__ void attn_phase(Frame& F) {
    LAS unsigned char* Ks = F.lds; LAS unsigned char* Vs = F.lds + 256 * KP;
    u32x4 k0[4], v0[4], k1[4], v1[4]; bf16x8 q0[2], q1[2], qc[2];
    const int per = (3072 + F.G - 1) / F.G; const int ub = F.vcu * per, ue = (ub + per < 3072) ? ub + per : 3072;
    int u = ub;
    if (u >= ue) return;
#define ATTN_DEC(A, U) do { A = attn_decode(U); A.cont = ((U) > ub && A.qb != 0) ? 1 : 0; } while (0)
    AUnit c0, c1; ATTN_DEC(c0, u); c1 = c0;
    attn_fetch(F, c0, k0, v0, q0);
    bool has1 = (u + 1) < ue;
    if (has1) { ATTN_DEC(c1, u + 1); attn_fetch(F, c1, k1, v1, q1); }
#define ATTN_STEP(KR, VR, QR, CU, UN) do { \
        _Pragma("unroll") for (int t = 0; t < 4; ++t) { const int c = F.tid + 512 * t, kk = c >> 3, ch = c & 7; \
            const int pr = (((CU.qb - 1 + (kk >> 7)) & 1) << 7) | (kk & 127); \
            if (!(CU.cont && t < 2)) { *(LAS u32x4*)(Ks + pr * KP + ch * 16) = KR[t]; *(LAS u32x4*)(Vs + pr * KP + ch * 16) = VR[t]; } } \
        qc[0] = QR[0]; qc[1] = QR[1]; \
        __syncthreads(); \
        const AUnit cur_ = CU; const int un_ = (UN); const bool hn_ = un_ < ue; \
        if (hn_) { ATTN_DEC(CU, un_); attn_fetch(F, CU, KR, VR, QR); } \
        attn_compute(F, cur_, qc); \
        __syncthreads(); } while (0)
    for (;;) {
        ATTN_STEP(k0, v0, q0, c0, u + 2);
        if (!has1) break;
        ATTN_STEP(k1, v1, q1, c1, u + 3);
        u += 2;
        if (u >= ue) break;
        has1 = (u + 1) < ue;
    }
#undef ATTN_STEP
#undef ATTN_DEC
}

__device__ __forceinline__ void attn_merge(Frame& F) {
    const int gt = F.vcu * 512 + F.tid, NT = F.G * 512;
    const float* LSE = WSP(float, WS_LSE); const bf16_t* AO = WSP(bf16_t, WS_AO);
    for (int idx = gt; idx < NTOK * 32; idx += NT) {
        const int n = idx >> 5, ch = idx & 31, h = ch >> 3;
        const float l0 = LSE[((size_t)0 * NTOK + n) * 4 + h], l1 = LSE[((size_t)1 * NTOK + n) * 4 + h], l2 = LSE[((size_t)2 * NTOK + n) * 4 + h];
        const float m = fmaxf(l0, fmaxf(l1, l2));
        float w0 = __builtin_amdgcn_exp2f(l0 - m), w1 = __builtin_amdgcn_exp2f(l1 - m), w2 = __builtin_amdgcn_exp2f(l2 - m);
        const float inv = 1.0f / (w0 + w1 + w2); w0 *= inv; w1 *= inv; w2 *= inv;
        f32x4 a0, a1, b0, b1, c0, c1;
        unpack8(*(const u32x4*)(AO + ((size_t)0 * NTOK + n) * 256 + ch * 8), a0, a1);
        unpack8(*(const u32x4*)(AO + ((size_t)1 * NTOK + n) * 256 + ch * 8), b0, b1);
        unpack8(*(const u32x4*)(AO + ((size_t)2 * NTOK + n) * 256 + ch * 8), c0, c1);
        *(u32x4*)(WSP(bf16_t, WS_HA) + (size_t)n * 512 + ch * 8) = pack8(a0 * w0 + b0 * w1 + c0 * w2, a1 * w0 + b1 * w1 + c1 * w2);
    }
}

__device__ __forceinline__ void route_phase(Frame& F) {
    constexpr int WP = 2064;
    LAS unsigned char* WRs = F.lds;
    LAS int* lcnt = (LAS int*)(F.lds + 32 * WP); LAS int* lbase = lcnt + 32;
    const int i = F.lane & 15, g = F.lane >> 4, w = F.wave;
    const bf16_t* X1B = WSP(bf16_t, WS_X1B); const bf16_t* WR = WSP(bf16_t, WS_WR);
    bool staged = false;
    for (int blk = F.vcu; blk < NTOK / 128; blk += F.G) {
        const int row0 = blk * 128 + 16 * w;
        bf16x8 af[32];
#pragma unroll
        for (int ks = 0; ks < 32; ++ks) af[ks] = *(const bf16x8*)(X1B + (size_t)(row0 + i) * DM + 32 * ks + 8 * g);
        if (!staged) { for (int c = F.tid; c < 32 * 128; c += 512) { const int e = c >> 7, ch = c & 127; *(LAS u32x4*)(WRs + e * WP + ch * 16) = *(const u32x4*)(WR + (size_t)e * DM + ch * 8); } staged = true; }
        if (F.tid < 32) lcnt[F.tid] = 0;
        __syncthreads();
        float ssq;
        { const f32x4* sp = (const f32x4*)(WSP(float, WS_SSQ) + (size_t)(row0 + i) * 16); const f32x4 a = sp[0], b = sp[1], c = sp[2], d4 = sp[3];
          ssq = (a[0] + a[1] + a[2] + a[3]) + (b[0] + b[1] + b[2] + b[3]) + (c[0] + c[1] + c[2] + c[3]) + (d4[0] + d4[1] + d4[2] + d4[3]); }
        const float rstd = __builtin_amdgcn_rsqf(ssq * (1.0f / DM) + EPS);
        f32x4 acc[2]; acc[0] = (f32x4){0.f, 0.f, 0.f, 0.f}; acc[1] = acc[0];
#pragma unroll
        for (int ks = 0; ks < 32; ++ks) {
            const bf16x8 b0 = *(const LAS bf16x8*)(WRs + i * WP + (32 * ks + 8 * g) * 2);
            const bf16x8 b1 = *(const LAS bf16x8*)(WRs + (16 + i) * WP + (32 * ks + 8 * g) * 2);
            acc[0] = MFMA16(af[ks], b0, acc[0]); acc[1] = MFMA16(af[ks], b1, acc[1]);
        }
        const float br0 = INP(I_BR)[i], br1 = INP(I_BR)[16 + i];
        float tv[4][4]; int ti[4][4];
#pragma unroll
        for (int r = 0; r < 4; ++r) {
            const float rs = __shfl(rstd, 4 * g + r);
            float v0 = rs * acc[0][r] + br0, v1 = rs * acc[1][r] + br1;
#pragma unroll
            for (int k = 0; k < 4; ++k) {
                float bv = v0; int bi = i; if (v1 > bv) { bv = v1; bi = 16 + i; }
#pragma unroll
                for (int o = 1; o < 16; o <<= 1) { const float ov = __shfl_xor(bv, o); const int oi = __shfl_xor(bi, o); if (ov > bv || (ov == bv && oi < bi)) { bv = ov; bi = oi; } }
                tv[r][k] = bv; ti[r][k] = bi;
                if (bi == i) v0 = -INFINITY; if (bi == 16 + i) v1 = -INFINITY;
            }
        }
        float mv = 0.f, ssum = 0.f; int me = 0;
#pragma unroll
        for (int r = 0; r < 4; ++r) {
            const float e0 = 1.0f, e1 = __expf(tv[r][1] - tv[r][0]), e2 = __expf(tv[r][2] - tv[r][0]), e3 = __expf(tv[r][3] - tv[r][0]);
            const float s = e0 + e1 + e2 + e3;
            if ((i >> 2) == r) { ssum = s;
                const int k = i & 3; mv = k == 0 ? e0 : (k == 1 ? e1 : (k == 2 ? e2 : e3)); me = k == 0 ? ti[r][0] : (k == 1 ? ti[r][1] : (k == 2 ? ti[r][2] : ti[r][3])); }
        }
        const float gate = mv / ssum;
        const int tok = row0 + 4 * g + (i >> 2);
        const float myrstd = __shfl(rstd, 4 * g + (i >> 2));
        const int rank = __hip_atomic_fetch_add(lcnt + me, 1, __ATOMIC_RELAXED, __HIP_MEMORY_SCOPE_WORKGROUP);
        __syncthreads();
        if (F.tid < 32) lbase[F.tid] = (int)__hip_atomic_fetch_add(WSP(unsigned, WS_CTL) + CW_CNT + F.tid, (unsigned)lcnt[F.tid], RLX_AGENT);
        __syncthreads();
        const int pos = lbase[me] + rank;
        WSP(int, WS_TOPE)[(size_t)tok * 4 + (i & 3)] = me;
        WSP(int, WS_TOPPOS)[(size_t)tok * 4 + (i & 3)] = pos;
        WSP(int, WS_LIST)[(size_t)me * NTOK + pos] = tok;
        WSP(float, WS_GLIST)[(size_t)me * NTOK + pos] = gate;
        WSP(float, WS_SRSTD)[(size_t)me * NTOK + pos] = myrstd;
        __syncthreads();
    }
}

__device__ __forceinline__ void combine_phase(Frame& F) {
    const LAS int* tab = (const LAS int*)(F.lds + TAB_OFF);
    const int gw = F.vcu * 8 + F.wave, NGW = F.G * 8;
    const unsigned char* Y2 = F.ws + WS_Y2;
    const int c = F.lane * 16;
    for (int n0 = gw * 2; n0 < NTOK; n0 += NGW * 2) {
        size_t ro[2][4];
#pragma unroll
        for (int t = 0; t < 2; ++t) { const u32x4 ev = *(const u32x4*)(WSP(int, WS_TOPE) + (size_t)(n0 + t) * 4), pv = *(const u32x4*)(WSP(int, WS_TOPPOS) + (size_t)(n0 + t) * 4);
#pragma unroll
            for (int k = 0; k < 4; ++k) ro[t][k] = (size_t)(tab[40 + (int)ev[k]] + (int)pv[k]) * 1024 + c; }
        f32x4 s[2][4]; u32x4 y[2][4];
#pragma unroll
        for (int t = 0; t < 2; ++t) {
            { const bf16_t* xb = WSP(bf16_t, WS_X1B) + (size_t)(n0 + t) * DM + c; unpack8(*(const u32x4*)xb, s[t][0], s[t][1]); unpack8(*(const u32x4*)(xb + 8), s[t][2], s[t][3]); }
#pragma unroll
            for (int k = 0; k < 4; ++k) y[t][k] = *(const u32x4*)(Y2 + ro[t][k]); }
#pragma unroll
        for (int t = 0; t < 2; ++t) {
            f32x4 m4[4];
#pragma unroll
            for (int q = 0; q < 4; ++q) m4[q] = (f32x4){0.f, 0.f, 0.f, 0.f};
#pragma unroll
            for (int k = 0; k < 4; ++k)
#pragma unroll
                for (int q = 0; q < 4; ++q) { const f32x2 lo = __builtin_amdgcn_cvt_pk_f32_fp8((int)y[t][k][q], false), hi = __builtin_amdgcn_cvt_pk_f32_fp8((int)y[t][k][q], true);
                    m4[q][0] += lo[0]; m4[q][1] += lo[1]; m4[q][2] += hi[0]; m4[q][3] += hi[1]; }
#pragma unroll
            for (int q = 0; q < 4; ++q) *(f32x4*)(F.out + (size_t)(n0 + t) * DM + c + 4 * q) = s[t][q] + m4[q] * 0.0625f; }
    }
}

__global__ void __launch_bounds__(512, 2) hyb_fwd(Args args) {
    extern __shared__ __attribute__((aligned(16))) unsigned char lds[];
    Frame F;
    F.lds = (LAS unsigned char*)lds;
    F.tid = threadIdx.x; F.lane = F.tid & 63; F.wave = __builtin_amdgcn_readfirstlane(F.tid >> 6);
#define REFRESH_IDS() do { } while (0)
    F.G = gridDim.x; { const int bx = blockIdx.x; F.vcu = (F.G % 8 == 0) ? (bx % 8) * (F.G / 8) + bx / 8 : bx; }
    F.ap = (KArgP)__builtin_amdgcn_kernarg_segment_ptr(); F.out = args.out; F.ws = args.ws;
    volatile LAS unsigned* MISC = (volatile LAS unsigned*)(F.lds + MISC_OFF);
    for (int u = F.tid; u < 32; u += 512) MISC[u] = 0u;
    __syncthreads();
    const int lo = args.ph_lo, hi = args.ph_hi & 255, variant = args.ph_hi >> 8;
    XcdBarrier bar; bar.bar = WSP(unsigned, WS_CTL) + CW_BAR; bar.x = 0; bar.st = nullptr;
    if (hi - lo > 1) bar = xcd_barrier_post(WSP(unsigned, WS_CTL) + CW_BAR, MISC + 8, F.tid == 0);
#define IN(k) (lo <= (k) && (k) < hi)
#define SEAM(k) do { if (IN(k) && IN((k) + 1)) { REFRESH_IDS(); xcd_barrier(bar, F.tid == 0); } REFRESH_IDS(); } while (0)

    if (IN(0)) { p0_prologue(F); } SEAM(0);

    if (IN(1)) {
        { SchedInProj S; S.T.init(NTOK / 256, FP8_FROM, F.G, (int)blockIdx.x); S.A = (const char*)WSP(bf16_t, WS_XN); S.B = (const char*)WSP(bf16_t, WS_WIN);
          EpiInProj E{F.ws, INP(I_AQG), INP(I_AKG), 1.0f};
          g8::gemm_phase<EpiInProj, SchedInProj, false>(F.lds, S, E, 2048u, 2048u, F.tid, F.wave); }
        { SchedInProj8 S; S.T.init(NTOK / 256, 23 - FP8_FROM, F.G, (int)blockIdx.x); S.A = (const char*)(F.ws + WS_XN8); S.B = (const char*)(F.ws + WS_WIN8);
          EpiInProj E{F.ws, INP(I_AQG), INP(I_AKG), 0.03125f};
          g8::gemm_phase<EpiInProj, SchedInProj8, true, 1>(F.lds, S, E, 1024u, 1024u, F.tid, F.wave); }
    } SEAM(1);

    if (IN(2)) {
        if (variant != 2) for (int u = F.vcu; u < 512; u += F.G) mlstm_state_unit(F, u);
        if (variant != 1) attn_phase(F);
    } SEAM(2);

    if (IN(3)) { mlstm_scan(F); } SEAM(3);

    if (IN(4)) {
        for (int u = F.vcu; u < 512; u += F.G) mlstm_out_unit(F, u);
        attn_merge(F);
    } SEAM(4);

    if (IN(5)) {
        SchedBranch S; S.T.init(NTOK / 256, 4, F.G, (int)blockIdx.x);
        S.A0 = (const char*)WSP(bf16_t, WS_HM); S.B0 = (const char*)WSP(bf16_t, WS_WM); S.A1 = (const char*)WSP(bf16_t, WS_HA); S.B1 = (const char*)WSP(bf16_t, WS_WA);
        EpiBranch E{WSP(bf16_t, WS_GM), WSP(bf16_t, WS_GA), WSP(bf16_t, WS_Y)};
        g8::gemm_phase<EpiBranch, SchedBranch, false>(F.lds, S, E, 1024u, 1024u, F.tid, F.wave);
    } SEAM(5);

    if (IN(6)) {
        SchedWout S; S.T.init(NTOK / 256, 4, F.G, (int)blockIdx.x); S.A = (const char*)WSP(bf16_t, WS_Y); S.B = (const char*)WSP(bf16_t, WS_WO);
        EpiWout E{WSP(bf16_t, WS_XN), WSP(bf16_t, WS_X1B), F.ws + WS_X1F8, WSP(float, WS_SSQ)};
        g8::gemm_phase<EpiWout, SchedWout, false>(F.lds, S, E, 2048u, 2048u, F.tid, F.wave);
    } SEAM(6);

    if (IN(7)) { route_phase(F); } SEAM(7);

    if (IN(8)) {
        moe_tables(F);
        const LAS int* tab = (const LAS int*)(F.lds + TAB_OFF);
        SchedMoe<8, true> S; S.T.init(__builtin_amdgcn_readfirstlane(tab[32]), 8, F.G, (int)blockIdx.x); S.tab = tab; S.A = (const char*)(F.ws + WS_X1F8); S.B = (const char*)(F.ws + WS_W1); S.LIST = WSP(int, WS_LIST);
        EpiMoe1 E{WSP(float, WS_SRSTD), INP(I_B1), F.ws + WS_H};
        g8::gemm_phase<EpiMoe1, SchedMoe<8, true>, true, 1, G8_LATE_MOE>(F.lds, S, E, 1024u, 1024u, F.tid, F.wave);
    } SEAM(8);

    if (IN(9)) {
        if (lo == 9) moe_tables(F);
        const LAS int* tab = (const LAS int*)(F.lds + TAB_OFF);
        SchedMoe<4, false> S; S.T.init(__builtin_amdgcn_readfirstlane(tab[32]), 4, F.G, (int)blockIdx.x); S.tab = tab; S.A = (const char*)(F.ws + WS_H); S.B = (const char*)(F.ws + WS_W2); S.LIST = WSP(int, WS_LIST);
        EpiMoe2 E{WSP(float, WS_GLIST), INP(I_B2), F.ws + WS_Y2};
        g8::gemm_phase<EpiMoe2, SchedMoe<4, false>, true, 1, G8_LATE_MOE>(F.lds, S, E, 1024u, 1024u, F.tid, F.wave);
    } SEAM(9);

    if (IN(10)) { if (lo == 10) moe_tables(F); combine_phase(F); }
#undef IN
#undef SEAM
}

extern "C" void kernel_launch(void* const* d_in, const int* in_sizes, int n_in, void* d_out, int out_size, void* d_ws, size_t ws_size, hipStream_t stream) {
    static int grid = 0;
    if (grid == 0) {
        if (n_in != 17 || out_size != NTOK * DM || ws_size < WS_NEED) { fprintf(stderr, "kernel_launch: unexpected problem (n_in %d, out %d, ws %zu, need %zu)\n", n_in, out_size, ws_size, (size_t)WS_NEED); grid = -1; return; }
        int dev = 0, cus = 0;
        if (hipGetDevice(&dev) != hipSuccess || hipDeviceGetAttribute(&cus, hipDeviceAttributeMultiprocessorCount, dev) != hipSuccess) { grid = -1; return; }
        if (hipFuncSetAttribute((const void*)hyb_fwd, hipFuncAttributeMaxDynamicSharedMemorySize, LDS_BYTES) != hipSuccess) { fprintf(stderr, "kernel_launch: hipFuncSetAttribute failed\n"); grid = -1; return; }
        int per_cu = 0;
        if (hipOccupancyMaxActiveBlocksPerMultiprocessor(&per_cu, (const void*)hyb_fwd, 512, LDS_BYTES) != hipSuccess || per_cu < 1) fprintf(stderr, "kernel_launch: occupancy query reports %d\n", per_cu);
        (void)hipGetLastError();
        grid = cus;
    }
    if (grid < 0) return;
    (void)hipMemsetAsync((char*)d_ws + WS_CTL, 0, CTL_ZERO_BYTES, stream);
    Args a{};
    for (int i = 0; i < 17; ++i) a.in[i] = (const float*)d_in[i];
    a.out = (float*)d_out; a.ws = (unsigned char*)d_ws;
    if (MK_N_LAUNCHES == 1) { a.ph_lo = 0; a.ph_hi = NPH; hipLaunchKernelGGL(hyb_fwd, dim3(grid), dim3(512), LDS_BYTES, stream, a); }
    else { for (int p = 0; p < (MAXPH < NPH ? MAXPH : NPH); ++p) { a.ph_lo = p; a.ph_hi = p + 1;
            if (p == DUP_PHASE && p == 7) { hipLaunchKernelGGL(hyb_fwd, dim3(grid), dim3(512), LDS_BYTES, stream, a); (void)hipMemsetAsync((char*)d_ws + WS_CTL + CW_CNT * 4, 0, 128, stream); }
            hipLaunchKernelGGL(hyb_fwd, dim3(grid), dim3(512), LDS_BYTES, stream, a);
            if (p == DUP_PHASE && p == 10) { Args a2 = a; a2.out = (float*)((unsigned char*)d_ws + WS_H); hipLaunchKernelGGL(hyb_fwd, dim3(grid), dim3(512), LDS_BYTES, stream, a2); }
            else if (p == DUP_PHASE && p != 7) { Args a2 = a; a2.ph_hi = a.ph_hi + 256 * DUP_VARIANT; hipLaunchKernelGGL(hyb_fwd, dim3(grid), dim3(512), LDS_BYTES, stream, a2); } } }
}
```

```cpp
#include <hip/hip_runtime.h>
#include <cstdio>
#include <cstdint>

#ifndef MK_N_LAUNCHES
#define MK_N_LAUNCHES 1
#endif

#ifndef MAXPH
#define MAXPH 99
#endif
#ifndef DUP_PHASE
#define DUP_PHASE -1
#endif
#ifndef DUP_VARIANT
#define DUP_VARIANT 0
#endif
#define LAS __attribute__((address_space(3)))
#define GAS __attribute__((address_space(1)))
typedef unsigned short bf16_t;
typedef short bf16x8 __attribute__((ext_vector_type(8)));
typedef short s16x4 __attribute__((ext_vector_type(4)));
typedef float f32x4 __attribute__((ext_vector_type(4)));
typedef float f32x2 __attribute__((ext_vector_type(2)));
typedef unsigned u32x4 __attribute__((ext_vector_type(4)));
typedef unsigned u32x2 __attribute__((ext_vector_type(2)));
typedef int v8i_t __attribute__((ext_vector_type(8)));
typedef int v4i_t __attribute__((ext_vector_type(4)));
template <int MODE> struct FragT { typedef bf16x8 type; };
template <> struct FragT<1> { typedef v4i_t type; };

constexpr int NTOK = 32768, SEQ = 16384, DM = 1024;
constexpr int NEXP = 32, DFF = 1024;
constexpr float EPS = 1e-6f;
constexpr float LOG2E = 1.4426950408889634f;
constexpr int NPH = 11;

constexpr size_t MiB = 1u << 20;
constexpr size_t WS_CTL = 0, CTL_ZERO_BYTES = 1 * MiB;
constexpr size_t WS_GATES = 1 * MiB;
constexpr size_t WS_SSQ = 2 * MiB;
constexpr size_t WS_LSE = 4 * MiB;
constexpr size_t WS_TOPE = 6 * MiB;
constexpr size_t WS_TOPPOS = 7 * MiB;
constexpr size_t WS_LIST = 8 * MiB;
constexpr size_t WS_GLIST = 12 * MiB;
constexpr size_t WS_SRSTD = 16 * MiB;
constexpr size_t WS_MSTAT = 20 * MiB;
constexpr size_t WS_RSTD1 = 20 * MiB + 512 * 1024;
constexpr size_t WS_WIN = 21 * MiB;
constexpr size_t WS_WM = 33 * MiB;
constexpr size_t WS_WA = 34 * MiB;
constexpr size_t WS_WO = 35 * MiB;
constexpr size_t WS_WR = 37 * MiB;
constexpr size_t WS_W1 = 38 * MiB;
constexpr size_t WS_W2 = 102 * MiB;
constexpr size_t WS_X1B = 134 * MiB;
constexpr size_t WS_X1F8 = 198 * MiB;
constexpr size_t WS_OVL = 230 * MiB;
constexpr size_t WS_XN = WS_OVL;
constexpr size_t WS_MQ = WS_XN + 64 * MiB;
constexpr size_t WS_MK = WS_MQ + 16 * MiB;
constexpr size_t WS_MV = WS_MK + 16 * MiB;
constexpr size_t WS_MO = WS_MV + 32 * MiB;
constexpr size_t WS_AQ = WS_MO + 32 * MiB;
constexpr size_t WS_AK = WS_AQ + 48 * MiB;
constexpr size_t WS_AV = WS_AK + 48 * MiB;
constexpr size_t WS_GM = WS_AV + 48 * MiB;
constexpr size_t WS_GA = WS_GM + 64 * MiB;
constexpr size_t WS_CLOC = WS_GA + 64 * MiB;
constexpr size_t WS_HM = WS_CLOC + 16 * MiB;
constexpr size_t WS_AO = WS_HM + 32 * MiB;
constexpr size_t WS_HA = WS_AO + 48 * MiB;
constexpr size_t WS_Y = WS_HA + 32 * MiB;
constexpr size_t WS_CINIT = WS_Y + 64 * MiB;
constexpr size_t WS_NINIT = WS_CINIT + 16 * MiB;
constexpr size_t WS_XN8 = WS_NINIT + 1 * MiB;
constexpr size_t WS_WIN8 = WS_XN8 + 32 * MiB;
constexpr size_t WS_END1 = WS_WIN8 + 6 * MiB;
constexpr size_t WS_H = WS_OVL;
constexpr size_t WS_Y2 = WS_OVL + 130 * MiB;
constexpr size_t WS_END2 = WS_Y2 + 256 * MiB;
constexpr size_t WS_NEED = (WS_END1 > WS_END2 ? WS_END1 : WS_END2);

constexpr int CW_CNT = 64;
constexpr int CW_BAR = 4096;

constexpr int RING_BYTES = 131072;
constexpr int TAB_OFF = 163840 - 256 - 1024;
constexpr int ROWBUF_OFF = RING_BYTES + 1024;
constexpr int TAB_OFF_UNUSED = 0;
constexpr int LDS_BYTES = 163840;
constexpr int MISC_OFF = LDS_BYTES - 256;

#define LOG2E_ 1.4426950408889634f
#define LDS_WAIT() asm volatile("s_waitcnt lgkmcnt(0)" ::: "memory")
#define VM_WAIT() asm volatile("s_waitcnt vmcnt(0)" ::: "memory")
__device__ __forceinline__ unsigned f2bf(float f) { unsigned u = __builtin_bit_cast(unsigned, f); return (u + 0x7fffu + ((u >> 16) & 1u)) >> 16; }
typedef __bf16 bf16x2_hw __attribute__((ext_vector_type(2)));
__device__ __forceinline__ unsigned pk2(float lo, float hi) { const f32x2 v = {lo, hi}; return __builtin_bit_cast(unsigned, __builtin_convertvector(v, bf16x2_hw)); }
__device__ __forceinline__ float bflo(unsigned w) { return __builtin_bit_cast(float, w << 16); }
__device__ __forceinline__ float bfhi(unsigned w) { return __builtin_bit_cast(float, w & 0xffff0000u); }
__device__ __forceinline__ float bf2f(bf16_t h) { return __builtin_bit_cast(float, (unsigned)h << 16); }
__device__ __forceinline__ float sigmoidf_(float x) { return __builtin_amdgcn_rcpf(1.0f + __builtin_amdgcn_exp2f(-LOG2E_ * x)); }
__device__ __forceinline__ u32x4 pack8(const f32x4 a, const f32x4 b) { u32x4 w; w.x = pk2(a[0], a[1]); w.y = pk2(a[2], a[3]); w.z = pk2(b[0], b[1]); w.w = pk2(b[2], b[3]); return w; }
__device__ __forceinline__ void unpack8(const u32x4 w, f32x4& a, f32x4& b) { a[0] = bflo(w.x); a[1] = bfhi(w.x); a[2] = bflo(w.y); a[3] = bfhi(w.y); b[0] = bflo(w.z); b[1] = bfhi(w.z); b[2] = bflo(w.w); b[3] = bfhi(w.w); }
__device__ __forceinline__ u32x2 pack8_fp8(const f32x4 a, const f32x4 b) { int w0 = 0, w1 = 0;
    w0 = __builtin_amdgcn_cvt_pk_fp8_f32(a[0], a[1], w0, false); w0 = __builtin_amdgcn_cvt_pk_fp8_f32(a[2], a[3], w0, true);
    w1 = __builtin_amdgcn_cvt_pk_fp8_f32(b[0], b[1], w1, false); w1 = __builtin_amdgcn_cvt_pk_fp8_f32(b[2], b[3], w1, true); return (u32x2){(unsigned)w0, (unsigned)w1}; }
#ifndef ST_WT
#define ST_WT 0
#endif
__device__ __forceinline__ unsigned q8_4(const f32x4 s, const float lo) {
    const unsigned b0 = __builtin_bit_cast(unsigned, fmaxf(s[0], lo) * 255.0f + 12582912.0f), b1 = __builtin_bit_cast(unsigned, fmaxf(s[1], lo) * 255.0f + 12582912.0f);
    const unsigned b2 = __builtin_bit_cast(unsigned, fmaxf(s[2], lo) * 255.0f + 12582912.0f), b3 = __builtin_bit_cast(unsigned, fmaxf(s[3], lo) * 255.0f + 12582912.0f);
    return __builtin_amdgcn_perm(b1, b0, 0x0c0c0400u) | (__builtin_amdgcn_perm(b3, b2, 0x0c0c0400u) << 16);
}
__device__ __forceinline__ u32x2 pack8_q8(const f32x4 a, const f32x4 b, const float lo) { return (u32x2){q8_4(a, lo), q8_4(b, lo)}; }
__device__ __forceinline__ void unpack8_q8(const u32x2 w, f32x4& a, f32x4& b) {
    a[0] = (float)(w.x & 0xffu); a[1] = (float)((w.x >> 8) & 0xffu); a[2] = (float)((w.x >> 16) & 0xffu); a[3] = (float)(w.x >> 24);
    b[0] = (float)(w.y & 0xffu); b[1] = (float)((w.y >> 8) & 0xffu); b[2] = (float)((w.y >> 16) & 0xffu); b[3] = (float)(w.y >> 24); }
__device__ __forceinline__ void st16(void* p, const u32x4 v) {
#if ST_WT
    asm volatile("global_store_dwordx4 %0, %1, off sc1\n\ts_nop 1" :: "v"(p), "v"(v) : "memory");
#else
    *(u32x4*)p = v;
#endif
}
typedef short v4i16_t __attribute__((ext_vector_type(4)));
__device__ __forceinline__ s16x4 trread(const LAS unsigned char* p) { return __builtin_bit_cast(s16x4, __builtin_amdgcn_ds_read_tr16_b64_v4i16((LAS v4i16_t*)p)); }
__device__ __forceinline__ bf16x8 cat4(s16x4 lo, s16x4 hi) { return (bf16x8){lo[0], lo[1], lo[2], lo[3], hi[0], hi[1], hi[2], hi[3]}; }
#define MFMA16(a, b, c) __builtin_amdgcn_mfma_f32_16x16x32_bf16((a), (b), (c), 0, 0, 0)

namespace g8 {
#ifndef G8_LATE_MOE
#define G8_LATE_MOE false
#endif
#ifndef G8_LATE_BF
#define G8_LATE_BF false
#endif
#ifndef FP8_FROM
#define FP8_FROM 4
#endif
#ifndef W2_TAIL
#define W2_TAIL 6144
#endif
#ifndef G8_WGM
#define G8_WGM 4
#endif
constexpr int BM = 256, BK = 64, HALF = 128, HTB = HALF * BK * 2, NXCD = 8, WGM = G8_WGM;
__device__ __forceinline__ int lds_byte(int r, int c) { return r * 128 + ((((c >> 3) ^ (r >> 1)) & 7) << 4); }
__device__ __forceinline__ void stage_rc(int b, int& R, int& C) { R = b >> 7; C = ((((b >> 4) ^ (R >> 1)) & 7) << 3); }
__device__ __forceinline__ int perm32(int rho) { const int n = rho >> 4, i = rho & 15; return 8 * (i >> 2) + 4 * n + (i & 3); }

struct GUnit { const char* A; const char* B; int nt; int pm, pn, sel, e, rt, x, y; };

struct TileOrder {
    int nM, nN, nwg, G, c;
    __device__ __forceinline__ void init(int nM_, int nN_, int G_, int c_) { nM = nM_; nN = nN_; nwg = nM * nN; G = G_; c = c_; }
    __device__ __forceinline__ bool tile(int i, int& pm, int& pn) const {
        const long L = (long)i * G + c; if (L >= nwg) return false;
        int wgid = (int)L; { const int q = nwg / NXCD, r = nwg % NXCD, xcd = wgid % NXCD, off = wgid / NXCD; wgid = (xcd < r ? xcd * (q + 1) : r * (q + 1) + (xcd - r) * q) + off; }
        const int nig = WGM * nN, gid = wgid / nig, fm = gid * WGM, gsz = (nM - fm) < WGM ? (nM - fm) : WGM;
        pm = fm + ((wgid % nig) % gsz); pn = (wgid % nig) / gsz; return true;
    }
};

template <class Epi, class Sched, bool GATHER, int MODE = 0, bool LATE = false>
__device__ __forceinline__ void gemm_phase(LAS unsigned char* lds, const Sched& S, const Epi& E, const unsigned pitchA, const unsigned pitchB, const int tid, const int wid) {
    const int lane = tid & 63, wr = wid >> 2, wc = wid & 3, fr = lane & 15, fq = lane >> 4;
    unsigned voffB[2]; unsigned offC[2][2];
    LAS unsigned* rowbuf = (LAS unsigned*)(lds + ROWBUF_OFF);
#pragma unroll
    for (int i = 0; i < 2; ++i) { int R, C; stage_rc(tid * 16 + i * 8192, R, C); const int Rb = (R & ~31) + perm32(R & 31);
        voffB[i] = (unsigned)Rb * pitchB + (unsigned)C * 2u; }
    const unsigned hstepB = (unsigned)HALF * pitchB, hstepA = (unsigned)HALF * pitchA;
    const size_t kstep = (size_t)(BK * 2);
    const unsigned ldsw = (unsigned)wid * 1024u;
    const int aoff = lds_byte(wr * 64 + fr, fq * 8), boff = lds_byte(wc * 32 + fr, fq * 8);
    const int aoff1 = aoff ^ 64, boff1 = boff ^ 64;
#define G8_SA(b, h) (((b) * 2 + (h)) * HTB)
#define G8_SB(b, h) ((4 + (b) * 2 + (h)) * HTB)
#define G8_STAGE_B(bufoff, gbase, h) do { const char* _gp = (const char*)(gbase) + (h) * hstepB; asm volatile("" : "+s"(_gp)); _Pragma("unroll") for (int _i = 0; _i < 2; ++_i) \
        __builtin_amdgcn_global_load_lds((const unsigned*)(_gp + voffB[_i]), (LAS unsigned*)(lds + (bufoff) + ldsw + _i * 8192), 16, 0, 0); } while (0)
#define G8_STAGE_A(bufoff, gbase, hh) do { const char* _gp = (const char*)(gbase) + (GATHER ? 0u : (hh) * hstepA); asm volatile("" : "+s"(_gp)); const unsigned* offs = offC[GATHER ? (hh) : 0]; _Pragma("unroll") for (int _i = 0; _i < 2; ++_i) \
        __builtin_amdgcn_global_load_lds((const unsigned*)(_gp + (offs)[_i]), (LAS unsigned*)(lds + (bufoff) + ldsw + _i * 8192), 16, 0, 0); } while (0)
#define G8_LDA(dst, b, h) do { _Pragma("unroll") for (int m = 0; m < 4; ++m) _Pragma("unroll") for (int k = 0; k < 2; ++k) dst[m][k] = *(const LAS frag_t*)(lds + G8_SA(b, h) + (k ? aoff1 : aoff) + m * 2048); } while (0)
#define G8_LDB(dst, b, h) do { _Pragma("unroll") for (int n = 0; n < 2; ++n) _Pragma("unroll") for (int k = 0; k < 2; ++k) dst[n][k] = *(const LAS frag_t*)(lds + G8_SB(b, h) + (k ? boff1 : boff) + n * 2048); } while (0)
#define G8_CAT(x) __builtin_shufflevector((x)[0], (x)[1], 0, 1, 2, 3, 4, 5, 6, 7)
#define G8_MMA(ai, bj, At, Bt) do { __builtin_amdgcn_s_setprio(1); _Pragma("unroll") for (int m = 0; m < 4; ++m) _Pragma("unroll") for (int n = 0; n < 2; ++n) { \
        if constexpr (MODE == 0) { _Pragma("unroll") for (int k = 0; k < 2; ++k) acc[ai][bj][m][n] = __builtin_amdgcn_mfma_f32_16x16x32_bf16(Bt[n][k], At[m][k], acc[ai][bj][m][n], 0, 0, 0); } \
        else { const v8i_t _b8 = G8_CAT(Bt[n]), _a8 = G8_CAT(At[m]); asm volatile("v_mfma_f32_16x16x128_f8f6f4 %0, %1, %2, %0" : "+v"(acc[ai][bj][m][n]) : "v"(_b8), "v"(_a8)); } } \
        __builtin_amdgcn_s_setprio(0); } while (0)
#define G8_SWITCH() do { if constexpr (GATHER) { if (last && has_next) { int t2_ = tid; asm volatile("" : "+v"(t2_)); \
        _Pragma("unroll") for (int h = 0; h < 2; ++h) _Pragma("unroll") for (int i = 0; i < 2; ++i) { int R_, C_; stage_rc(t2_ * 16 + i * 8192, R_, C_); offC[h][i] = S.arow_lds(nxt, h * HALF + R_, rowbuf) + (unsigned)C_ * 2u; } \
        asm volatile("s_waitcnt lgkmcnt(0)" : "+v"(offC[0][0]), "+v"(offC[0][1]), "+v"(offC[1][0]), "+v"(offC[1][1]) :: "memory"); } } } while (0)
#define G8_WAIT_V(n) asm volatile("s_waitcnt vmcnt(" #n ")" ::: "memory")
#define G8_WAIT_L(n) asm volatile("s_waitcnt lgkmcnt(" #n ")" ::: "memory")
#define G8_BAR __builtin_amdgcn_s_barrier()
#define G8_SCHED __builtin_amdgcn_sched_barrier(0)
    GUnit cur, nxt; int ui = 0;
    if (!S.next(0, cur)) return;
    f32x4 acc[2][2][4][2];
#pragma unroll
    for (int a = 0; a < 2; ++a)
#pragma unroll
        for (int b = 0; b < 2; ++b)
#pragma unroll
            for (int m = 0; m < 4; ++m)
#pragma unroll
                for (int n = 0; n < 2; ++n) acc[a][b][m][n] = (f32x4){0.f, 0.f, 0.f, 0.f};
    typedef typename FragT<MODE>::type frag_t;
    frag_t At[4][2], B0[2][2], B1[2][2];
    const char* cA = cur.A; const char* cB = cur.B;
#pragma unroll
    for (int h = 0; h < 2; ++h)
#pragma unroll
        for (int i = 0; i < 2; ++i) { int R, C; stage_rc(tid * 16 + i * 8192, R, C);
            if constexpr (GATHER) offC[h][i] = S.arow(cur, h * HALF + R) + (unsigned)C * 2u;
            else offC[h][i] = (unsigned)R * pitchA + (unsigned)C * 2u;
        }
    if constexpr (GATHER) { asm volatile("s_waitcnt vmcnt(0)" : "+v"(offC[0][0]), "+v"(offC[0][1]), "+v"(offC[1][0]), "+v"(offC[1][1]) :: "memory"); }
    E.aux_dma(cur, lds + ROWBUF_OFF + 1024, 0, wid, lane);
    G8_STAGE_B(G8_SB(0, 0), cB, 0); G8_STAGE_B(G8_SB(0, 1), cB, 1); G8_STAGE_A(G8_SA(0, 0), cA, 0); G8_STAGE_A(G8_SA(0, 1), cA, 1);
    if (wr == 1) G8_BAR;
    G8_WAIT_V(2); G8_BAR;
    G8_STAGE_B(G8_SB(1, 0), cB + kstep, 0); G8_STAGE_A(G8_SA(1, 0), cA + kstep, 0); G8_STAGE_B(G8_SB(1, 1), cB + kstep, 1);
    G8_WAIT_V(6); G8_BAR;
    for (;;) {
        const bool has_next = S.next(ui + 1, nxt);
        const char* nA = has_next ? nxt.A : cA; const char* nB = has_next ? nxt.B : cB;
        if constexpr (GATHER) { if (has_next) S.rows_dma(nxt, rowbuf, wid, lane); }
        const int nt = cur.nt;
#pragma unroll 1
        for (int t = 0; t < nt; t += 2) {
            const bool last = (t == nt - 2);
            const char* a1 = cA + (size_t)(t + 1) * kstep;
            const char* a2 = last ? nA : cA + (size_t)(t + 2) * kstep; const char* b2 = last ? nB : cB + (size_t)(t + 2) * kstep;
            const char* a3 = a2 + kstep; const char* b3 = b2 + kstep;
            if constexpr (!LATE) {
            G8_LDB(B0, 0, 0); G8_LDB(B1, 0, 1); G8_SCHED; G8_LDA(At, 0, 0); G8_STAGE_A(G8_SA(1, 1), a1, 1);
            if (t != 0 || ui == 0) G8_WAIT_V(8);
            G8_WAIT_L(0); G8_BAR; G8_MMA(0, 0, At, B0); G8_MMA(0, 1, At, B1); G8_BAR; G8_SCHED;
            G8_SWITCH();
            G8_LDA(At, 0, 1); G8_STAGE_B(G8_SB(0, 0), b2, 0); G8_STAGE_B(G8_SB(0, 1), b2, 1); G8_STAGE_A(G8_SA(0, 0), a2, 0);
            G8_WAIT_V(8); G8_WAIT_L(0); G8_BAR; G8_MMA(1, 0, At, B0); G8_MMA(1, 1, At, B1); G8_BAR; G8_SCHED;
            G8_LDB(B0, 1, 0); G8_LDB(B1, 1, 1); G8_SCHED; G8_LDA(At, 1, 0); G8_STAGE_A(G8_SA(0, 1), a2, 1);
            G8_WAIT_V(8); G8_WAIT_L(0); G8_BAR; G8_MMA(0, 0, At, B0); G8_MMA(0, 1, At, B1); G8_BAR; G8_SCHED;
            G8_LDA(At, 1, 1); G8_STAGE_B(G8_SB(1, 0), b3, 0); G8_STAGE_B(G8_SB(1, 1), b3, 1); G8_STAGE_A(G8_SA(1, 0), a3, 0);
            if (last) G8_WAIT_V(6); else G8_WAIT_V(8);
            G8_WAIT_L(0); G8_BAR; G8_MMA(1, 0, At, B0); G8_MMA(1, 1, At, B1); G8_BAR; G8_SCHED;
            } else {
            G8_LDB(B0, 0, 0); G8_LDB(B1, 0, 1); G8_SCHED; G8_LDA(At, 0, 0);
            G8_WAIT_V(6); G8_WAIT_L(0); G8_BAR; G8_MMA(0, 0, At, B0); G8_SCHED; G8_STAGE_A(G8_SA(1, 1), a1, 1); G8_SCHED; G8_MMA(0, 1, At, B1); G8_BAR; G8_SCHED;
            G8_SWITCH();
            G8_LDA(At, 0, 1);
            G8_WAIT_V(2); G8_WAIT_L(0); G8_BAR; G8_MMA(1, 0, At, B0); G8_SCHED; G8_STAGE_B(G8_SB(0, 0), b2, 0); G8_STAGE_B(G8_SB(0, 1), b2, 1); G8_SCHED; G8_MMA(1, 1, At, B1); G8_SCHED; G8_STAGE_A(G8_SA(0, 0), a2, 0); G8_BAR; G8_SCHED;
            G8_LDB(B0, 1, 0); G8_LDB(B1, 1, 1); G8_SCHED; G8_LDA(At, 1, 0);
            G8_WAIT_V(6); G8_WAIT_L(0); G8_BAR; G8_MMA(0, 0, At, B0); G8_SCHED; G8_STAGE_A(G8_SA(0, 1), a2, 1); G8_SCHED; G8_MMA(0, 1, At, B1); G8_BAR; G8_SCHED;
            G8_LDA(At, 1, 1);
            G8_WAIT_V(2); G8_WAIT_L(0); G8_BAR; G8_MMA(1, 0, At, B0); G8_SCHED; G8_STAGE_B(G8_SB(1, 0), b3, 0); G8_STAGE_B(G8_SB(1, 1), b3, 1); G8_SCHED; G8_MMA(1, 1, At, B1); G8_SCHED; G8_STAGE_A(G8_SA(1, 0), a3, 0); G8_BAR; G8_SCHED;
            }
        }
        if (wr == 0) G8_BAR;
        if constexpr (MODE == 1) asm volatile("s_nop 15\n\ts_nop 15" ::: "memory");
        const bool keep = E(acc, cur, wr, wc, fr, fq, lds + ROWBUF_OFF + 1024, ui & 1);
        if (!has_next) break;
        E.aux_dma(nxt, lds + ROWBUF_OFF + 1024, (ui + 1) & 1, wid, lane);
        if (!keep) {
#pragma unroll
            for (int a = 0; a < 2; ++a)
#pragma unroll
                for (int b = 0; b < 2; ++b)
#pragma unroll
                    for (int m = 0; m < 4; ++m)
#pragma unroll
                        for (int n = 0; n < 2; ++n) acc[a][b][m][n] = (f32x4){0.f, 0.f, 0.f, 0.f};
        }
        cur = nxt; cA = nA; cB = nB; ++ui;
        if (wr == 1) G8_BAR;
    }
    G8_WAIT_V(0);
    G8_BAR;
#undef G8_SA
#undef G8_SB
#undef G8_STAGE_A
#undef G8_STAGE_B
#undef G8_LDA
#undef G8_LDB
#undef G8_MMA
#undef G8_CAT
#undef G8_WAIT_V
#undef G8_SWITCH
#undef G8_WAIT_L
#undef G8_BAR
#undef G8_SCHED
}
}

typedef GAS unsigned gu32;
#define RLX_AGENT __ATOMIC_RELAXED, __HIP_MEMORY_SCOPE_AGENT
#define XB_TMO      128
#define XB_XCNT(j)  (256  + 64 * (j))
#define XB_XSUB(j)  (1280 + 64 * (j))
#define XB_XGEN(j)  (2304 + 64 * (j))
#define XB_TOP      3328
#define XB_TOPGEN   3392
#define XCD_BAR_WORDS 3456
#define XB_SPIN_CAP (1u << 22)
__device__ __forceinline__ unsigned xb_ld(unsigned* p)              { return __hip_atomic_load(p, __ATOMIC_RELAXED, __HIP_MEMORY_SCOPE_AGENT); }
__device__ __forceinline__ unsigned xb_add(unsigned* p, unsigned v) { return __hip_atomic_fetch_add(p, v, __ATOMIC_RELAXED, __HIP_MEMORY_SCOPE_AGENT); }
__device__ __forceinline__ unsigned xb_xcc_id() { return (unsigned)__builtin_amdgcn_s_getreg((3 << 11) | 20) & 0xFu; }
#define XB_SPIN(cond, bar) do { unsigned _sp = 0; while (cond) { __builtin_amdgcn_s_sleep(1); \
    if ((++_sp & 255u) == 0u) { if (xb_ld(&(bar)[XB_TMO])) break; if (_sp > XB_SPIN_CAP) { atomicAdd(&(bar)[XB_TMO], 1u); break; } } } } while (0)
struct XcdBarrier { unsigned* bar; unsigned x; volatile LAS unsigned* st; };
__device__ __forceinline__ XcdBarrier xcd_barrier_post(unsigned* bar, volatile LAS unsigned* st, const bool t0) {
    XcdBarrier b; b.bar = bar; b.x = xb_xcc_id(); b.st = st;
    if (t0) (void)xb_add(&bar[XB_XCNT(b.x)], 1u);
    return b;
}
__device__ __forceinline__ void xcd_barrier_complete(unsigned* bar, unsigned x, unsigned& nloc, unsigned& nx) {
    const unsigned G = gridDim.x * gridDim.y * gridDim.z;
    unsigned sum, cnt, mine, sp = 0u;
    for (;;) {
        sum = 0u; cnt = 0u; mine = 0u;
#pragma unroll
        for (unsigned j = 0; j < 16; ++j) { const unsigned c = xb_ld(&bar[XB_XCNT(j)]); sum += c; cnt += (c > 0u) ? 1u : 0u; mine = (j == x) ? c : mine; }
        if (sum == G) break;
        __builtin_amdgcn_s_sleep(1);
        if ((++sp & 255u) == 0u) { if (xb_ld(&bar[XB_TMO])) break; if (sp > XB_SPIN_CAP) { atomicAdd(&bar[XB_TMO], 1u); break; } }
    }
    nloc = mine > 0u ? mine : 1u; nx = cnt > 0u ? cnt : 1u;
}
__device__ __forceinline__ void xcd_barrier(const XcdBarrier& b, const bool t0) {
    asm volatile("s_waitcnt vmcnt(0)" ::: "memory");
    __syncthreads();
    if (t0) {
        unsigned* bar = b.bar;
        __builtin_amdgcn_s_waitcnt(0);
        unsigned nloc = b.st[0], nx = b.st[1];
        if (nloc == 0u) { xcd_barrier_complete(bar, b.x, nloc, nx); b.st[0] = nloc; b.st[1] = nx; }
        const unsigned old = xb_add(&bar[XB_XSUB(b.x)], 1u);
        const unsigned gen = old / nloc;
        if (old + 1u == (gen + 1u) * nloc) {
            __builtin_amdgcn_fence(__ATOMIC_RELEASE, "agent");
            asm volatile("s_waitcnt vmcnt(0)" ::: "memory");
            const unsigned og = xb_add(&bar[XB_TOP], 1u);
            const unsigned target = (og / nx + 1u) * nx;
            if (og + 1u != target) XB_SPIN(xb_ld(&bar[XB_TOP]) < target, bar);
            (void)xb_add(&bar[XB_XGEN(b.x)], 1u);
            __builtin_amdgcn_fence(__ATOMIC_ACQUIRE, "agent");
            asm volatile("s_waitcnt vmcnt(0)" ::: "memory");
        } else {
            XB_SPIN(xb_ld(&bar[XB_XGEN(b.x)]) == gen, bar);
            __builtin_amdgcn_fence(__ATOMIC_ACQUIRE, "agent");
            asm volatile("s_waitcnt vmcnt(0)" ::: "memory");
        }
    }
    __syncthreads();
}

struct Args { const float* in[17]; float* out; unsigned char* ws; int ph_lo, ph_hi; };
typedef const __attribute__((address_space(4))) Args* KArgP;
struct Frame {
    LAS unsigned char* lds;
    int tid, lane, wave, vcu, G;
    KArgP ap;
    float* out; unsigned char* ws;
};
#define INP(k) ((const GAS float*)F.ap->in[k])
enum { I_X = 0, I_N1G, I_WIN, I_GATEB, I_MNG, I_AQG, I_AKG, I_WMB, I_WAB, I_WOUT, I_N2G, I_WR, I_BR, I_W1, I_B1, I_W2, I_B2 };
#define WSP(T, off) ((T*)(F.ws + (off)))

__device__ __forceinline__ float wave_sum(float v) {
#pragma unroll
    for (int o = 1; o < 64; o <<= 1) v += __shfl_xor(v, o);
    return v;
}

struct TItem { const GAS float* src; const GAS float* scale; unsigned char* dst; int srcpitch, dstpitchB, r0, r1, fmt, half; };
__device__ __forceinline__ TItem titem_decode(Frame& F, int it) {
    constexpr int NI_IN = 92 * 16, NI_WM = 16 * 8, NI_WA = 16 * 4, NI_WO = 16 * 16, NI_WR = 16, NI_W1 = 32 * 32 * 16;
    TItem t; t.scale = nullptr; t.fmt = 0; t.half = 0;
    int r = it;
    if (r < NI_IN) { const int q = r % 92, kb = r / 92, pn = q >> 2, wc = q & 3; const int colbase = pn < 6 ? 256 * pn : 1544 + 256 * (pn - 6);
        t.src = INP(I_WIN) + (size_t)(64 * kb) * 5896 + colbase + 64 * wc; t.srcpitch = 5896; t.r0 = 256 * pn + 32 * wc; t.r1 = t.r0 + 128; t.scale = INP(I_N1G) + 64 * kb;
        if (pn >= FP8_FROM) { t.dst = F.ws + WS_WIN8 + 64 * kb; t.dstpitchB = 1024; t.fmt = 1; } else { t.dst = F.ws + WS_WIN + 128 * kb; t.dstpitchB = 2048; }
        return t; } r -= NI_IN;
    if (r < NI_WM) { const int kb = r % 8, q = r / 8, pn = q >> 2, wc = q & 3;
        t.src = INP(I_WMB) + (size_t)(64 * kb) * 1024 + 256 * pn + 64 * wc; t.srcpitch = 1024; t.dst = F.ws + WS_WM + 64 * kb; t.dstpitchB = 512; t.fmt = 1; t.r0 = 256 * pn + 32 * wc; t.r1 = t.r0 + 128; return t; } r -= NI_WM;
    if (r < NI_WA) { const int kb = r % 4, q = r / 4, pn = q >> 2, wc = q & 3;
        t.src = INP(I_WAB) + (size_t)(64 * kb) * 1024 + 256 * pn + 64 * wc; t.srcpitch = 1024; t.dst = F.ws + WS_WA + 64 * kb; t.dstpitchB = 512; t.fmt = 1; t.r0 = 256 * pn + 32 * wc; t.r1 = t.r0 + 128; return t; } r -= NI_WA;
    if (r < NI_WO) { const int kb = r % 16, q = r / 16, pn = q >> 2, wc = q & 3;
        t.src = INP(I_WOUT) + (size_t)(64 * kb) * 1024 + 256 * pn + 64 * wc; t.srcpitch = 1024; t.dst = F.ws + WS_WO + 64 * kb; t.dstpitchB = 1024; t.fmt = 1; t.r0 = 256 * pn + 32 * wc; t.r1 = t.r0 + 128; return t; } r -= NI_WO;
    if (r < NI_WR) { const int kb = r;
        t.src = INP(I_WR) + (size_t)(64 * kb) * 32; t.srcpitch = 32; t.dst = F.ws + WS_WR + 128 * kb; t.dstpitchB = 2048; t.r0 = 0; t.r1 = 0; t.scale = INP(I_N2G) + 64 * kb; t.half = 1; return t; } r -= NI_WR;
    if (r < NI_W1) { const int cb = r % 32; int q = r / 32; const int kb = q % 16, e = q / 16;
        const int q2 = cb & 15, rr = 256 * (q2 >> 1) + 64 * (q2 & 1) + (cb >= 16 ? 128 : 0);
        t.src = INP(I_W1) + (size_t)e * 1024 * 2048 + (size_t)(64 * kb) * 2048 + 64 * cb; t.srcpitch = 2048; t.dst = F.ws + WS_W1 + (size_t)e * 2048 * 1024 + 64 * kb; t.dstpitchB = 1024; t.r0 = rr; t.r1 = rr + 32;
        t.scale = INP(I_N2G) + 64 * kb; t.fmt = 1; return t; } r -= NI_W1;
    { const int cb = r % 16; int q = r / 16; const int kb = q % 16, e = q / 16, pn = cb >> 2, wc = cb & 3;
        t.src = INP(I_W2) + (size_t)e * 1024 * 1024 + (size_t)(64 * kb) * 1024 + 256 * pn + 64 * wc; t.srcpitch = 1024; t.dst = F.ws + WS_W2 + (size_t)e * 1024 * 1024 + 64 * kb; t.dstpitchB = 1024; t.r0 = 256 * pn + 32 * wc; t.r1 = t.r0 + 128; t.fmt = 1; return t; }
}
__device__ __forceinline__ void titem_load(const TItem& t, int lane, f32x4 (&v)[16], float (&sc)[16]) {
    const int cq = lane & 15, kq = lane >> 4;
#pragma unroll
    for (int i = 0; i < 16; ++i) { v[i] = (f32x4){0.f, 0.f, 0.f, 0.f}; if (!t.half || cq < 8) v[i] = __builtin_nontemporal_load((const GAS f32x4*)(t.src + (size_t)(4 * i + kq) * t.srcpitch + 4 * cq)); }
#pragma unroll
    for (int i = 0; i < 16; ++i) sc[i] = (t.scale ? t.scale[4 * i + kq] : 1.0f) * (t.fmt == 1 ? 32.0f : 1.0f);
}
__device__ __forceinline__ void titem_store(const TItem& t, int lane, const f32x4 (&v)[16], const float (&sc)[16], LAS float* scr) {
    const int cq = lane & 15, kq = lane >> 4;
#pragma unroll
    for (int i = 0; i < 16; ++i) { LAS float* s = scr + (4 * i + kq) * 65 + 4 * cq; s[0] = v[i][0] * sc[i]; s[1] = v[i][1] * sc[i]; s[2] = v[i][2] * sc[i]; s[3] = v[i][3] * sc[i]; }
    LDS_WAIT(); asm volatile("" ::: "memory");
    if (t.fmt == 0) {
        const int ch = lane & 7;
#pragma unroll
        for (int q = 0; q < 8; ++q) { const int n = (lane >> 3) + 8 * q; const LAS float* s = scr + (8 * ch) * 65 + n;
            u32x4 o; o.x = pk2(s[0 * 65], s[1 * 65]); o.y = pk2(s[2 * 65], s[3 * 65]); o.z = pk2(s[4 * 65], s[5 * 65]); o.w = pk2(s[6 * 65], s[7 * 65]);
            if (!t.half || n < 32) *(GAS u32x4*)(t.dst + (size_t)(n < 32 ? t.r0 + n : t.r1 + n - 32) * t.dstpitchB + ch * 16) = o; }
    } else {
        const int ch = lane & 3;
#pragma unroll
        for (int q = 0; q < 4; ++q) { const int n = (lane >> 2) + 16 * q; const LAS float* s = scr + (16 * ch) * 65 + n;
            f32x4 a0 = (f32x4){s[0 * 65], s[1 * 65], s[2 * 65], s[3 * 65]}, a1 = (f32x4){s[4 * 65], s[5 * 65], s[6 * 65], s[7 * 65]};
            f32x4 a2 = (f32x4){s[8 * 65], s[9 * 65], s[10 * 65], s[11 * 65]}, a3 = (f32x4){s[12 * 65], s[13 * 65], s[14 * 65], s[15 * 65]};
            const u32x2 lo = pack8_fp8(a0, a1), hi = pack8_fp8(a2, a3);
            *(GAS u32x4*)(t.dst + (size_t)(n < 32 ? t.r0 + n : t.r1 + n - 32) * t.dstpitchB + ch * 16) = (u32x4){lo.x, lo.y, hi.x, hi.y}; }
    }
    LDS_WAIT(); asm volatile("" ::: "memory");
}

__device__ __forceinline__ void p0_prologue(Frame& F) {
    LAS float* scr = (LAS float*)(F.lds + F.wave * 16640);
    const int gw = F.vcu * 8 + F.wave, NGW = F.G * 8;
    constexpr int NITEMS = 92 * 16 + 16 * 8 + 16 * 4 + 16 * 16 + 16 + 32 * 32 * 16 + 32 * 16 * 16 - W2_TAIL;
    {
        int it = gw;
        if (it < NITEMS) {
            f32x4 vc[16], vn[16]; float sc_c[16], sc_n[16];
            TItem cur = titem_decode(F, it); titem_load(cur, F.lane, vc, sc_c);
            for (;;) {
                const int itn = it + NGW; const bool has_next = itn < NITEMS;
                TItem nxt = cur;
                if (has_next) { nxt = titem_decode(F, itn); titem_load(nxt, F.lane, vn, sc_n); }
                titem_store(cur, F.lane, vc, sc_c, scr);
                if (!has_next) break;
                cur = nxt; it = itn;
#pragma unroll
                for (int i = 0; i < 16; ++i) { vc[i] = vn[i]; sc_c[i] = sc_n[i]; }
            }
        }
    }
    __syncthreads();
    LAS float* WG = (LAS float*)(F.lds);
    for (int u = F.tid; u < 1024 * 8; u += 512) WG[(u & 7) * 1024 + (u >> 3)] = INP(I_WIN)[(size_t)(u >> 3) * 5896 + 1536 + (u & 7)];
    __syncthreads();
    f32x4 g1v[4];
#pragma unroll
    for (int j = 0; j < 4; ++j) g1v[j] = *(const GAS f32x4*)(INP(I_N1G) + 4 * F.lane + 256 * j);
    const float gb = INP(I_GATEB)[F.lane & 7];
    if (gw < NTOK) {
        f32x4 vn[4];
        { const GAS f32x4* xr = (const GAS f32x4*)(INP(I_X) + (size_t)gw * DM) + F.lane;
#pragma unroll
          for (int j = 0; j < 4; ++j) vn[j] = __builtin_nontemporal_load(xr + 64 * j); }
        for (int m = gw; m < NTOK; m += NGW) {
            f32x4 v[4]; float s2 = 0.f;
#pragma unroll
            for (int j = 0; j < 4; ++j) { v[j] = vn[j]; s2 += (v[j].x * v[j].x + v[j].y * v[j].y) + (v[j].z * v[j].z + v[j].w * v[j].w); }
            if (m + NGW < NTOK) { const GAS f32x4* xr = (const GAS f32x4*)(INP(I_X) + (size_t)(m + NGW) * DM) + F.lane;
#pragma unroll
                for (int j = 0; j < 4; ++j) vn[j] = __builtin_nontemporal_load(xr + 64 * j); }
            const float rstd = __builtin_amdgcn_rsqf(wave_sum(s2) * (1.f / DM) + EPS);
            GAS unsigned long long* o8 = (GAS unsigned long long*)(WSP(bf16_t, WS_XN) + (size_t)m * DM) + F.lane;
            float ga[8];
#pragma unroll
            for (int c = 0; c < 8; ++c) ga[c] = 0.f;
            if (F.lane == 0) WSP(float, WS_RSTD1)[m] = rstd;
#pragma unroll
            for (int j = 0; j < 4; ++j) {
                o8[64 * j] = (unsigned long long)pk2(v[j].x, v[j].y) | ((unsigned long long)pk2(v[j].z, v[j].w) << 32);
                { int w8 = 0; w8 = __builtin_amdgcn_cvt_pk_fp8_f32(v[j].x, v[j].y, w8, false); w8 = __builtin_amdgcn_cvt_pk_fp8_f32(v[j].z, v[j].w, w8, true);
                  ((GAS unsigned*)(F.ws + WS_XN8 + (size_t)m * DM))[F.lane + 64 * j] = (unsigned)w8; }
                v[j] = v[j] * rstd * g1v[j];
#pragma unroll
                for (int c = 0; c < 8; ++c) { const f32x4 w = *(const LAS f32x4*)(WG + c * 1024 + 4 * F.lane + 256 * j); ga[c] += (v[j].x * w.x + v[j].y * w.y) + (v[j].z * w.z + v[j].w * w.w); }
            }
#pragma unroll
            for (int c = 0; c < 4; ++c) { const float mine = (F.lane & 4) ? ga[c + 4] : ga[c], oth = (F.lane & 4) ? ga[c] : ga[c + 4]; ga[c] = mine + __shfl_xor(oth, 4); }
#pragma unroll
            for (int c = 0; c < 2; ++c) { const float mine = (F.lane & 2) ? ga[c + 2] : ga[c], oth = (F.lane & 2) ? ga[c] : ga[c + 2]; ga[c] = mine + __shfl_xor(oth, 2); }
            { const float mine = (F.lane & 1) ? ga[1] : ga[0], oth = (F.lane & 1) ? ga[0] : ga[1]; ga[0] = mine + __shfl_xor(oth, 1); }
            float t = ga[0];
            t += __shfl_xor(t, 8); t += __shfl_xor(t, 16); t += __shfl_xor(t, 32);
            if (F.lane < 8) { const float z = t + gb; WSP(float, WS_GATES)[(size_t)m * 8 + F.lane] = 15.0f * tanhf(z * (1.0f / 15.0f)); }
        }
    }
}

__device__ __forceinline__ void convert_tail(Frame& F, int first, int count, int idx, int nblk) {
    LAS float* scr = (LAS float*)(F.lds + F.wave * 16640);
    f32x4 v[16]; float sc[16];
    for (int it = idx * 8 + F.wave; it < count; it += nblk * 8) { const TItem t = titem_decode(F, first + it); titem_load(t, F.lane, v, sc); titem_store(t, F.lane, v, sc, scr); }
}

struct SchedInProj { g8::TileOrder T; const char* A; const char* B;
    __device__ __forceinline__ bool next(int i, g8::GUnit& u) const { int pm, pn; if (!T.tile(i, pm, pn)) return false; u.pm = pm; u.pn = pn; u.nt = 16; u.sel = 0; u.e = 0; u.rt = 0; u.x = 0; u.y = 0;
        u.A = A + (size_t)pm * 256 * 2048; u.B = B + (size_t)pn * 256 * 2048; return true; }
    __device__ __forceinline__ unsigned arow(const g8::GUnit&, int) const { return 0u; }
};
struct SchedInProj8 { g8::TileOrder T; const char* A; const char* B;
    __device__ __forceinline__ bool next(int i, g8::GUnit& u) const { int pm, pl; if (!T.tile(i, pm, pl)) return false; const int pn = FP8_FROM + pl; u.pm = pm; u.pn = pn; u.nt = 8; u.sel = 0; u.e = 0; u.rt = 0; u.x = 256 * pm; u.y = 256;
        u.A = A; u.B = B + (size_t)pn * 256 * 1024; return true; }
    __device__ __forceinline__ unsigned arow(const g8::GUnit& u, int r) const { return (unsigned)(u.x + r) * 1024u; }
    __device__ __forceinline__ void rows_dma(const g8::GUnit&, LAS unsigned*, int, int) const {}
    __device__ __forceinline__ unsigned arow_lds(const g8::GUnit& u, int r, const LAS unsigned*) const { return (unsigned)(u.x + r) * 1024u; }
};
struct EpiInProj {
    unsigned char* ws; const GAS float* gq; const GAS float* gk; float ascale;
    __device__ __forceinline__ void aux_dma(const g8::GUnit& u, LAS unsigned char* aux, int par, int wid, int lane) const {
        if (wid == 4) __builtin_amdgcn_global_load_lds((const unsigned*)((const float*)(ws + WS_RSTD1) + 256 * u.pm + 4 * lane), (LAS unsigned*)(aux + par * 2048), 16, 0, 0); }
    __device__ __forceinline__ bool operator()(f32x4 (&acc)[2][2][4][2], const g8::GUnit& u, int wr, int wc, int fr, int fq, LAS unsigned char* aux, int par) const {
        const int pn = u.pn;
        size_t base; int pitch, col0, kind = 0, grp = 0; float sc = 1.f;
        if (pn == 0)      { base = WS_MQ; pitch = 256; col0 = 0; }
        else if (pn == 1) { base = WS_MK; pitch = 256; col0 = 0; sc = 0.125f; }
        else if (pn < 4)  { base = WS_MV; pitch = 512; col0 = 256 * (pn - 2); }
        else if (pn < 6)  { base = WS_MO; pitch = 512; col0 = 256 * (pn - 4); kind = 1; }
        else if (pn < 9)  { base = WS_AQ; pitch = 768; col0 = 256 * (pn - 6); kind = 2; grp = pn - 6; sc = 0.125f * LOG2E; }
        else if (pn < 12) { base = WS_AK; pitch = 768; col0 = 256 * (pn - 9); kind = 3; grp = pn - 9; }
        else if (pn < 15) { base = WS_AV; pitch = 768; col0 = 256 * (pn - 12); }
        else if (pn < 19) { base = WS_GM; pitch = 1024; col0 = 256 * (pn - 15); kind = 1; }
        else              { base = WS_GA; pitch = 1024; col0 = 256 * (pn - 19); kind = 1; }
        const float glo = pn >= 19 ? (1.0f / 255.0f) : 0.f;
        bf16_t* dst = (bf16_t*)(ws + base);
        const int L0 = 64 * wc + 8 * fq;
        const int row0 = u.pm * 256 + wr * 64 + fr;
        f32x4 gn[2][2];
        if (kind >= 2) { const int go = grp * 64 + 8 * fq;
#pragma unroll
            for (int bj = 0; bj < 2; ++bj)
#pragma unroll
                for (int n = 0; n < 2; ++n) { const f32x4 a = *(const GAS f32x4*)(gq + go + 32 * bj + 4 * n), b = *(const GAS f32x4*)(gk + go + 32 * bj + 4 * n); gn[bj][n] = (kind == 2) ? a : b; } }
#pragma unroll
        for (int ai = 0; ai < 2; ++ai)
#pragma unroll
            for (int m = 0; m < 4; ++m) {
                const int row = row0 + 128 * ai + 16 * m;
                const float rs = ((const LAS float*)(aux + par * 2048))[128 * ai + 64 * wr + 16 * m + fr] * ascale;
                f32x4 v[2][2];
#pragma unroll
                for (int bj = 0; bj < 2; ++bj)
#pragma unroll
                    for (int n = 0; n < 2; ++n) v[bj][n] = acc[ai][bj][m][n] * (kind == 1 ? rs * -LOG2E_ : rs);
                if (kind == 1) {
#pragma unroll
                    for (int bj = 0; bj < 2; ++bj)
#pragma unroll
                        for (int n = 0; n < 2; ++n)
#pragma unroll
                            for (int e = 0; e < 4; ++e) v[bj][n][e] = __builtin_amdgcn_rcpf(1.0f + __builtin_amdgcn_exp2f(v[bj][n][e]));
                } else if (kind >= 2) {
                    float ss = 0.f;
#pragma unroll
                    for (int bj = 0; bj < 2; ++bj)
#pragma unroll
                        for (int n = 0; n < 2; ++n) ss += (v[bj][n][0] * v[bj][n][0] + v[bj][n][1] * v[bj][n][1]) + (v[bj][n][2] * v[bj][n][2] + v[bj][n][3] * v[bj][n][3]);
                    ss += __shfl_xor(ss, 16); ss += __shfl_xor(ss, 32);
                    const float r = sc * __builtin_amdgcn_rsqf(ss * (1.0f / 64.0f) + EPS);
#pragma unroll
                    for (int bj = 0; bj < 2; ++bj)
#pragma unroll
                        for (int n = 0; n < 2; ++n) v[bj][n] = v[bj][n] * gn[bj][n] * r;
                } else {
#pragma unroll
                    for (int bj = 0; bj < 2; ++bj)
#pragma unroll
                        for (int n = 0; n < 2; ++n) v[bj][n] = v[bj][n] * sc;
                }
                if (kind == 1) {
                    const bool odd = fq & 1; const float lo = glo;
                    const u32x2 q0 = pack8_q8(v[0][0], v[0][1], lo), q1 = pack8_q8(v[1][0], v[1][1], lo);
                    const u32x2 snd = odd ? q0 : q1;
                    u32x2 rcv; rcv.x = (unsigned)__shfl_xor((int)snd.x, 16); rcv.y = (unsigned)__shfl_xor((int)snd.y, 16);
                    const u32x4 w16 = odd ? (u32x4){rcv.x, rcv.y, q1.x, q1.y} : (u32x4){q0.x, q0.y, rcv.x, rcv.y};
                    st16((unsigned char*)dst + (size_t)row * pitch + col0 + 64 * wc + (odd ? 32 + 8 * (fq - 1) : 8 * fq), w16);
                } else {
#pragma unroll
                for (int bj = 0; bj < 2; ++bj) st16(dst + (size_t)row * pitch + col0 + L0 + 32 * bj, pack8(v[bj][0], v[bj][1]));
                }
            }
        return false;
    }
};

struct SchedBranch { g8::TileOrder T; const char *A0, *B0, *A1, *B1;
    __device__ __forceinline__ bool next(int i, g8::GUnit& u) const { int pm, pn; if (!T.tile(i >> 1, pm, pn)) return false; u.pm = pm; u.pn = pn; u.sel = i & 1; u.e = 0; u.rt = 0; u.x = 0; u.y = 0;
        if (u.sel == 0) { u.nt = 8; u.A = A0 + (size_t)pm * 256 * 1024; u.B = B0 + (size_t)pn * 256 * 1024; }
        else            { u.nt = 4; u.A = A1 + (size_t)pm * 256 * 1024; u.B = B1 + (size_t)pn * 256 * 1024; }
        return true; }
    __device__ __forceinline__ unsigned arow(const g8::GUnit&, int) const { return 0u; }
};
struct SchedBranch8 { g8::TileOrder T; const char *A0, *B0, *A1, *B1;
    __device__ __forceinline__ bool next(int i, g8::GUnit& u) const { int pm, pn; if (!T.tile(i >> 1, pm, pn)) return false; u.pm = pm; u.pn = pn; u.sel = i & 1; u.e = 0; u.rt = 0; u.x = 256 * pm; u.y = 256;
        if (u.sel == 0) { u.nt = 4; u.A = A0; u.B = B0 + (size_t)pn * 256 * 512; }
        else            { u.nt = 2; u.A = A1; u.B = B1 + (size_t)pn * 256 * 512; }
        return true; }
    __device__ __forceinline__ unsigned arow(const g8::GUnit& u, int r) const { return (unsigned)(u.x + r) * 512u; }
    __device__ __forceinline__ void rows_dma(const g8::GUnit&, LAS unsigned*, int, int) const {}
    __device__ __forceinline__ unsigned arow_lds(const g8::GUnit& u, int r, const LAS unsigned*) const { return (unsigned)(u.x + r) * 512u; }
};
struct EpiBranch {
    const unsigned char *GM, *GA; unsigned char* Y;
    __device__ __forceinline__ void aux_dma(const g8::GUnit&, LAS unsigned char*, int, int, int) const {}
    __device__ __forceinline__ bool operator()(f32x4 (&acc)[2][2][4][2], const g8::GUnit& u, int wr, int wc, int fr, int fq, LAS unsigned char* aux, int par) const {
        const int row0 = u.pm * 256 + wr * 64 + fr, c0 = 256 * u.pn + 64 * wc + 8 * fq;
        u32x2 gan[2], gmn[2], gac[2], gmc[2];
#pragma unroll
        for (int bj = 0; bj < 2; ++bj) { const size_t ro = (size_t)row0 * 1024 + c0 + 32 * bj; gan[bj] = *(const u32x2*)(GA + ro); gmn[bj] = gan[bj]; if (u.sel == 0) gmn[bj] = *(const u32x2*)(GM + ro); }
#pragma unroll
        for (int ai = 0; ai < 2; ++ai)
#pragma unroll
            for (int m = 0; m < 4; ++m) {
#pragma unroll
                for (int bj = 0; bj < 2; ++bj) { gac[bj] = gan[bj]; gmc[bj] = gmn[bj]; }
                if (ai * 4 + m < 7) { const int it = ai * 4 + m + 1; const size_t rn = (size_t)(row0 + 128 * (it >> 2) + 16 * (it & 3)) * 1024 + c0;
#pragma unroll
                    for (int bj = 0; bj < 2; ++bj) { gan[bj] = *(const u32x2*)(GA + rn + 32 * bj); gmn[bj] = gan[bj]; if (u.sel == 0) gmn[bj] = *(const u32x2*)(GM + rn + 32 * bj); } }
                u32x2 f8[2];
#pragma unroll
                for (int bj = 0; bj < 2; ++bj) {
                    f32x4 a0, a1; unpack8_q8(gac[bj], a0, a1);
                    if (u.sel == 0) { f32x4 m0, m1; unpack8_q8(gmc[bj], m0, m1);
#pragma unroll
                        for (int e = 0; e < 4; ++e) { acc[ai][bj][m][0][e] *= m0[e] * __builtin_amdgcn_rcpf(a0[e]); acc[ai][bj][m][1][e] *= m1[e] * __builtin_amdgcn_rcpf(a1[e]); }
                    } else { f8[bj] = pack8_fp8(acc[ai][bj][m][0] * (a0 * (0.03125f / 255.0f)), acc[ai][bj][m][1] * (a1 * (0.03125f / 255.0f))); }
                }
                if (u.sel != 0) {
                    const bool odd = fq & 1;
                    const u32x2 snd = odd ? f8[0] : f8[1];
                    u32x2 rcv; rcv.x = (unsigned)__shfl_xor((int)snd.x, 16); rcv.y = (unsigned)__shfl_xor((int)snd.y, 16);
                    const u32x4 w16 = odd ? (u32x4){rcv.x, rcv.y, f8[1].x, f8[1].y} : (u32x4){f8[0].x, f8[0].y, rcv.x, rcv.y};
                    st16(Y + (size_t)(row0 + 128 * ai + 16 * m) * 1024 + 256 * u.pn + 64 * wc + (odd ? 32 + 8 * (fq - 1) : 8 * fq), w16);
                }
            }
        return u.sel == 0;
    }
};

struct SchedWout { g8::TileOrder T; const char* A; const char* B;
    __device__ __forceinline__ bool next(int i, g8::GUnit& u) const { int pm, pn; if (!T.tile(i, pm, pn)) return false; u.pm = pm; u.pn = pn; u.nt = 16; u.sel = 0; u.e = 0; u.rt = 0; u.x = 0; u.y = 0;
        u.A = A + (size_t)pm * 256 * 2048; u.B = B + (size_t)pn * 256 * 2048; return true; }
    __device__ __forceinline__ unsigned arow(const g8::GUnit&, int) const { return 0u; }
};
struct SchedWout8 { g8::TileOrder T; const char* A; const char* B;
    __device__ __forceinline__ bool next(int i, g8::GUnit& u) const { int pm, pn; if (!T.tile(i, pm, pn)) return false; u.pm = pm; u.pn = pn; u.nt = 8; u.sel = 0; u.e = 0; u.rt = 0; u.x = 256 * pm; u.y = 256;
        u.A = A; u.B = B + (size_t)pn * 256 * 1024; return true; }
    __device__ __forceinline__ unsigned arow(const g8::GUnit& u, int r) const { return (unsigned)(u.x + r) * 1024u; }
    __device__ __forceinline__ void rows_dma(const g8::GUnit&, LAS unsigned*, int, int) const {}
    __device__ __forceinline__ unsigned arow_lds(const g8::GUnit& u, int r, const LAS unsigned*) const { return (unsigned)(u.x + r) * 1024u; }
};
struct EpiWout {
    const bf16_t* x; bf16_t* X1B; unsigned char* X1F8; float* SSQ; float ascale;
    __device__ __forceinline__ void aux_dma(const g8::GUnit&, LAS unsigned char*, int, int, int) const {}
    __device__ __forceinline__ bool operator()(f32x4 (&acc)[2][2][4][2], const g8::GUnit& u, int wr, int wc, int fr, int fq, LAS unsigned char* aux, int par) const {
        const int row0 = u.pm * 256 + wr * 64 + fr, c0 = 256 * u.pn + 64 * wc + 8 * fq;
        const bool odd = fq & 1;
        u32x4 xn[2], xc[2];
#pragma unroll
        for (int bj = 0; bj < 2; ++bj) { const size_t ro = (size_t)row0 * 1024 + c0; xn[bj] = *(const u32x4*)(x + ro + 32 * bj); }
#pragma unroll
        for (int ai = 0; ai < 2; ++ai)
#pragma unroll
            for (int m = 0; m < 4; ++m) {
                const int row = row0 + 128 * ai + 16 * m; const size_t ro = (size_t)row * 1024 + c0; float ss = 0.f;
#pragma unroll
                for (int bj = 0; bj < 2; ++bj) xc[bj] = xn[bj];
                if (ai * 4 + m < 7) { const int it = ai * 4 + m + 1; const size_t rn = (size_t)(row0 + 128 * (it >> 2) + 16 * (it & 3)) * 1024 + c0;
#pragma unroll
                    for (int bj = 0; bj < 2; ++bj) xn[bj] = *(const u32x4*)(x + rn + 32 * bj); }
                u32x2 f8[2];
#pragma unroll
                for (int bj = 0; bj < 2; ++bj) {
                    f32x4 x0, x1; unpack8(xc[bj], x0, x1);
                    const f32x4 v0 = acc[ai][bj][m][0] * ascale + x0, v1 = acc[ai][bj][m][1] * ascale + x1;
                    st16(X1B + ro + 32 * bj, pack8(v0, v1)); f8[bj] = pack8_fp8(v0, v1);
                    ss += (v0[0] * v0[0] + v0[1] * v0[1]) + (v0[2] * v0[2] + v0[3] * v0[3]) + (v1[0] * v1[0] + v1[1] * v1[1]) + (v1[2] * v1[2] + v1[3] * v1[3]);
                }
                const u32x2 snd = odd ? f8[0] : f8[1];
                u32x2 rcv; rcv.x = (unsigned)__shfl_xor((int)snd.x, 16); rcv.y = (unsigned)__shfl_xor((int)snd.y, 16);
                const u32x4 w16 = odd ? (u32x4){rcv.x, rcv.y, f8[1].x, f8[1].y} : (u32x4){f8[0].x, f8[0].y, rcv.x, rcv.y};
                st16(X1F8 + (size_t)row * 1024 + 256 * u.pn + 64 * wc + (odd ? 32 + 8 * (fq - 1) : 8 * fq), w16);
                ss += __shfl_xor(ss, 16); ss += __shfl_xor(ss, 32);
                if (fq == 0) SSQ[(size_t)row * 16 + u.pn * 4 + wc] = ss;
            }
        return false;
    }
};

__device__ __forceinline__ void moe_tables(Frame& F) {
    LAS int* tab = (LAS int*)(F.lds + TAB_OFF);
    if (F.wave == 0) { const unsigned* cnt = WSP(unsigned, WS_CTL) + CW_CNT;
        const int c = F.lane < NEXP ? (int)__hip_atomic_load(cnt + (F.lane & 31), RLX_AGENT) : 0;
        const int t = (c + 255) >> 8; int ts = t, of = c;
#pragma unroll
        for (int o = 1; o < 32; o <<= 1) { const int a = __shfl_up(ts, o), b2 = __shfl_up(of, o); if (F.lane >= o) { ts += a; of += b2; } }
        if (F.lane < NEXP) { tab[F.lane] = ts - t; tab[40 + F.lane] = of - c; tab[80 + F.lane] = c; }
        if (F.lane == NEXP - 1) { tab[32] = ts; tab[72] = of; } }
    __syncthreads();
}
template <int NPN, bool G1>
struct SchedMoe { g8::TileOrder T; const LAS int* tab; const char* A; const char* B; const int* LIST;
    __device__ __forceinline__ bool next(int i, g8::GUnit& u) const { int pm, pn; if (!T.tile(i, pm, pn)) return false;
        int e = 0;
        for (int k = 1; k < NEXP; ++k) e = (tab[k] <= pm) ? k : e;
        e = __builtin_amdgcn_readfirstlane(e);
        const int ts = __builtin_amdgcn_readfirstlane(tab[e]), of = __builtin_amdgcn_readfirstlane(tab[40 + e]), cn = __builtin_amdgcn_readfirstlane(tab[80 + e]);
        const int rt = pm - ts; u.pm = pm; u.pn = pn; u.sel = 0; u.e = e; u.rt = rt; u.nt = 8; u.x = of + 256 * rt; u.y = cn - 256 * rt;
        if (G1) { u.A = A; u.B = B + ((size_t)e * 2048 + 256 * pn) * 1024; }
        else { u.A = A; u.B = B + ((size_t)e * 1024 + 256 * pn) * 1024; }
        return true; }
    __device__ __forceinline__ unsigned arow(const g8::GUnit& u, int r) const {
        if (G1) { const int rr = r < u.y ? r : u.y - 1; const int tok = LIST[(size_t)u.e * NTOK + 256 * u.rt + rr]; return (unsigned)tok * 1024u; }
        else return (unsigned)(u.x + r) * 1024u; }
    __device__ __forceinline__ void rows_dma(const g8::GUnit& u, LAS unsigned* buf, int wid, int lane) const {
        if (G1) { if (wid < 4) __builtin_amdgcn_global_load_lds((const unsigned*)(LIST + (size_t)u.e * NTOK + 256 * u.rt + 64 * wid + lane), (LAS unsigned*)(buf + 64 * wid), 4, 0, 0); } }
    __device__ __forceinline__ unsigned arow_lds(const g8::GUnit& u, int r, const LAS unsigned* buf) const {
        if (G1) { const unsigned tok = buf[r]; return (tok < (unsigned)NTOK ? tok : 0u) * 1024u; }
        else return (unsigned)(u.x + r) * 1024u; }
};
struct EpiMoe1 {
    const float* SRSTD; const GAS float* b1; unsigned char* H;
    __device__ __forceinline__ void aux_dma(const g8::GUnit& u, LAS unsigned char* aux, int par, int wid, int lane) const {
        if (wid == 4) __builtin_amdgcn_global_load_lds((const unsigned*)(SRSTD + (size_t)u.e * NTOK + 256 * u.rt + 4 * lane), (LAS unsigned*)(aux + par * 2048), 16, 0, 0);
        if (wid == 5) __builtin_amdgcn_global_load_lds((const unsigned*)((const float*)b1 + (size_t)u.e * 2048 + (lane < 32 ? 0 : 1024) + 128 * u.pn + 4 * (lane & 31)), (LAS unsigned*)(aux + par * 2048 + 1024), 16, 0, 0); }
    __device__ __forceinline__ bool operator()(f32x4 (&acc)[2][2][4][2], const g8::GUnit& u, int wr, int wc, int fr, int fq, LAS unsigned char* aux, int par) const {
        const int j0 = 128 * u.pn + 32 * wc + 8 * fq; const bool odd = fq & 1;
        const LAS float* sb = (const LAS float*)(aux + par * 2048); const LAS float* bbuf = sb + 256;
        f32x4 bg[2], bl[2];
#pragma unroll
        for (int n = 0; n < 2; ++n) { bg[n] = *(const LAS f32x4*)(bbuf + 32 * wc + 8 * fq + 4 * n); bl[n] = *(const LAS f32x4*)(bbuf + 128 + 32 * wc + 8 * fq + 4 * n) + 1.0f; }
        float rsv[2][4];
#pragma unroll
        for (int ai = 0; ai < 2; ++ai)
#pragma unroll
            for (int m = 0; m < 4; ++m) { const int r = 128 * ai + 64 * wr + 16 * m + fr; rsv[ai][m] = (r < u.y) ? sb[r] * 0.03125f : 0.f; }
#pragma unroll
        for (int ai = 0; ai < 2; ++ai)
#pragma unroll
            for (int mp = 0; mp < 2; ++mp) {
                u32x2 h8[2]; int rr[2];
#pragma unroll
                for (int q = 0; q < 2; ++q) { const int m = 2 * mp + q;
                    const int r = 128 * ai + 64 * wr + 16 * m + fr; rr[q] = r;
                    const float rs = rsv[ai][m];
                    f32x4 o[2];
#pragma unroll
                    for (int n = 0; n < 2; ++n)
#pragma unroll
                        for (int e = 0; e < 4; ++e) {
                            const float g = fminf(rs * acc[ai][0][m][n][e] + bg[n][e], 7.0f);
                            const float l1 = __builtin_amdgcn_fmed3f(rs * acc[ai][1][m][n][e] + bl[n][e], -6.0f, 8.0f);
                            o[n][e] = (g * l1) * __builtin_amdgcn_rcpf(1.0f + __builtin_amdgcn_exp2f(g * (-1.702f * LOG2E_)));
                        }
                    h8[q] = pack8_fp8(o[0], o[1]); }
                const u32x2 snd = odd ? h8[0] : h8[1];
                u32x2 rcv; rcv.x = (unsigned)__shfl_xor((int)snd.x, 16); rcv.y = (unsigned)__shfl_xor((int)snd.y, 16);
                const u32x4 w16 = odd ? (u32x4){rcv.x, rcv.y, h8[1].x, h8[1].y} : (u32x4){h8[0].x, h8[0].y, rcv.x, rcv.y};
                const int r = odd ? rr[1] : rr[0];
                if (r < u.y) st16(H + (size_t)(u.x + r) * 1024 + (odd ? j0 - 8 : j0), w16);
            }
        return false;
    }
};
struct EpiMoe2 {
    const float* GLIST; const GAS float* b2; unsigned char* Y2;
    __device__ __forceinline__ void aux_dma(const g8::GUnit& u, LAS unsigned char* aux, int par, int wid, int lane) const {
        if (wid == 4) __builtin_amdgcn_global_load_lds((const unsigned*)(GLIST + (size_t)u.e * NTOK + 256 * u.rt + 4 * lane), (LAS unsigned*)(aux + par * 2048), 16, 0, 0);
        if (wid == 5) __builtin_amdgcn_global_load_lds((const unsigned*)((const float*)b2 + (size_t)u.e * 1024 + 256 * u.pn + 4 * lane), (LAS unsigned*)(aux + par * 2048 + 1024), 16, 0, 0); }
    __device__ __forceinline__ bool operator()(f32x4 (&acc)[2][2][4][2], const g8::GUnit& u, int wr, int wc, int fr, int fq, LAS unsigned char* aux, int par) const {
        const int c0 = 256 * u.pn + 64 * wc + 8 * fq; const bool odd = fq & 1;
        const LAS float* sb = (const LAS float*)(aux + par * 2048); const LAS float* bbuf = sb + 256;
        f32x4 bb[2][2];
#pragma unroll
        for (int bj = 0; bj < 2; ++bj)
#pragma unroll
            for (int n = 0; n < 2; ++n) bb[bj][n] = *(const LAS f32x4*)(bbuf + 64 * wc + 8 * fq + 32 * bj + 4 * n);
        float gtv[2][4];
#pragma unroll
        for (int ai = 0; ai < 2; ++ai)
#pragma unroll
            for (int m = 0; m < 4; ++m) { const int r = 128 * ai + 64 * wr + 16 * m + fr; gtv[ai][m] = (r < u.y) ? sb[r] * 16.0f : 0.f; }
#pragma unroll
        for (int ai = 0; ai < 2; ++ai)
#pragma unroll
            for (int m = 0; m < 4; ++m) {
                const int r = 128 * ai + 64 * wr + 16 * m + fr; const bool valid = r < u.y;
                const float gt = gtv[ai][m];
                u32x2 f8[2];
#pragma unroll
                for (int bj = 0; bj < 2; ++bj) f8[bj] = pack8_fp8((acc[ai][bj][m][0] * 0.03125f + bb[bj][0]) * gt, (acc[ai][bj][m][1] * 0.03125f + bb[bj][1]) * gt);
                const u32x2 snd = odd ? f8[0] : f8[1];
                u32x2 rcv; rcv.x = (unsigned)__shfl_xor((int)snd.x, 16); rcv.y = (unsigned)__shfl_xor((int)snd.y, 16);
                const u32x4 w16 = odd ? (u32x4){rcv.x, rcv.y, f8[1].x, f8[1].y} : (u32x4){f8[0].x, f8[0].y, rcv.x, rcv.y};
                if (valid) st16(Y2 + (size_t)(u.x + r) * 1024 + 256 * u.pn + 64 * wc + (odd ? 32 + 8 * (fq - 1) : 8 * fq), w16);
            }
        return false;
    }
};

constexpr int KP = 160, VP = 288;
constexpr int ML_K = 0, ML_V = 256 * KP, ML_C = ML_V + 256 * VP, ML_F = ML_C + 64 * VP, ML_OST = ML_F + 3328;
__device__ __forceinline__ float logsigmoidf_(float f) { return fminf(f, 0.f) - __logf(1.0f + __expf(-fabsf(f))); }

struct GateRaw { float iv[4], fr[4]; };
__device__ __forceinline__ void ml_gates_load(Frame& F, int n0, int h, GateRaw& R) {
#pragma unroll
    for (int e = 0; e < 4; ++e) { R.iv[e] = 0.f; R.fr[e] = 0.f; }
    if (F.wave == 0) {
        const float* G = WSP(float, WS_GATES);
#pragma unroll
        for (int e = 0; e < 4; ++e) { const size_t t = (size_t)(n0 + 4 * F.lane + e) * 8; R.iv[e] = G[t + h]; R.fr[e] = G[t + 4 + h]; }
    }
}
__device__ __forceinline__ void ml_gates_scan(Frame& F, const GateRaw& R, LAS float* Bc, LAS float* ig) {
    if (F.wave == 0) {
        float lf[4];
#pragma unroll
        for (int e = 0; e < 4; ++e) lf[e] = logsigmoidf_(R.fr[e]);
        lf[1] += lf[0]; lf[2] += lf[1]; lf[3] += lf[2];
        float tot = lf[3], inc = tot;
#pragma unroll
        for (int o = 1; o < 64; o <<= 1) { const float t = __shfl_up(inc, o); if (F.lane >= o) inc += t; }
        const float exc = inc - tot;
#pragma unroll
        for (int e = 0; e < 4; ++e) { Bc[4 * F.lane + e] = exc + lf[e]; ig[4 * F.lane + e] = R.iv[e]; }
    }
}

__device__ __forceinline__ void mlstm_state_unit(Frame& F, int u) {
    const int bh = u >> 6, sc = u & 63, b = bh >> 2, h = bh & 3;
    const int n0 = b * SEQ + sc * 256;
    LAS unsigned char* Ks = F.lds + ML_K; LAS unsigned char* Vs = F.lds + ML_V;
    LAS float* Bc = (LAS float*)(F.lds + ML_F); LAS float* ig = Bc + 256;
    const bf16_t* MK = WSP(bf16_t, WS_MK); const bf16_t* MV = WSP(bf16_t, WS_MV);
    GateRaw graw; ml_gates_load(F, n0, h, graw);
    u32x4 kreg[4], vreg[8];
#pragma unroll
    for (int t = 0; t < 4; ++t) { const int c = F.tid + 512 * t, s = c >> 3, ch = c & 7; kreg[t] = *(const u32x4*)(MK + (size_t)(n0 + s) * 256 + h * 64 + ch * 8); }
#pragma unroll
    for (int t = 0; t < 8; ++t) { const int c = F.tid + 512 * t, s = c >> 4, ch = c & 15; vreg[t] = *(const u32x4*)(MV + (size_t)(n0 + s) * 512 + h * 128 + ch * 8); }
    ml_gates_scan(F, graw, Bc, ig);
    __syncthreads();
    const float Gt = Bc[255];
#pragma unroll
    for (int t = 0; t < 4; ++t) { const int c = F.tid + 512 * t, s = c >> 3, ch = c & 7; const float w = __expf(Gt - Bc[s] + ig[s]);
        f32x4 a0, a1; unpack8(kreg[t], a0, a1);
        *(LAS u32x4*)(Ks + s * KP + ch * 16) = pack8(a0 * w, a1 * w); }
#pragma unroll
    for (int t = 0; t < 8; ++t) { const int c = F.tid + 512 * t, s = c >> 4, ch = c & 15; *(LAS u32x4*)(Vs + s * VP + ch * 16) = vreg[t]; }
    __syncthreads();
    const int i = F.lane & 15, g = F.lane >> 4, w = F.wave;
    f32x4 acc[4], accn[4];
#pragma unroll
    for (int t = 0; t < 4; ++t) { acc[t] = (f32x4){0.f, 0.f, 0.f, 0.f}; accn[t] = (f32x4){0.f, 0.f, 0.f, 0.f}; }
    const bf16x8 ones = (bf16x8){0x3F80, 0x3F80, 0x3F80, 0x3F80, 0x3F80, 0x3F80, 0x3F80, 0x3F80};
    const int roff = (4 * g + (i >> 2));
    for (int ks = 0; ks < 8; ++ks) {
        const int s0 = 32 * ks;
        const LAS unsigned char* vp = Vs + (s0 + roff) * VP + (16 * w + 4 * (i & 3)) * 2;
        const bf16x8 bv = cat4(trread(vp), trread(vp + 16 * VP));
#pragma unroll
        for (int dk = 0; dk < 4; ++dk) {
            const LAS unsigned char* kp = Ks + (s0 + roff) * KP + (16 * dk + 4 * (i & 3)) * 2;
            const bf16x8 ak = cat4(trread(kp), trread(kp + 16 * KP));
            acc[dk] = MFMA16(ak, bv, acc[dk]);
            if (w == 0) accn[dk] = MFMA16(ak, ones, accn[dk]);
        }
    }
    float* CL = WSP(float, WS_CLOC) + (size_t)u * 8192;
#pragma unroll
    for (int dk = 0; dk < 4; ++dk)
#pragma unroll
        for (int r = 0; r < 4; ++r) CL[(16 * dk + 4 * g + r) * 128 + 16 * w + i] = acc[dk][r];
    if (w == 0 && i == 0) {
#pragma unroll
        for (int dk = 0; dk < 4; ++dk)
#pragma unroll
            for (int r = 0; r < 4; ++r) WSP(float, WS_MSTAT)[(size_t)u * 64 + 16 * dk + 4 * g + r] = accn[dk][r];
    }
    if (F.tid == 0) WSP(float, WS_MSTAT)[512 * 64 + u] = Gt;
    __syncthreads();
}

__device__ __forceinline__ void mlstm_scan(Frame& F) {
    const int gt = F.vcu * 512 + F.tid, NT = F.G * 512;
    const float* GT = WSP(float, WS_MSTAT) + 512 * 64;
    for (int idx = gt; idx < 8 * 8256; idx += NT) {
        const int bh = idx / 8256, el = idx % 8256;
        const float* p; float* q; size_t stride;
        if (el < 8192) { p = WSP(float, WS_CLOC) + (size_t)bh * 64 * 8192 + el; q = WSP(float, WS_CINIT) + (size_t)bh * 64 * 8192 + el; stride = 8192; }
        else { p = WSP(float, WS_MSTAT) + (size_t)bh * 64 * 64 + (el - 8192); q = WSP(float, WS_NINIT) + (size_t)bh * 64 * 64 + (el - 8192); stride = 64; }
        float st = 0.f;
#pragma unroll 1
        for (int s0 = 0; s0 < 64; s0 += 32) {
            float v[32], gv[32];
#pragma unroll
            for (int k = 0; k < 32; ++k) { v[k] = p[(size_t)(s0 + k) * stride]; gv[k] = GT[bh * 64 + s0 + k]; }
#pragma unroll
            for (int k = 0; k < 32; ++k) { q[(size_t)(s0 + k) * stride] = st; st = __expf(gv[k]) * st + v[k]; }
        }
    }
}

__device__ __forceinline__ void mlstm_out_unit(Frame& F, int u) {
    const int bh = u >> 6, sc = u & 63, b = bh >> 2, h = bh & 3;
    const int n0 = b * SEQ + sc * 256;
    LAS unsigned char* Ks = F.lds + ML_K; LAS unsigned char* Vs = F.lds + ML_V; LAS unsigned char* Cs = F.lds + ML_C;
    LAS float* Bc = (LAS float*)(F.lds + ML_F); LAS float* cS = Bc + 256; LAS float* eB = Bc + 512; LAS float* nI = Bc + 768;
    const bf16_t* MK = WSP(bf16_t, WS_MK); const bf16_t* MV = WSP(bf16_t, WS_MV);
    GateRaw graw; ml_gates_load(F, n0, h, graw);
    u32x4 kreg[4], vreg[8]; f32x4 creg[2][2];
#pragma unroll
    for (int t = 0; t < 4; ++t) { const int c = F.tid + 512 * t, s = c >> 3, ch = c & 7; kreg[t] = *(const u32x4*)(MK + (size_t)(n0 + s) * 256 + h * 64 + ch * 8); }
#pragma unroll
    for (int t = 0; t < 8; ++t) { const int c = F.tid + 512 * t, s = c >> 4, ch = c & 15; vreg[t] = *(const u32x4*)(MV + (size_t)(n0 + s) * 512 + h * 128 + ch * 8); }
    { const float* CL = WSP(float, WS_CINIT) + (size_t)u * 8192;
#pragma unroll
      for (int t = 0; t < 2; ++t) { const int c = F.tid + 512 * t, dk = c >> 4, ch = c & 15; creg[t][0] = *(const f32x4*)(CL + dk * 128 + ch * 8); creg[t][1] = *(const f32x4*)(CL + dk * 128 + ch * 8 + 4); } }
    const float nIv = (F.tid < 64) ? WSP(float, WS_NINIT)[(size_t)u * 64 + F.tid] : 0.f;
    ml_gates_scan(F, graw, Bc, cS);
    __syncthreads();
    if (F.tid < 256) { const float bt = Bc[F.tid]; const float iv = cS[F.tid]; eB[F.tid] = __expf(bt); __builtin_amdgcn_s_waitcnt(0); cS[F.tid] = (iv - bt) * LOG2E; Bc[F.tid] = bt * LOG2E; }
    if (F.tid < 64) nI[F.tid] = nIv;
#pragma unroll
    for (int t = 0; t < 4; ++t) { const int c = F.tid + 512 * t, s = c >> 3, ch = c & 7; *(LAS u32x4*)(Ks + s * KP + ch * 16) = kreg[t]; }
#pragma unroll
    for (int t = 0; t < 8; ++t) { const int c = F.tid + 512 * t, s = c >> 4, ch = c & 15; *(LAS u32x4*)(Vs + s * VP + ch * 16) = vreg[t]; }
#pragma unroll
    for (int t = 0; t < 2; ++t) { const int c = F.tid + 512 * t, dk = c >> 4, ch = c & 15; *(LAS u32x4*)(Cs + dk * VP + ch * 16) = pack8(creg[t][0], creg[t][1]); }
    __syncthreads();
    const int i = F.lane & 15, g = F.lane >> 4, w = F.wave;
    const bf16_t* MQ = WSP(bf16_t, WS_MQ); const unsigned char* MO = F.ws + WS_MO;
    const GAS float* mg = INP(I_MNG) + h * 128;
    LAS unsigned char* ost = F.lds + ML_OST + w * 2176;
    float gnv[8];
#pragma unroll
    for (int dv = 0; dv < 8; ++dv) gnv[dv] = mg[16 * dv + i];
#pragma unroll 1
    for (int half = 0; half < 2; ++half) {
        const int rt = half == 0 ? w : 15 - w;
        const int tq = 16 * rt + i;
        bf16x8 qf[2];
#pragma unroll
        for (int ks = 0; ks < 2; ++ks) qf[ks] = *(const bf16x8*)(MQ + (size_t)(n0 + tq) * 256 + h * 64 + 32 * ks + 8 * g);
        u32x2 mo[2][2];
#pragma unroll
        for (int hf = 0; hf < 2; ++hf)
#pragma unroll
            for (int q = 0; q < 2; ++q) mo[hf][q] = *(const u32x2*)(MO + (size_t)(n0 + 16 * rt + (F.lane >> 3) + 8 * q) * 512 + h * 128 + 64 * hf + 8 * (F.lane & 7));
        f32x4 acc[8];
#pragma unroll
        for (int t = 0; t < 8; ++t) acc[t] = (f32x4){0.f, 0.f, 0.f, 0.f};
        float dni = 0.f;
#pragma unroll
        for (int ks = 0; ks < 2; ++ks) {
#pragma unroll
            for (int j = 0; j < 8; ++j) dni += bf2f((bf16_t)qf[ks][j]) * nI[32 * ks + 8 * g + j];
#pragma unroll
            for (int dv = 0; dv < 8; ++dv) {
                const LAS unsigned char* cp = Cs + (32 * ks + 8 * g + (i >> 2)) * VP + (16 * dv + 4 * (i & 3)) * 2;
                acc[dv] = MFMA16(qf[ks], cat4(trread(cp), trread(cp + 4 * VP)), acc[dv]);
            }
        }
        dni += __shfl_xor(dni, 16); dni += __shfl_xor(dni, 32);
        float den = dni * eB[tq];
        { float er[4];
#pragma unroll
          for (int r = 0; r < 4; ++r) er[r] = eB[16 * rt + 4 * g + r];
#pragma unroll
          for (int dv = 0; dv < 8; ++dv)
#pragma unroll
            for (int r = 0; r < 4; ++r) acc[dv][r] *= er[r]; }
        const float bt2 = Bc[tq];
        float dpart = 0.f;
        const int nks = (rt >> 1) + 1;
        for (int ks = 0; ks < nks; ++ks) {
            const int s0 = 32 * ks;
            f32x4 s0v = (f32x4){0.f, 0.f, 0.f, 0.f}, s1v = (f32x4){0.f, 0.f, 0.f, 0.f};
#pragma unroll
            for (int kk = 0; kk < 2; ++kk) {
                const bf16x8 k0 = *(const LAS bf16x8*)(Ks + (s0 + i) * KP + (32 * kk + 8 * g) * 2);
                const bf16x8 k1 = *(const LAS bf16x8*)(Ks + (s0 + 16 + i) * KP + (32 * kk + 8 * g) * 2);
                s0v = MFMA16(k0, qf[kk], s0v); s1v = MFMA16(k1, qf[kk], s1v);
            }
            const f32x4 c0 = *(const LAS f32x4*)(cS + s0 + 4 * g), c1 = *(const LAS f32x4*)(cS + s0 + 16 + 4 * g);
            f32x4 p0, p1;
#pragma unroll
            for (int r = 0; r < 4; ++r) {
                const int sa = s0 + 4 * g + r, sb = sa + 16;
                p0[r] = (sa <= tq) ? s0v[r] * __builtin_amdgcn_exp2f(bt2 + c0[r]) : 0.f;
                p1[r] = (sb <= tq) ? s1v[r] * __builtin_amdgcn_exp2f(bt2 + c1[r]) : 0.f;
                dpart += p0[r] + p1[r];
            }
            const u32x4 pw = pack8(p0, p1); const bf16x8 pa = __builtin_bit_cast(bf16x8, pw);
#pragma unroll
            for (int dv = 0; dv < 8; ++dv) {
                const LAS unsigned char* vp = Vs + (s0 + 4 * g + (i >> 2)) * VP + (16 * dv + 4 * (i & 3)) * 2;
                acc[dv] = MFMA16(pa, cat4(trread(vp), trread(vp + 16 * VP)), acc[dv]);
            }
        }
        dpart += __shfl_xor(dpart, 16); dpart += __shfl_xor(dpart, 32);
        den += dpart;
        float ss[4], dn[4];
#pragma unroll
        for (int r = 0; r < 4; ++r) { const float d = __shfl(den, 4 * g + r); dn[r] = __builtin_amdgcn_rcpf(fmaxf(fabsf(d), 1.0f)); ss[r] = 0.f; }
#pragma unroll
        for (int dv = 0; dv < 8; ++dv)
#pragma unroll
            for (int r = 0; r < 4; ++r) { acc[dv][r] *= dn[r]; ss[r] += acc[dv][r] * acc[dv][r]; }
#pragma unroll
        for (int r = 0; r < 4; ++r) { float s = ss[r]; s += __shfl_xor(s, 1); s += __shfl_xor(s, 2); s += __shfl_xor(s, 4); s += __shfl_xor(s, 8); ss[r] = __builtin_amdgcn_rsqf(s * (1.0f / 128.0f) + EPS); }
#pragma unroll
        for (int hf = 0; hf < 2; ++hf) {
#pragma unroll
            for (int dq = 0; dq < 4; ++dq) { const int dv = 4 * hf + dq;
#pragma unroll
                for (int r = 0; r < 4; ++r) *(LAS bf16_t*)(ost + (4 * g + r) * 136 + (16 * dq + i) * 2) = (bf16_t)f2bf(acc[dv][r] * ss[r] * gnv[dv]); }
            LDS_WAIT();
#pragma unroll
            for (int q = 0; q < 2; ++q) { const int row = (F.lane >> 3) + 8 * q, ch = F.lane & 7;
                const LAS unsigned* sp = (const LAS unsigned*)(ost + row * 136 + ch * 16);
                const u32x4 hv = (u32x4){sp[0], sp[1], sp[2], sp[3]};
                f32x4 a0, a1, m0, m1; unpack8(hv, a0, a1); unpack8_q8(mo[hf][q], m0, m1);
                *(u32x2*)(F.ws + WS_HM + (size_t)(n0 + 16 * rt + row) * 512 + h * 128 + 64 * hf + 8 * ch) = pack8_fp8(a0 * (m0 * (16.0f / 255.0f)), a1 * (m1 * (16.0f / 255.0f))); }
            LDS_WAIT();
        }
    }
    __syncthreads();
}

struct AUnit { int b, grp, h, d, rc, qb, cont; };
__device__ __forceinline__ AUnit attn_decode(int u) { AUnit a; a.b = u / 1536; int r_ = u % 1536; a.grp = r_ / 512; r_ %= 512; a.h = r_ / 128; const int j = r_ % 128;
    a.d = a.grp == 0 ? 1 : (a.grp == 1 ? 4 : 16); const int nb = 128 / a.d; a.rc = j / nb; a.qb = j % nb; a.cont = 0; return a; }
__device__ __forceinline__ void attn_fetch(Frame& F, const AUnit& a, u32x4 (&kr)[4], u32x4 (&vr)[4], bf16x8 (&qf)[2]) {
    const bf16_t* AK = WSP(bf16_t, WS_AK); const bf16_t* AV = WSP(bf16_t, WS_AV); const bf16_t* AQ = WSP(bf16_t, WS_AQ);
    const size_t hoff = (size_t)a.grp * 256 + a.h * 64; const int kk0 = a.qb == 0 ? 128 : 0;
#pragma unroll
    for (int t = 0; t < 4; ++t) { const int c = F.tid + 512 * t, kk = c >> 3, ch = c & 7;
        kr[t] = (u32x4){0u, 0u, 0u, 0u}; vr[t] = kr[t];
        if (kk >= kk0 && !(a.cont && t < 2)) { const int tok = (128 * (a.qb - 1) + kk) * a.d + a.rc; const size_t o = (size_t)(a.b * SEQ + tok) * 768 + hoff + ch * 8; kr[t] = *(const u32x4*)(AK + o); vr[t] = *(const u32x4*)(AV + o); } }
    const int i = F.lane & 15, g = F.lane >> 4; const int tokq = (128 * a.qb + 16 * F.wave + i) * a.d + a.rc;
#pragma unroll
    for (int ks = 0; ks < 2; ++ks) qf[ks] = *(const bf16x8*)(AQ + (size_t)(a.b * SEQ + tokq) * 768 + hoff + 32 * ks + 8 * g);
}
__device__ __forceinline__ void attn_compute(Frame& F, const AUnit& a, const bf16x8 (&qf)[2]) {
    const int b = a.b, grp = a.grp, h = a.h, d = a.d, rc = a.rc, qb = a.qb;
    LAS unsigned char* Ks = F.lds; LAS unsigned char* Vs = F.lds + 256 * KP;
    const int kk0 = qb == 0 ? 128 : 0;
    const int i = F.lane & 15, g = F.lane >> 4, w = F.wave;
    const int qi = 16 * w + i;
    const int tokq = (128 * qb + qi) * d + rc;
    const float slope2 = exp2f(-8.0f * (float)(grp * 4 + h + 1) / 12.0f) * (float)d * LOG2E;
    const int slo = w >> 1;
    f32x4 s0v[5], s1v[5];
    float mx = -INFINITY;
    const int dbase = qi + 128 - 32 * slo - 4 * g;
    const float nb0 = -slope2 * (float)dbase;
#pragma unroll
    for (int si = 0; si < 5; ++si) {
        const int kb = 32 * (slo + si);
        const int pb = (((qb - 1 + (kb >> 7)) & 1) << 7) | (kb & 127);
        f32x4 a0, a1;
#pragma unroll
        for (int r = 0; r < 4; ++r) { a0[r] = nb0 + slope2 * (float)(32 * si + r); a1[r] = nb0 + slope2 * (float)(32 * si + r + 16); }
#pragma unroll
        for (int kk = 0; kk < 2; ++kk) {
            const bf16x8 k0 = *(const LAS bf16x8*)(Ks + (pb + i) * KP + (32 * kk + 8 * g) * 2);
            const bf16x8 k1 = *(const LAS bf16x8*)(Ks + (pb + 16 + i) * KP + (32 * kk + 8 * g) * 2);
            a0 = MFMA16(k0, qf[kk], a0); a1 = MFMA16(k1, qf[kk], a1);
        }
        if (si == 0 || si == 4 || kk0) {
#pragma unroll
            for (int r = 0; r < 4; ++r) {
                const int ka = kb + 4 * g + r, kc = ka + 16;
                const int da = dbase - 32 * si - r, dc = da - 16;
                if (!(da >= 0 && da <= 128 && ka >= kk0)) a0[r] = -INFINITY;
                if (!(dc >= 0 && dc <= 128 && kc >= kk0)) a1[r] = -INFINITY;
            }
        }
#pragma unroll
        for (int r = 0; r < 4; ++r) mx = fmaxf(mx, fmaxf(a0[r], a1[r]));
        s0v[si] = a0; s1v[si] = a1;
    }
    mx = fmaxf(mx, __shfl_xor(mx, 16)); mx = fmaxf(mx, __shfl_xor(mx, 32));
    float den = 0.f;
    f32x4 o[4];
#pragma unroll
    for (int t = 0; t < 4; ++t) o[t] = (f32x4){0.f, 0.f, 0.f, 0.f};
#pragma unroll
    for (int si = 0; si < 5; ++si) {
        const int kb = 32 * (slo + si);
        const int pb = (((qb - 1 + (kb >> 7)) & 1) << 7) | (kb & 127);
        f32x4 p0, p1;
#pragma unroll
        for (int r = 0; r < 4; ++r) { p0[r] = __builtin_amdgcn_exp2f(s0v[si][r] - mx); p1[r] = __builtin_amdgcn_exp2f(s1v[si][r] - mx); den += p0[r] + p1[r]; }
        const u32x4 pw = pack8(p0, p1); const bf16x8 pa = __builtin_bit_cast(bf16x8, pw);
#pragma unroll
        for (int dt = 0; dt < 4; ++dt) {
            const LAS unsigned char* vp = Vs + (pb + 4 * g + (i >> 2)) * KP + (16 * dt + 4 * (i & 3)) * 2;
            o[dt] = MFMA16(pa, cat4(trread(vp), trread(vp + 16 * KP)), o[dt]);
        }
    }
    den += __shfl_xor(den, 16); den += __shfl_xor(den, 32);
    if (g == 0) WSP(float, WS_LSE)[((size_t)grp * NTOK + b * SEQ + tokq) * 4 + h] = mx + __log2f(den);
    bf16_t* AO = WSP(bf16_t, WS_AO) + (size_t)grp * NTOK * 256;
    LAS unsigned char* ost = F.lds + 2 * 256 * KP + w * 2176;
#pragma unroll
    for (int r = 0; r < 4; ++r) {
        const float dn = __builtin_amdgcn_rcpf(__shfl(den, 4 * g + r));
#pragma unroll
        for (int dt = 0; dt < 4; ++dt) *(LAS bf16_t*)(ost + (4 * g + r) * 136 + (16 * dt + i) * 2) = (bf16_t)f2bf(o[dt][r] * dn);
    }
    LDS_WAIT();
#pragma unroll
    for (int q = 0; q < 2; ++q) { const int row = (F.lane >> 3) + 8 * q, ch = F.lane & 7;
        const LAS unsigned* sp = (const LAS unsigned*)(ost + row * 136 + ch * 16);
        const u32x4 hv = (u32x4){sp[0], sp[1], sp[2], sp[3]};
        const int tk = (128 * qb + 16 * w + row) * d + rc;
        *(u32x4*)(AO + (size_t)(b * SEQ + tk) * 256 + h * 64 + 8 * ch) = hv; }
    LDS_WAIT();
}
__device__ __forceinline__ void attn_phase(Frame& F) {
    LAS unsigned char* Ks = F.lds; LAS unsigned char* Vs = F.lds + 256 * KP;
    u32x4 k0[4], v0[4], k1[4], v1[4]; bf16x8 q0[2], q1[2], qc[2];
    const int per = (3072 + F.G - 1) / F.G; const int ub = F.vcu * per, ue = (ub + per < 3072) ? ub + per : 3072;
    int u = ub;
    if (u >= ue) return;
#define ATTN_DEC(A, U) do { A = attn_decode(U); A.cont = ((U) > ub && A.qb != 0) ? 1 : 0; } while (0)
    AUnit c0, c1; ATTN_DEC(c0, u); c1 = c0;
    attn_fetch(F, c0, k0, v0, q0);
    bool has1 = (u + 1) < ue;
    if (has1) { ATTN_DEC(c1, u + 1); attn_fetch(F, c1, k1, v1, q1); }
#define ATTN_STEP(KR, VR, QR, CU, UN) do { \
        _Pragma("unroll") for (int t = 0; t < 4; ++t) { const int c = F.tid + 512 * t, kk = c >> 3, ch = c & 7; \
            const int pr = (((CU.qb - 1 + (kk >> 7)) & 1) << 7) | (kk & 127); \
            if (!(CU.cont && t < 2)) { *(LAS u32x4*)(Ks + pr * KP + ch * 16) = KR[t]; *(LAS u32x4*)(Vs + pr * KP + ch * 16) = VR[t]; } } \
        qc[0] = QR[0]; qc[1] = QR[1]; \
        __syncthreads(); \
        const AUnit cur_ = CU; const int un_ = (UN); const bool hn_ = un_ < ue; \
        if (hn_) { ATTN_DEC(CU, un_); attn_fetch(F, CU, KR, VR, QR); } \
        attn_compute(F, cur_, qc); \
        __syncthreads(); } while (0)
    for (;;) {
        ATTN_STEP(k0, v0, q0, c0, u + 2);
        if (!has1) break;
        ATTN_STEP(k1, v1, q1, c1, u + 3);
        u += 2;
        if (u >= ue) break;
        has1 = (u + 1) < ue;
    }
#undef ATTN_STEP
#undef ATTN_DEC
}

__device__ __forceinline__ void attn_merge(Frame& F) {
    const int gt = F.vcu * 512 + F.tid, NT = F.G * 512;
    const float* LSE = WSP(float, WS_LSE); const bf16_t* AO = WSP(bf16_t, WS_AO);
    for (int idx = gt; idx < NTOK * 32; idx += NT) {
        const int n = idx >> 5, ch = idx & 31, h = ch >> 3;
        const float l0 = LSE[((size_t)0 * NTOK + n) * 4 + h], l1 = LSE[((size_t)1 * NTOK + n) * 4 + h], l2 = LSE[((size_t)2 * NTOK + n) * 4 + h];
        const float m = fmaxf(l0, fmaxf(l1, l2));
        float w0 = __builtin_amdgcn_exp2f(l0 - m), w1 = __builtin_amdgcn_exp2f(l1 - m), w2 = __builtin_amdgcn_exp2f(l2 - m);
        const float inv = 16.0f / (w0 + w1 + w2); w0 *= inv; w1 *= inv; w2 *= inv;
        f32x4 a0, a1, b0, b1, c0, c1;
        unpack8(*(const u32x4*)(AO + ((size_t)0 * NTOK + n) * 256 + ch * 8), a0, a1);
        unpack8(*(const u32x4*)(AO + ((size_t)1 * NTOK + n) * 256 + ch * 8), b0, b1);
        unpack8(*(const u32x4*)(AO + ((size_t)2 * NTOK + n) * 256 + ch * 8), c0, c1);
        *(u32x2*)(F.ws + WS_HA + (size_t)n * 512 + ch * 8) = pack8_fp8(a0 * w0 + b0 * w1 + c0 * w2, a1 * w0 + b1 * w1 + c1 * w2);
    }
}

__device__ __forceinline__ void route_phase(Frame& F) {
    constexpr int WP = 2064;
    LAS unsigned char* WRs = F.lds;
    LAS int* lcnt = (LAS int*)(F.lds + 32 * WP); LAS int* lbase = lcnt + 32;
    const int i = F.lane & 15, g = F.lane >> 4, w = F.wave;
    const bf16_t* X1B = WSP(bf16_t, WS_X1B); const bf16_t* WR = WSP(bf16_t, WS_WR);
    bool staged = false;
    for (int blk = F.vcu; blk < NTOK / 128; blk += F.G) {
        const int row0 = blk * 128 + 16 * w;
        bf16x8 af[32];
#pragma unroll
        for (int ks = 0; ks < 32; ++ks) af[ks] = *(const bf16x8*)(X1B + (size_t)(row0 + i) * DM + 32 * ks + 8 * g);
        if (!staged) { for (int c = F.tid; c < 32 * 128; c += 512) { const int e = c >> 7, ch = c & 127; *(LAS u32x4*)(WRs + e * WP + ch * 16) = *(const u32x4*)(WR + (size_t)e * DM + ch * 8); } staged = true; }
        if (F.tid < 32) lcnt[F.tid] = 0;
        __syncthreads();
        float ssq;
        { const f32x4* sp = (const f32x4*)(WSP(float, WS_SSQ) + (size_t)(row0 + i) * 16); const f32x4 a = sp[0], b = sp[1], c = sp[2], d4 = sp[3];
          ssq = (a[0] + a[1] + a[2] + a[3]) + (b[0] + b[1] + b[2] + b[3]) + (c[0] + c[1] + c[2] + c[3]) + (d4[0] + d4[1] + d4[2] + d4[3]); }
        const float rstd = __builtin_amdgcn_rsqf(ssq * (1.0f / DM) + EPS);
        f32x4 acc[2]; acc[0] = (f32x4){0.f, 0.f, 0.f, 0.f}; acc[1] = acc[0];
#pragma unroll
        for (int ks = 0; ks < 32; ++ks) {
            const bf16x8 b0 = *(const LAS bf16x8*)(WRs + i * WP + (32 * ks + 8 * g) * 2);
            const bf16x8 b1 = *(const LAS bf16x8*)(WRs + (16 + i) * WP + (32 * ks + 8 * g) * 2);
            acc[0] = MFMA16(af[ks], b0, acc[0]); acc[1] = MFMA16(af[ks], b1, acc[1]);
        }
        const float br0 = INP(I_BR)[i], br1 = INP(I_BR)[16 + i];
        float tv[4][4]; int ti[4][4];
#pragma unroll
        for (int r = 0; r < 4; ++r) {
            const float rs = __shfl(rstd, 4 * g + r);
            float v0 = rs * acc[0][r] + br0, v1 = rs * acc[1][r] + br1;
#pragma unroll
            for (int k = 0; k < 4; ++k) {
                float bv = v0; int bi = i; if (v1 > bv) { bv = v1; bi = 16 + i; }
#pragma unroll
                for (int o = 1; o < 16; o <<= 1) { const float ov = __shfl_xor(bv, o); const int oi = __shfl_xor(bi, o); if (ov > bv || (ov == bv && oi < bi)) { bv = ov; bi = oi; } }
                tv[r][k] = bv; ti[r][k] = bi;
                if (bi == i) v0 = -INFINITY; if (bi == 16 + i) v1 = -INFINITY;
            }
        }
        float mv = 0.f, ssum = 0.f; int me = 0;
#pragma unroll
        for (int r = 0; r < 4; ++r) {
            const float e0 = 1.0f, e1 = __expf(tv[r][1] - tv[r][0]), e2 = __expf(tv[r][2] - tv[r][0]), e3 = __expf(tv[r][3] - tv[r][0]);
            const float s = e0 + e1 + e2 + e3;
            if ((i >> 2) == r) { ssum = s;
                const int k = i & 3; mv = k == 0 ? e0 : (k == 1 ? e1 : (k == 2 ? e2 : e3)); me = k == 0 ? ti[r][0] : (k == 1 ? ti[r][1] : (k == 2 ? ti[r][2] : ti[r][3])); }
        }
        const float gate = mv / ssum;
        const int tok = row0 + 4 * g + (i >> 2);
        const float myrstd = __shfl(rstd, 4 * g + (i >> 2));
        const int rank = __hip_atomic_fetch_add(lcnt + me, 1, __ATOMIC_RELAXED, __HIP_MEMORY_SCOPE_WORKGROUP);
        __syncthreads();
        if (F.tid < 32) lbase[F.tid] = (int)__hip_atomic_fetch_add(WSP(unsigned, WS_CTL) + CW_CNT + F.tid, (unsigned)lcnt[F.tid], RLX_AGENT);
        __syncthreads();
        const int pos = lbase[me] + rank;
        WSP(int, WS_TOPE)[(size_t)tok * 4 + (i & 3)] = me;
        WSP(int, WS_TOPPOS)[(size_t)tok * 4 + (i & 3)] = pos;
        WSP(int, WS_LIST)[(size_t)me * NTOK + pos] = tok;
        WSP(float, WS_GLIST)[(size_t)me * NTOK + pos] = gate;
        WSP(float, WS_SRSTD)[(size_t)me * NTOK + pos] = myrstd;
        __syncthreads();
    }
}

__device__ __forceinline__ void combine_phase(Frame& F) {
    const LAS int* tab = (const LAS int*)(F.lds + TAB_OFF);
    const int gw = F.vcu * 8 + F.wave, NGW = F.G * 8;
    const unsigned char* Y2 = F.ws + WS_Y2;
    const int c = F.lane * 4;
    for (int n0 = gw * 2; n0 < NTOK; n0 += NGW * 2) {
        size_t ro[2][4];
#pragma unroll
        for (int t = 0; t < 2; ++t) { const u32x4 ev = *(const u32x4*)(WSP(int, WS_TOPE) + (size_t)(n0 + t) * 4), pv = *(const u32x4*)(WSP(int, WS_TOPPOS) + (size_t)(n0 + t) * 4);
#pragma unroll
            for (int k = 0; k < 4; ++k) ro[t][k] = (size_t)(tab[40 + (int)ev[k]] + (int)pv[k]) * 1024 + c; }
        u32x2 xb[2][4]; unsigned y[2][4][4];
#pragma unroll
        for (int t = 0; t < 2; ++t) {
#pragma unroll
            for (int q = 0; q < 4; ++q) xb[t][q] = *(const u32x2*)(WSP(bf16_t, WS_X1B) + (size_t)(n0 + t) * DM + c + 256 * q);
#pragma unroll
            for (int k = 0; k < 4; ++k)
#pragma unroll
                for (int q = 0; q < 4; ++q) y[t][k][q] = *(const unsigned*)(Y2 + ro[t][k] + 256 * q); }
#pragma unroll
        for (int t = 0; t < 2; ++t)
#pragma unroll
            for (int q = 0; q < 4; ++q) {
                f32x4 m4 = (f32x4){0.f, 0.f, 0.f, 0.f};
#pragma unroll
                for (int k = 0; k < 4; ++k) { const f32x2 lo = __builtin_amdgcn_cvt_pk_f32_fp8((int)y[t][k][q], false), hi = __builtin_amdgcn_cvt_pk_f32_fp8((int)y[t][k][q], true);
                    m4[0] += lo[0]; m4[1] += lo[1]; m4[2] += hi[0]; m4[3] += hi[1]; }
                const f32x4 s = (f32x4){bflo(xb[t][q].x), bfhi(xb[t][q].x), bflo(xb[t][q].y), bfhi(xb[t][q].y)};
                *(f32x4*)(F.out + (size_t)(n0 + t) * DM + c + 256 * q) = s + m4 * 0.0625f; }
    }
}

__global__ void __launch_bounds__(512, 2) hyb_fwd(Args args) {
    extern __shared__ __attribute__((aligned(16))) unsigned char lds[];
    Frame F;
    F.lds = (LAS unsigned char*)lds;
    F.tid = threadIdx.x; F.lane = F.tid & 63; F.wave = __builtin_amdgcn_readfirstlane(F.tid >> 6);
#define REFRESH_IDS() do { } while (0)
    F.G = gridDim.x; { const int bx = blockIdx.x; F.vcu = (F.G % 8 == 0) ? (bx % 8) * (F.G / 8) + bx / 8 : bx; }
    F.ap = (KArgP)__builtin_amdgcn_kernarg_segment_ptr(); F.out = args.out; F.ws = args.ws;
    volatile LAS unsigned* MISC = (volatile LAS unsigned*)(F.lds + MISC_OFF);
    for (int u = F.tid; u < 32; u += 512) MISC[u] = 0u;
    __syncthreads();
    const int lo = args.ph_lo, hi = args.ph_hi & 255, variant = args.ph_hi >> 8;
    XcdBarrier bar; bar.bar = WSP(unsigned, WS_CTL) + CW_BAR; bar.x = 0; bar.st = nullptr;
    if (hi - lo > 1) bar = xcd_barrier_post(WSP(unsigned, WS_CTL) + CW_BAR, MISC + 8, F.tid == 0);
#define IN(k) (lo <= (k) && (k) < hi)
#define SEAM(k) do { if (IN(k) && IN((k) + 1)) { REFRESH_IDS(); xcd_barrier(bar, F.tid == 0); } REFRESH_IDS(); } while (0)

    if (IN(0)) { p0_prologue(F); } SEAM(0);

    if (IN(1)) {
        { SchedInProj S; S.T.init(NTOK / 256, FP8_FROM, F.G, (int)blockIdx.x); S.A = (const char*)WSP(bf16_t, WS_XN); S.B = (const char*)WSP(bf16_t, WS_WIN);
          EpiInProj E{F.ws, INP(I_AQG), INP(I_AKG), 1.0f};
          g8::gemm_phase<EpiInProj, SchedInProj, false>(F.lds, S, E, 2048u, 2048u, F.tid, F.wave); }
        { SchedInProj8 S; S.T.init(NTOK / 256, 23 - FP8_FROM, F.G, (int)blockIdx.x); S.A = (const char*)(F.ws + WS_XN8); S.B = (const char*)(F.ws + WS_WIN8);
          EpiInProj E{F.ws, INP(I_AQG), INP(I_AKG), 0.03125f};
          g8::gemm_phase<EpiInProj, SchedInProj8, true, 1>(F.lds, S, E, 1024u, 1024u, F.tid, F.wave); }
        { constexpr int ALL = 92 * 16 + 16 * 8 + 16 * 4 + 16 * 16 + 16 + 32 * 32 * 16 + 32 * 16 * 16;
          const int rem = ((NTOK / 256) * (23 - FP8_FROM)) % F.G;
          if (W2_TAIL > 0 && rem != 0 && (int)blockIdx.x >= rem) convert_tail(F, ALL - W2_TAIL, W2_TAIL / 2, (int)blockIdx.x - rem, F.G - rem);
          else if (W2_TAIL > 0 && rem == 0) convert_tail(F, ALL - W2_TAIL, W2_TAIL / 2, (int)blockIdx.x, F.G); }
    } SEAM(1);

    if (IN(2)) {
        if (variant != 2) for (int u = F.vcu; u < 512; u += F.G) mlstm_state_unit(F, u);
        if (variant != 1) attn_phase(F);
    } SEAM(2);

    if (IN(3)) { mlstm_scan(F); } SEAM(3);

    if (IN(4)) {
        for (int u = F.vcu; u < 512; u += F.G) mlstm_out_unit(F, u);
        attn_merge(F);
    } SEAM(4);

    if (IN(5)) {
        SchedBranch8 S; S.T.init(NTOK / 256, 4, F.G, (int)blockIdx.x);
        S.A0 = (const char*)(F.ws + WS_HM); S.B0 = (const char*)(F.ws + WS_WM); S.A1 = (const char*)(F.ws + WS_HA); S.B1 = (const char*)(F.ws + WS_WA);
        EpiBranch E{F.ws + WS_GM, F.ws + WS_GA, F.ws + WS_Y};
        g8::gemm_phase<EpiBranch, SchedBranch8, true, 1>(F.lds, S, E, 512u, 512u, F.tid, F.wave);
    } SEAM(5);

    if (IN(6)) {
        SchedWout8 S; S.T.init(NTOK / 256, 4, F.G, (int)blockIdx.x); S.A = (const char*)(F.ws + WS_Y); S.B = (const char*)(F.ws + WS_WO);
        EpiWout E{WSP(bf16_t, WS_XN), WSP(bf16_t, WS_X1B), F.ws + WS_X1F8, WSP(float, WS_SSQ), 1.0f / 512.0f};
        g8::gemm_phase<EpiWout, SchedWout8, true, 1>(F.lds, S, E, 1024u, 1024u, F.tid, F.wave);
    } SEAM(6);

    if (IN(7)) { route_phase(F); } SEAM(7);

    if (IN(8)) {
        moe_tables(F);
        const LAS int* tab = (const LAS int*)(F.lds + TAB_OFF);
        SchedMoe<8, true> S; S.T.init(__builtin_amdgcn_readfirstlane(tab[32]), 8, F.G, (int)blockIdx.x); S.tab = tab; S.A = (const char*)(F.ws + WS_X1F8); S.B = (const char*)(F.ws + WS_W1); S.LIST = WSP(int, WS_LIST);
        EpiMoe1 E{WSP(float, WS_SRSTD), INP(I_B1), F.ws + WS_H};
        g8::gemm_phase<EpiMoe1, SchedMoe<8, true>, true, 1, G8_LATE_MOE>(F.lds, S, E, 1024u, 1024u, F.tid, F.wave);
        { constexpr int ALL = 92 * 16 + 16 * 8 + 16 * 4 + 16 * 16 + 16 + 32 * 32 * 16 + 32 * 16 * 16;
          const int rem = (__builtin_amdgcn_readfirstlane(tab[32]) * 8) % F.G;
          if (W2_TAIL > 0 && rem != 0 && (int)blockIdx.x >= rem) convert_tail(F, ALL - W2_TAIL / 2, W2_TAIL / 2, (int)blockIdx.x - rem, F.G - rem);
          else if (W2_TAIL > 0 && rem == 0) convert_tail(F, ALL - W2_TAIL / 2, W2_TAIL / 2, (int)blockIdx.x, F.G); }
    } SEAM(8);

    if (IN(9)) {
        if (lo == 9) moe_tables(F);
        const LAS int* tab = (const LAS int*)(F.lds + TAB_OFF);
        SchedMoe<4, false> S; S.T.init(__builtin_amdgcn_readfirstlane(tab[32]), 4, F.G, (int)blockIdx.x); S.tab = tab; S.A = (const char*)(F.ws + WS_H); S.B = (const char*)(F.ws + WS_W2); S.LIST = WSP(int, WS_LIST);
        EpiMoe2 E{WSP(float, WS_GLIST), INP(I_B2), F.ws + WS_Y2};
        g8::gemm_phase<EpiMoe2, SchedMoe<4, false>, true, 1, G8_LATE_MOE>(F.lds, S, E, 1024u, 1024u, F.tid, F.wave);
    } SEAM(9);

    if (IN(10)) { if (lo == 10) moe_tables(F); combine_phase(F); }
#undef IN
#undef SEAM
}

extern "C" void kernel_launch(void* const* d_in, const int* in_sizes, int n_in, void* d_out, int out_size, void* d_ws, size_t ws_size, hipStream_t stream) {
    static int grid = 0;
    if (grid == 0) {
        if (n_in != 17 || out_size != NTOK * DM || ws_size < WS_NEED) { fprintf(stderr, "kernel_launch: unexpected problem (n_in %d, out %d, ws %zu, need %zu)\n", n_in, out_size, ws_size, (size_t)WS_NEED); grid = -1; return; }
        int dev = 0, cus = 0;
        if (hipGetDevice(&dev) != hipSuccess || hipDeviceGetAttribute(&cus, hipDeviceAttributeMultiprocessorCount, dev) != hipSuccess) { grid = -1; return; }
        if (hipFuncSetAttribute((const void*)hyb_fwd, hipFuncAttributeMaxDynamicSharedMemorySize, LDS_BYTES) != hipSuccess) { fprintf(stderr, "kernel_launch: hipFuncSetAttribute failed\n"); grid = -1; return; }
        int per_cu = 0;
        if (hipOccupancyMaxActiveBlocksPerMultiprocessor(&per_cu, (const void*)hyb_fwd, 512, LDS_BYTES) != hipSuccess || per_cu < 1) fprintf(stderr, "kernel_launch: occupancy query reports %d\n", per_cu);
        (void)hipGetLastError();
        grid = cus;
    }
    if (grid < 0) return;
    (void)hipMemsetAsync((char*)d_ws + WS_CTL, 0, CTL_ZERO_BYTES, stream);
    Args a{};
    for (int i = 0; i < 17; ++i) a.in[i] = (const float*)d_in[i];
    a.out = (float*)d_out; a.ws = (unsigned char*)d_ws;
    if (MK_N_LAUNCHES == 1) { a.ph_lo = 0; a.ph_hi = NPH; hipLaunchKernelGGL(hyb_fwd, dim3(grid), dim3(512), LDS_BYTES, stream, a); }
    else { for (int p = 0; p < (MAXPH < NPH ? MAXPH : NPH); ++p) { a.ph_lo = p; a.ph_hi = p + 1;
            if (p == DUP_PHASE && p == 7) { hipLaunchKernelGGL(hyb_fwd, dim3(grid), dim3(512), LDS_BYTES, stream, a); (void)hipMemsetAsync((char*)d_ws + WS_CTL + CW_CNT * 4, 0, 128, stream); }
            hipLaunchKernelGGL(hyb_fwd, dim3(grid), dim3(512), LDS_BYTES, stream, a);
            if (p == DUP_PHASE && p == 10) { Args a2 = a; a2.out = (float*)((unsigned char*)d_ws + WS_H); hipLaunchKernelGGL(hyb_fwd, dim3(grid), dim3(512), LDS_BYTES, stream, a2); }
            else if (p == DUP_PHASE && p != 7) { Args a2 = a; a2.ph_hi = a.ph_hi + 256 * DUP_VARIANT; hipLaunchKernelGGL(hyb_fwd, dim3(grid), dim3(512), LDS_BYTES, stream, a2); } } }
}
```
